# Optimizing an MI355X kernel written in HIP

```python
import math, functools
import jax, jax.numpy as jnp
from jax import lax
import numpy as np

D_MODEL = 2048
BATCH = 2
SEQ = 8192
DEPTH = 1
DEC_BATCH = 32
DEC_SEQ = 16
PAST_LEN = 2048

CHUNK = 64
Q_BLOCK = 128
EPS = 1e-6
MLA_HEADS = 8
QK_NOPE = 128
QK_ROPE = 64
V_HEAD = 128
Q_RANK = 512
KV_RANK = 512
ROPE_BASE = 10000.0
ATTN_SCALE = (QK_NOPE + QK_ROPE) ** -0.5
HG_HEADS = 8
HG_EXPAND = 128
HG_VDIM = 128
HG_FK = HG_HEADS * HG_EXPAND
HG_V = HG_HEADS * HG_VDIM
MIX_WIDTH = MLA_HEADS * V_HEAD + HG_V
D_FF = 4 * D_MODEL
N_IN = Q_RANK + KV_RANK + QK_ROPE + 2 * HG_FK + 2 * HG_V
IN_SPLITS = [Q_RANK, Q_RANK + KV_RANK, Q_RANK + KV_RANK + QK_ROPE,
             Q_RANK + KV_RANK + QK_ROPE + HG_FK, Q_RANK + KV_RANK + QK_ROPE + 2 * HG_FK,
             Q_RANK + KV_RANK + QK_ROPE + 2 * HG_FK + HG_V]

kernel_name = 'chunk_causal_mla_hgrn2_adaln_encoder_step'


def rms_norm(x, gain=None):
    xf = x.astype(jnp.float32)
    y = xf * lax.rsqrt(jnp.mean(xf * xf, axis=-1, keepdims=True) + EPS)
    if gain is not None:
        y = y * gain.astype(jnp.float32)
    return y.astype(x.dtype)


def rope_tables(pos):
    half = QK_ROPE // 2
    inv_freq = jnp.exp(-math.log(ROPE_BASE) * jnp.arange(half, dtype=jnp.float32) / half)
    ang = pos.astype(jnp.float32)[:, None] * inv_freq[None, :]
    return jnp.cos(ang), jnp.sin(ang)


def apply_rope(x, cos, sin):
    xf = x.astype(jnp.float32)
    x1, x2 = xf[..., :QK_ROPE // 2], xf[..., QK_ROPE // 2:]
    return jnp.concatenate([x1 * cos - x2 * sin, x2 * cos + x1 * sin], axis=-1).astype(x.dtype)


def mla_prompt_attn(q_nope, q_pe, ckv, kpe, w_uk, w_uv):
    B, S, H, _ = q_nope.shape
    k_nope = jnp.einsum('bsc,chd->bshd', ckv, w_uk)
    v = jnp.einsum('bsc,chd->bshd', ckv, w_uv)
    nb = S // Q_BLOCK
    key_chunk = jnp.arange(S) // CHUNK

    def block(args):
        qn, qp, i = args
        s = (jnp.einsum('bqhd,bkhd->bhqk', qn, k_nope)
             + jnp.einsum('bqhr,bkr->bhqk', qp, kpe)).astype(jnp.float32) * ATTN_SCALE
        q_chunk = (i * Q_BLOCK + jnp.arange(Q_BLOCK)) // CHUNK
        s = jnp.where(key_chunk[None, :] <= q_chunk[:, None], s, -jnp.inf)
        p = jax.nn.softmax(s, axis=-1).astype(v.dtype)
        return jnp.einsum('bhqk,bkhd->bqhd', p, v)

    to_blocks = lambda a: jnp.moveaxis(a.reshape(B, nb, Q_BLOCK, *a.shape[2:]), 1, 0)
    o = lax.map(block, (to_blocks(q_nope), to_blocks(q_pe), jnp.arange(nb)))
    return jnp.moveaxis(o, 0, 1).reshape(B, S, H * V_HEAD)


def mla_sample_attn(past_ckv, past_kpe, q_nope, q_pe, ckv, kpe, w_uk, w_uv):
    B, L, H, _ = q_nope.shape
    ckv_all = jnp.concatenate([past_ckv.astype(ckv.dtype), ckv], axis=1)
    kpe_all = jnp.concatenate([past_kpe.astype(kpe.dtype), kpe], axis=1)
    q_lat = jnp.einsum('bqhd,chd->bqhc', q_nope, w_uk)
    s = (jnp.einsum('bqhc,bkc->bhqk', q_lat, ckv_all)
         + jnp.einsum('bqhr,bkr->bhqk', q_pe, kpe_all)).astype(jnp.float32) * ATTN_SCALE
    p = jax.nn.softmax(s, axis=-1).astype(ckv_all.dtype)
    ctx = jnp.einsum('bhqk,bkc->bqhc', p, ckv_all)
    return jnp.einsum('bqhc,chd->bqhd', ctx, w_uv).reshape(B, L, H * V_HEAD)


def gla_chunk(S, q, k, v, g):
    L = q.shape[1]
    b = jnp.cumsum(g, axis=1)
    o = jnp.einsum('blhk,bhkv->blhv', q * jnp.exp(b), S)
    causal = jnp.tril(jnp.ones((L, L), dtype=bool))[None, :, :, None, None]
    decay = jnp.exp(jnp.where(causal, b[:, :, None] - b[:, None, :], -jnp.inf))
    a = jnp.einsum('bthk,bshk,btshk->bhts', q, k, decay)
    o = o + jnp.einsum('bhts,bshv->bthv', a, v)
    b_last = b[:, -1]
    S_new = (jnp.exp(b_last)[..., None] * S
             + jnp.einsum('bshk,bshv->bhkv', k * jnp.exp(b_last[:, None] - b), v))
    return S_new, o


def hgrn_prompt(q, k, v, g):
    B, S, H, K = q.shape
    n = S // CHUNK
    to_chunks = lambda a: jnp.moveaxis(a.reshape(B, n, CHUNK, *a.shape[2:]), 1, 0)
    S0 = jnp.zeros((B, H, K, HG_VDIM), jnp.float32)
    S_fin, o = lax.scan(lambda s, xs: gla_chunk(s, *xs), S0,
                        (to_chunks(q), to_chunks(k), to_chunks(v), to_chunks(g)))
    return jnp.moveaxis(o, 0, 1).reshape(B, S, H, HG_VDIM), S_fin


def hgrn_sample(state0, q, k, v, g):
    S_new, o = gla_chunk(state0.astype(jnp.float32), q, k, v, g)
    return o, S_new


def trunk_layer(x, c, cos, sin, lb, lw, attend, recur):
    (w_ada, b_ada, w_in, w_uq, g_q, g_kv, w_uk, w_uv, g_hgrn, w_out, w_ff1, w_ff2) = lw
    B, L, _ = x.shape
    mod = (jax.nn.silu(c) @ w_ada + b_ada)[:, None, :]
    sh1, sc1, gt1, sh2, sc2, gt2 = jnp.split(mod, 6, axis=-1)
    h = rms_norm(x) * (1 + sc1) + sh1
    cq, ckv, kpe, hq, hf, hi, hg = jnp.split(h @ w_in, IN_SPLITS, axis=-1)
    q = (rms_norm(cq, g_q) @ w_uq).reshape(B, L, MLA_HEADS, QK_NOPE + QK_ROPE)
    q_nope = q[..., :QK_NOPE]
    q_pe = apply_rope(q[..., QK_NOPE:], cos[:, None], sin[:, None])
    ckv = rms_norm(ckv, g_kv)
    kpe = apply_rope(kpe, cos, sin)
    o_mla = attend(q_nope, q_pe, ckv, kpe, w_uk, w_uv)
    f = lb + (1 - lb) * jax.nn.sigmoid(hf.astype(jnp.float32))
    heads = lambda a, d: a.reshape(B, L, HG_HEADS, d)
    q_h = heads(jax.nn.silu(hq.astype(jnp.float32)) * HG_EXPAND ** -0.5, HG_EXPAND)
    o_hg, s_fin = recur(q_h, heads(1 - f, HG_EXPAND), heads(hi.astype(jnp.float32), HG_VDIM),
                        heads(jnp.log(f), HG_EXPAND))
    o_hg = rms_norm(o_hg.astype(x.dtype), g_hgrn) * jax.nn.silu(heads(hg, HG_VDIM))
    mix = jnp.concatenate([o_mla, o_hg.reshape(B, L, HG_V)], axis=-1) @ w_out
    x = x + gt1 * mix
    h = rms_norm(x) * (1 + sc2) + sh2
    x = x + gt2 * (jnp.square(jax.nn.relu(h @ w_ff1)) @ w_ff2)
    return x, ckv, kpe, s_fin.astype(x.dtype)


def setup_inputs(seed: int = 0) -> dict:
    key = jax.random.key(seed)
    ks = jax.random.split(key, 24)
    nrm = lambda k, shape, s: jax.random.normal(k, shape, jnp.float32) * s
    return {
        'x_prompt': nrm(ks[0], (BATCH, SEQ, D_MODEL), 1.0),
        'x_sample': nrm(ks[1], (DEC_BATCH, DEC_SEQ, D_MODEL), 1.0),
        'c_prompt': nrm(ks[2], (BATCH, D_MODEL), 1.0),
        'c_sample': nrm(ks[3], (DEC_BATCH, D_MODEL), 1.0),
        'cache_ckv': nrm(ks[4], (DEPTH, DEC_BATCH, PAST_LEN, KV_RANK), 1.0),
        'cache_kpe': nrm(ks[5], (DEPTH, DEC_BATCH, PAST_LEN, QK_ROPE), 1.0),
        'state_hgrn': nrm(ks[6], (DEPTH, DEC_BATCH, HG_HEADS, HG_EXPAND, HG_VDIM), 0.5),
        'w_ada': nrm(ks[7], (DEPTH, D_MODEL, 6 * D_MODEL), 0.5 * D_MODEL ** -0.5),
        'b_ada': nrm(ks[8], (DEPTH, 6 * D_MODEL), 0.02),
        'w_in': nrm(ks[9], (DEPTH, D_MODEL, N_IN), D_MODEL ** -0.5),
        'w_uq': nrm(ks[10], (DEPTH, Q_RANK, MLA_HEADS * (QK_NOPE + QK_ROPE)), Q_RANK ** -0.5),
        'g_q': 1.0 + nrm(ks[11], (DEPTH, Q_RANK), 0.01),
        'g_kv': 1.0 + nrm(ks[12], (DEPTH, KV_RANK), 0.01),
        'w_uk': nrm(ks[13], (DEPTH, KV_RANK, MLA_HEADS, QK_NOPE), KV_RANK ** -0.5),
        'w_uv': nrm(ks[14], (DEPTH, KV_RANK, MLA_HEADS, V_HEAD), KV_RANK ** -0.5),
        'hg_lower_bounds': nrm(ks[15], (DEPTH + 1, HG_FK), 0.1),
        'g_hgrn': 1.0 + nrm(ks[16], (DEPTH, HG_VDIM), 0.01),
        'w_out': nrm(ks[17], (DEPTH, MIX_WIDTH, D_MODEL), MIX_WIDTH ** -0.5),
        'w_ff1': nrm(ks[18], (DEPTH, D_MODEL, D_FF), D_MODEL ** -0.5),
        'w_ff2': nrm(ks[19], (DEPTH, D_FF, D_MODEL), D_FF ** -0.5),
        'g_final': 1.0 + nrm(ks[20], (D_MODEL,), 0.01),
    }


def reference(x_prompt, x_sample, c_prompt, c_sample, cache_ckv, cache_kpe, state_hgrn,
              w_ada, b_ada, w_in, w_uq, g_q, g_kv, w_uk, w_uv, hg_lower_bounds, g_hgrn,
              w_out, w_ff1, w_ff2, g_final):
    lb_all = jnp.cumsum(jax.nn.softmax(hg_lower_bounds.astype(jnp.float32), axis=0), axis=0)
    cos_p, sin_p = rope_tables(jnp.arange(x_prompt.shape[1]))
    cos_s, sin_s = rope_tables(PAST_LEN + jnp.arange(x_sample.shape[1]))
    yp, ys = x_prompt, x_sample
    ckv_p, kpe_p, st_p, ckv_s, kpe_s, st_s = [], [], [], [], [], []
    for l in range(DEPTH):
        lw = (w_ada[l], b_ada[l], w_in[l], w_uq[l], g_q[l], g_kv[l], w_uk[l], w_uv[l],
              g_hgrn[l], w_out[l], w_ff1[l], w_ff2[l])
        yp, a, b, s = trunk_layer(yp, c_prompt, cos_p, sin_p, lb_all[l], lw,
                                  mla_prompt_attn, hgrn_prompt)
        ckv_p.append(a); kpe_p.append(b); st_p.append(s)
        ys, a, b, s = trunk_layer(ys, c_sample, cos_s, sin_s, lb_all[l], lw,
                                  functools.partial(mla_sample_attn, cache_ckv[l], cache_kpe[l]),
                                  functools.partial(hgrn_sample, state_hgrn[l]))
        ckv_s.append(a); kpe_s.append(b); st_s.append(s)
    y_prompt = rms_norm(yp, g_final)
    y_sample = rms_norm(ys, g_final)
    return (y_prompt, y_sample, jnp.stack(ckv_p), jnp.stack(kpe_p), jnp.stack(st_p),
            jnp.stack(ckv_s), jnp.stack(kpe_s), jnp.stack(st_s))
```

```cpp
#include <hip/hip_runtime.h>
#include <hip/hip_cooperative_groups.h>
#include <cstdio>
namespace cg = cooperative_groups;

#define LAS __attribute__((address_space(3)))
typedef unsigned short bf16_t;
typedef short bf16x8 __attribute__((ext_vector_type(8)));
typedef float f32x4 __attribute__((ext_vector_type(4)));
typedef float f32x2 __attribute__((ext_vector_type(2)));
typedef unsigned u32x4 __attribute__((ext_vector_type(4)));
typedef unsigned u32x2 __attribute__((ext_vector_type(2)));

constexpr int MP = 16384, MS = 512, MT = MP + MS;
constexpr int DM = 2048, NMOD = 12288, NINP = 5376, DFF = 8192;
constexpr float EPSN = 1e-6f;
constexpr float QSCALE = 0.07216878364870322f * 1.4426950408889634f;
constexpr int NCHUNK_P = 2048, NCHUNK = 2304;

constexpr size_t O_Y = 0, O_CKV_P = 34603008, O_KPE_P = 42991616, O_ST_P = 44040192, O_CKV_S = 44302336, O_KPE_S = 44564480, O_ST_S = 44597248;
constexpr size_t OB_G = 0, OB_QH = 69206016, OB_VH = 103809024;
constexpr size_t WS_CTL = 0, WS_MOD = 4096, WS_ZERO_BYTES = 4096 + 34 * 12288 * 4;
constexpr size_t WS_ROPE = 1675264;
constexpr size_t WS_WIN = WS_ROPE + 2097152;
constexpr size_t WS_WUQ = WS_WIN + (size_t)NINP * 2048 * 2;
constexpr size_t WS_WUK = WS_WUQ + 1536 * 512 * 2;
constexpr size_t WS_WUV = WS_WUK + 1024 * 512 * 2;
constexpr size_t WS_WUKO = WS_WUV + 1024 * 512 * 2;
constexpr size_t WS_WOUT = WS_WUKO + 1024 * 512 * 2;
constexpr size_t WS_WFF1 = WS_WOUT + 2048 * 2048 * 2;
constexpr size_t WS_WFF2 = WS_WFF1 + (size_t)8192 * 2048 * 2;
constexpr size_t WS_H = WS_WFF2 + (size_t)8192 * 2048 * 2;
constexpr size_t WS_KN = WS_H, WS_VT = WS_H + (size_t)MP * 1024 * 2;
constexpr size_t WS_ARENA = WS_H + (size_t)MT * 2048 * 2;
constexpr size_t WS_GATE = WS_ARENA;
constexpr size_t WS_KPE = WS_GATE + (size_t)MT * 1024 * 2;
constexpr size_t WS_CQKV = WS_KPE + (size_t)MT * 64 * 2;
constexpr size_t WS_Q = WS_CQKV;
constexpr size_t WS_CQN = WS_CQKV + (size_t)MT * 1024 * 4;
constexpr size_t WS_QLAT = WS_WIN;
constexpr size_t WS_PO = WS_CQKV + (size_t)MT * 1536 * 2;
constexpr size_t WS_PML = WS_PO + (size_t)256 * 8 * 16 * 512 * 2;
constexpr size_t WS_CKV = WS_CQN + (size_t)MT * 512 * 2;
constexpr size_t WS_U = WS_CKV + (size_t)MT * 512 * 2;
constexpr size_t WS_MIX = WS_U;
constexpr size_t WS_DD = WS_U + (size_t)NCHUNK * 16384 * 2;
constexpr size_t WS_S = WS_DD + (size_t)NCHUNK * 128 * 4;
constexpr size_t WS_END = WS_S + (size_t)NCHUNK * 16384 * 2;
constexpr size_t WS_FFH = WS_ARENA;
constexpr size_t WS_BAR = WS_END, WS_TOTAL = WS_END + 16384;
static_assert(WS_ARENA + (size_t)MT * DFF * 2 <= WS_END, "ffh overlay");
static_assert(WS_PML + 256 * 8 * 16 * 2 * 4 <= WS_CKV, "sample partials");
static_assert((size_t)32 * 8 * 16 * 576 * 2 <= (size_t)NINP * 2048 * 2, "qlat");

#ifndef P5MASK2
#define P5MASK2 0x380
#endif
#ifndef P5REPS
#define P5REPS 1
#endif
#ifndef PHMASK
#define PHMASK 0xFFFF
#endif
constexpr int LDS_BYTES = 131072 + 256;
constexpr int LDS_Q = 131072;

typedef __bf16 bf16v2 __attribute__((ext_vector_type(2)));
__device__ __forceinline__ unsigned pk2(float lo, float hi) { const f32x2 v = (f32x2){lo, hi}; const bf16v2 b = __builtin_convertvector(v, bf16v2); return __builtin_bit_cast(unsigned, b); }
__device__ __forceinline__ float bf2f(bf16_t b) { return __uint_as_float(((unsigned)b) << 16); }
__device__ __forceinline__ float wave_sum(float v) {
#pragma unroll
    for (int o = 1; o < 64; o <<= 1) v += __shfl_xor(v, o);
    return v;
}
__device__ __forceinline__ int ltid() { int t = threadIdx.x; asm volatile("" : "+v"(t)); return t; }
__device__ __forceinline__ float silu_f(float v) { return v * __builtin_amdgcn_rcpf(1.0f + __expf(-v)); }
__device__ __forceinline__ int row_pos(int r) { return r < MP ? (r & 8191) : 2048 + ((r - MP) & 15); }
__device__ __forceinline__ int row_ci(int r) { return r < MP ? (r >> 13) : 2 + ((r - MP) >> 4); }

namespace pg8 {
constexpr int BM = 256, BK = 64, HALF = 128, HTB = HALF * BK * 2, STAGE_BYTES = 8 * HTB, NXCD = 8, WGM = 8;
__host__ __device__ __forceinline__ int lds_byte(int r, int c) { const int st = (r >> 4) * 2 + (c >> 5), rr = r & 15, cc = c & 31, ob = rr * 64 + cc * 2; return st * 1024 + (ob ^ (((ob >> 9) & 1) << 5)); }
__host__ __device__ __forceinline__ void stage_rc(int b, int& R, int& C) { const int st = b / 1024, sb = b % 1024, swz = sb ^ (((sb >> 9) & 1) << 5); R = (st >> 1) * 16 + swz / 64; C = (st & 1) * 32 + (swz % 64) / 2; }
struct Unit { int pm, pn, k0, nt, sl; };
struct Gemm { const bf16_t* A; const bf16_t* Bt; int M, N, K; };
struct StaticOrder {
    int nM, nN, nwg, G, c, ntK, ns, tail_pm0, ntail;
    __host__ __device__ void init(int M, int N, int K, int G_, int c_, int ns_ = 1, int tail_pm0_ = 0, int ntail_ = 0) { nM = M / BM; nN = N / BM; nwg = nM * nN; G = G_; c = c_; ntK = K / BK; ns = ns_; tail_pm0 = tail_pm0_; ntail = ntail_; }
    __host__ __device__ __forceinline__ void unit_of(int L, Unit& u) const {
        int wgid = L; { const int q = nwg / NXCD, r = nwg % NXCD, xcd = wgid % NXCD, off = wgid / NXCD; wgid = (xcd < r ? xcd * (q + 1) : r * (q + 1) + (xcd - r) * q) + off; }
        const int nig = WGM * nN, gid = wgid / nig, fm = gid * WGM, gsz = (nM - fm) < WGM ? (nM - fm) : WGM;
        u.pm = fm + ((wgid % nig) % gsz); u.pn = (wgid % nig) / gsz;
    }
    __host__ __device__ __forceinline__ bool next(int i, Unit& u) const {
        int L = i * G + c, k0 = 0, nt = ntK, sl = 0; bool ok = L < nwg;
        if (!ok) L = 0;
        unit_of(L, u);
        if (ns > 1) {
            const int rounds = nwg / G, idx = c / ns;
            const bool tail = (i == rounds) && (idx < ntail);
            if (tail) { nt = ntK / ns; k0 = (c % ns) * nt * BK; sl = 1; u.pm = tail_pm0 + idx / nN; u.pn = idx % nN; ok = true; }
        }
        u.k0 = k0; u.nt = nt; u.sl = sl; return ok;
    }
};
template <class Epi>
__device__ __forceinline__ void gemm_phase(LAS unsigned char* lds, const Gemm g, const StaticOrder& S, const Epi& E) {
    const int tid = ltid(), wid = __builtin_amdgcn_readfirstlane(tid >> 6), lane = tid & 63, wr = wid >> 2, wc = wid & 3, fr = lane & 15, fq = lane >> 4;
    const int K = g.K;
    unsigned voffA[2], voffB[2];
#pragma unroll
    for (int i = 0; i < 2; ++i) { int R, C; stage_rc(tid * 16 + i * 8192, R, C); voffA[i] = (unsigned)(R * K + C) * 2u; voffB[i] = (unsigned)(R * K + C) * 2u; }
    const size_t kstep = (size_t)(BK * 2);
    const size_t hstep = (size_t)HALF * K * 2;
    const size_t tstep = 2 * hstep;
    const unsigned ldsw = (unsigned)wid * 1024u;
    const int aoff = lds_byte(wr * 64 + fr, fq * 8), boff = lds_byte(wc * 32 + fr, fq * 8);
#define PG8_SA(b, h) (((b) * 2 + (h)) * HTB)
#define PG8_SB(b, h) ((4 + (b) * 2 + (h)) * HTB)
#define PG8_STAGE(bufoff, gbase, voff) do { _Pragma("unroll") for (int _i = 0; _i < 2; ++_i) \
        __builtin_amdgcn_global_load_lds((const unsigned*)((const char*)(gbase) + (voff)[_i]), (LAS unsigned*)(lds + (bufoff) + ldsw + _i * 8192), 16, 0, 0); } while (0)
#define PG8_LDA(dst, b, h) do { _Pragma("unroll") for (int m = 0; m < 4; ++m) _Pragma("unroll") for (int k = 0; k < 2; ++k) dst[m][k] = *(const LAS bf16x8*)(lds + PG8_SA(b, h) + aoff + m * 2048 + k * 1024); } while (0)
#define PG8_LDB(dst, b, h) do { _Pragma("unroll") for (int n = 0; n < 2; ++n) _Pragma("unroll") for (int k = 0; k < 2; ++k) dst[n][k] = *(const LAS bf16x8*)(lds + PG8_SB(b, h) + boff + n * 2048 + k * 1024); } while (0)
#define PG8_MMA(ai, bj, At, Bt) do { __builtin_amdgcn_s_setprio(1); _Pragma("unroll") for (int m = 0; m < 4; ++m) _Pragma("unroll") for (int n = 0; n < 2; ++n) _Pragma("unroll") for (int k = 0; k < 2; ++k) \
        acc[ai][bj][m][n] = __builtin_amdgcn_mfma_f32_16x16x32_bf16(Bt[n][k], At[m][k], acc[ai][bj][m][n], 0, 0, 0); __builtin_amdgcn_s_setprio(0); } while (0)
#define PG8_WAIT_V(n) asm volatile("s_waitcnt vmcnt(" #n ")" ::: "memory")
#define PG8_WAIT_L(n) asm volatile("s_waitcnt lgkmcnt(" #n ")" ::: "memory")
#define PG8_BAR __builtin_amdgcn_s_barrier()
#define PG8_SCHED __builtin_amdgcn_sched_barrier(0)
    Unit cur, nxt; int ui = 0;
    if (!S.next(0, cur)) return;
    f32x4 acc[2][2][4][2];
#pragma unroll
    for (int a = 0; a < 2; ++a)
#pragma unroll
        for (int b = 0; b < 2; ++b)
#pragma unroll
            for (int m = 0; m < 4; ++m)
#pragma unroll
                for (int n = 0; n < 2; ++n) acc[a][b][m][n] = (f32x4){0.f, 0.f, 0.f, 0.f};
    bf16x8 At[4][2], B0[2][2], B1[2][2];
    const char* cA = (const char*)g.A + (size_t)cur.pm * tstep + (size_t)cur.k0 * 2; const char* cB = (const char*)g.Bt + (size_t)cur.pn * tstep + (size_t)cur.k0 * 2;
    PG8_STAGE(PG8_SB(0, 0), cB, voffB); PG8_STAGE(PG8_SA(0, 0), cA, voffA); PG8_STAGE(PG8_SB(0, 1), cB + hstep, voffB); PG8_STAGE(PG8_SA(0, 1), cA + hstep, voffA);
    if (wr == 1) PG8_BAR;
    PG8_WAIT_V(4); PG8_BAR;
    PG8_STAGE(PG8_SB(1, 0), cB + kstep, voffB); PG8_STAGE(PG8_SA(1, 0), cA + kstep, voffA); PG8_STAGE(PG8_SB(1, 1), cB + hstep + kstep, voffB);
    PG8_WAIT_V(6); PG8_BAR;
    for (;;) {
        const bool has_next = S.next(ui + 1, nxt);
        const char* nA = has_next ? (const char*)g.A + (size_t)nxt.pm * tstep + (size_t)nxt.k0 * 2 : cA; const char* nB = has_next ? (const char*)g.Bt + (size_t)nxt.pn * tstep + (size_t)nxt.k0 * 2 : cB;
        const int nt = cur.nt;
        for (int t = 0; t < nt; t += 2) {
            const bool last = (t == nt - 2);
            const char* a1 = cA + (size_t)(t + 1) * kstep;
            const char* a2 = last ? nA : cA + (size_t)(t + 2) * kstep; const char* b2 = last ? nB : cB + (size_t)(t + 2) * kstep;
            const char* a3 = a2 + kstep; const char* b3 = b2 + kstep;
            PG8_LDB(B0, 0, 0); PG8_SCHED; PG8_LDA(At, 0, 0); PG8_STAGE(PG8_SA(1, 1), a1 + hstep, voffA);
            PG8_WAIT_L(8); PG8_BAR; PG8_WAIT_L(0); PG8_MMA(0, 0, At, B0); PG8_BAR; PG8_SCHED;
            PG8_LDB(B1, 0, 1); PG8_STAGE(PG8_SB(0, 0), b2, voffB);
            PG8_BAR; PG8_WAIT_L(0); PG8_MMA(0, 1, At, B1); PG8_BAR;
            PG8_LDA(At, 0, 1); PG8_STAGE(PG8_SA(0, 0), a2, voffA);
            PG8_BAR; PG8_WAIT_L(0); PG8_MMA(1, 0, At, B0); PG8_BAR; PG8_SCHED;
            PG8_STAGE(PG8_SB(0, 1), b2 + hstep, voffB);
            PG8_WAIT_V(6); PG8_BAR; PG8_MMA(1, 1, At, B1); PG8_BAR;
            PG8_LDB(B0, 1, 0); PG8_SCHED; PG8_LDA(At, 1, 0); PG8_STAGE(PG8_SA(0, 1), a2 + hstep, voffA);
            PG8_WAIT_L(8); PG8_BAR; PG8_WAIT_L(0); PG8_MMA(0, 0, At, B0); PG8_BAR; PG8_SCHED;
            PG8_LDB(B1, 1, 1); PG8_STAGE(PG8_SB(1, 0), b3, voffB);
            PG8_BAR; PG8_WAIT_L(0); PG8_MMA(0, 1, At, B1); PG8_BAR;
            PG8_LDA(At, 1, 1); PG8_STAGE(PG8_SA(1, 0), a3, voffA);
            PG8_BAR; PG8_WAIT_L(0); PG8_MMA(1, 0, At, B0); PG8_BAR; PG8_SCHED;
            PG8_STAGE(PG8_SB(1, 1), b3 + hstep, voffB);
            PG8_WAIT_V(6); PG8_BAR; PG8_MMA(1, 1, At, B1); PG8_BAR;
        }
        E(acc, cur, wr, wc, fr, fq);
        if (!has_next) break;
#pragma unroll
        for (int a = 0; a < 2; ++a)
#pragma unroll
            for (int b = 0; b < 2; ++b)
#pragma unroll
                for (int m = 0; m < 4; ++m)
#pragma unroll
                    for (int n = 0; n < 2; ++n) acc[a][b][m][n] = (f32x4){0.f, 0.f, 0.f, 0.f};
        cur = nxt; cA = nA; cB = nB; ++ui;
    }
    PG8_WAIT_V(0);
    if (wr == 0) PG8_BAR;
    PG8_BAR;
#undef PG8_SA
#undef PG8_SB
#undef PG8_STAGE
#undef PG8_LDA
#undef PG8_LDB
#undef PG8_MMA
#undef PG8_WAIT_V
#undef PG8_WAIT_L
#undef PG8_BAR
#undef PG8_SCHED
}
}

template <class F>
__device__ __forceinline__ void epi_walk(const f32x4 (&acc)[2][2][4][2], const pg8::Unit& u, int wr, int wc, int fr, int fq, const F& f) {
    const int row0 = u.pm * 256 + wr * 64 + fr;
#pragma unroll
    for (int ai = 0; ai < 2; ++ai)
#pragma unroll
        for (int m = 0; m < 4; ++m) {
            const int r = row0 + ai * 128 + m * 16;
#pragma unroll
            for (int bj = 0; bj < 2; ++bj)
#pragma unroll
                for (int n = 0; n < 2; ++n) f(r, bj * 128 + wc * 32 + n * 16 + 4 * fq, acc[ai][bj][m][n]);
        }
}

struct EpiIn {
    float* cqkv; bf16_t* qh; float* g; bf16_t* vh; bf16_t* gate; bf16_t* kpe; const f32x2* rope; float* okp; float* oks; const float* hglb;
    __device__ __forceinline__ void operator()(const f32x4 (&acc)[2][2][4][2], const pg8::Unit& u, int wr, int wc, int fr, int fq) const {
        const int pn = u.pn;
        epi_walk(acc, u, wr, wc, fr, fq, [&](int r, int cl, f32x4 v) {
            const int c = pn * 256 + cl;
            if (pn < 4) { *(f32x4*)(cqkv + (size_t)r * 1024 + c) = v; }
            else if (pn < 8) {
                const float sc = 0.08838834764831845f;
                u32x2 w; w.x = pk2(silu_f(v[0]) * sc, silu_f(v[1]) * sc); w.y = pk2(silu_f(v[2]) * sc, silu_f(v[3]) * sc);
                *(u32x2*)(qh + (size_t)r * 1024 + (c - 1024)) = w;
            } else if (pn < 12) {
                const int j = c - 2048;
                const f32x4 a0 = *(const f32x4*)(hglb + j), a1 = *(const f32x4*)(hglb + 1024 + j);
                f32x4 o;
#pragma unroll
                for (int e = 0; e < 4; ++e) { const float lb = __builtin_amdgcn_rcpf(1.0f + __expf(a1[e] - a0[e])); const float sg = __builtin_amdgcn_rcpf(1.0f + __expf(-v[e])); o[e] = __logf(lb + (1.0f - lb) * sg); }
                *(f32x4*)(g + (size_t)r * 1024 + j) = o;
            } else if (pn < 16) {
                u32x2 w; w.x = pk2(v[0], v[1]); w.y = pk2(v[2], v[3]);
                *(u32x2*)(vh + (size_t)r * 1024 + (c - 3072)) = w;
            } else if (pn < 20) {
                u32x2 w; w.x = pk2(silu_f(v[0]), silu_f(v[1])); w.y = pk2(silu_f(v[2]), silu_f(v[3]));
                *(u32x2*)(gate + (size_t)r * 1024 + (c - 4096)) = w;
            } else if (cl < 64) {
                const int i0 = cl >> 1, pos = row_pos(r);
                const f32x2 c0 = rope[pos * 32 + i0], c1 = rope[pos * 32 + i0 + 1];
                const float o1a = v[0] * c0.x - v[1] * c0.y, o2a = v[1] * c0.x + v[0] * c0.y;
                const float o1b = v[2] * c1.x - v[3] * c1.y, o2b = v[3] * c1.x + v[2] * c1.y;
                float* ob = r < MP ? okp + (size_t)r * 64 : oks + (size_t)(r - MP) * 64;
                *(f32x2*)(ob + i0) = (f32x2){o1a, o1b}; *(f32x2*)(ob + 32 + i0) = (f32x2){o2a, o2b};
                u32x2 w; w.x = pk2(o1a, o2a); w.y = pk2(o1b, o2b);
                *(u32x2*)(kpe + (size_t)r * 64 + cl) = w;
            }
        });
    }
};
struct EpiQ {
    bf16_t* q; const f32x2* rope;
    __device__ __forceinline__ void operator()(const f32x4 (&acc)[2][2][4][2], const pg8::Unit& u, int wr, int wc, int fr, int fq) const {
        const int pn = u.pn;
        epi_walk(acc, u, wr, wc, fr, fq, [&](int r, int cl, f32x4 v) {
            const int c = pn * 256 + cl, h = c / 192, j = c - h * 192;
            u32x2 w;
            if (j < 128) { w.x = pk2(v[0] * QSCALE, v[1] * QSCALE); w.y = pk2(v[2] * QSCALE, v[3] * QSCALE); }
            else {
                const int i0 = (j - 128) >> 1, pos = row_pos(r);
                const f32x2 c0 = rope[pos * 32 + i0], c1 = rope[pos * 32 + i0 + 1];
                const float o1a = v[0] * c0.x - v[1] * c0.y, o2a = v[1] * c0.x + v[0] * c0.y;
                const float o1b = v[2] * c1.x - v[3] * c1.y, o2b = v[3] * c1.x + v[2] * c1.y;
                w.x = pk2(o1a * QSCALE, o2a * QSCALE); w.y = pk2(o1b * QSCALE, o2b * QSCALE);
            }
            *(u32x2*)(q + (size_t)r * 1536 + c) = w;
        });
    }
};
struct EpiPlain {
    bf16_t* o; int ldc;
    __device__ __forceinline__ void operator()(const f32x4 (&acc)[2][2][4][2], const pg8::Unit& u, int wr, int wc, int fr, int fq) const {
        const int pn = u.pn;
        epi_walk(acc, u, wr, wc, fr, fq, [&](int r, int cl, f32x4 v) {
            u32x2 w; w.x = pk2(v[0], v[1]); w.y = pk2(v[2], v[3]);
            *(u32x2*)(o + (size_t)r * ldc + pn * 256 + cl) = w;
        });
    }
};
struct EpiRelu2 {
    bf16_t* o;
    __device__ __forceinline__ void operator()(const f32x4 (&acc)[2][2][4][2], const pg8::Unit& u, int wr, int wc, int fr, int fq) const {
        const int pn = u.pn;
        epi_walk(acc, u, wr, wc, fr, fq, [&](int r, int cl, f32x4 v) {
            f32x4 t;
#pragma unroll
            for (int e = 0; e < 4; ++e) { const float a = fmaxf(v[e], 0.f); t[e] = a * a; }
            u32x2 w; w.x = pk2(t[0], t[1]); w.y = pk2(t[2], t[3]);
            *(u32x2*)(o + (size_t)r * DFF + pn * 256 + cl) = w;
        });
    }
};
struct EpiRes {
    const float* xa; const float* xb; float* xo; const float* mod; const float* bada; int goff; float* part;
    __device__ __forceinline__ void operator()(const f32x4 (&acc)[2][2][4][2], const pg8::Unit& u, int wr, int wc, int fr, int fq) const {
        const int pn = u.pn, sl = u.sl, sidx = u.k0 / (u.nt * 64);
        epi_walk(acc, u, wr, wc, fr, fq, [&](int r, int cl, f32x4 v) {
            const int c = pn * 256 + cl;
            if (sl) { *(f32x4*)(part + ((size_t)sidx * MS + (r - MP)) * DM + c) = v; }
            else {
                const int ci = row_ci(r);
                const float* xi = r < MP ? xa + (size_t)r * DM : xb + (size_t)(r - MP) * DM;
                const f32x4 gt = *(const f32x4*)(mod + (size_t)ci * NMOD + goff + c) + *(const f32x4*)(bada + goff + c);
                const f32x4 x = *(const f32x4*)(xi + c);
                *(f32x4*)(xo + (size_t)r * DM + c) = x + gt * v;
            }
        });
    }
};

__device__ __forceinline__ int map_row(int mat, int n) {
    if (mat == 0) { if (n < 1024) return n; if (n < 1088) { const int i = n - 1024; return 5120 + (i < 32 ? 2 * i : 2 * (i - 32) + 1); } return n - 64; }
    if (mat == 1) { const int h = n / 192, j = n - h * 192; if (j < 128) return n; const int i = j - 128; return h * 192 + 128 + (i < 32 ? 2 * i : 2 * (i - 32) + 1); }
    return n;
}
struct TrItem { const float* W; bf16_t* WT; int K, N, mat, item; };
__device__ __forceinline__ void tr_load(const TrItem& t, int lane, float (&tv)[32]) {
    const int nblk = t.N / 32, kb = t.item / nblk, nb = t.item % nblk, k0 = 64 * kb, n0 = 32 * nb;
#pragma unroll
    for (int i = 0; i < 32; ++i) { const int kk = 2 * i + (lane >> 5); tv[i] = t.W[(size_t)(k0 + kk) * t.N + n0 + (lane & 31)]; }
}
__device__ __forceinline__ void tr_store(const TrItem& t, int lane, const float (&tv)[32], LAS float* scr) {
    const int nblk = t.N / 32, kb = t.item / nblk, nb = t.item % nblk, k0 = 64 * kb, n0 = 32 * nb;
#pragma unroll
    for (int i = 0; i < 32; ++i) { const int kk = 2 * i + (lane >> 5); scr[kk * 33 + (lane & 31)] = tv[i]; }
    asm volatile("s_waitcnt lgkmcnt(0)" ::: "memory");
    const int c = lane & 7;
#pragma unroll
    for (int j = 0; j < 4; ++j) { const int n = (lane >> 3) + 8 * j; const LAS float* sp = scr + (8 * c) * 33 + n;
        u32x4 o; o.x = pk2(sp[0 * 33], sp[1 * 33]); o.y = pk2(sp[2 * 33], sp[3 * 33]); o.z = pk2(sp[4 * 33], sp[5 * 33]); o.w = pk2(sp[6 * 33], sp[7 * 33]);
        *(u32x4*)(t.WT + (size_t)map_row(t.mat, n0 + n) * t.K + k0 + 8 * c) = o; }
    asm volatile("s_waitcnt lgkmcnt(0)" ::: "memory");
}
__device__ __forceinline__ TrItem tr_item(const float* const* in, unsigned char* ws, int it) {
    constexpr int I0 = 32 * 162, I1 = 8 * 48, I2 = 8 * 32, I3 = 8 * 32, I4 = 32 * 64, I5 = 32 * 256;
    int r = it;
    if (r < I0) return TrItem{in[9], (bf16_t*)(ws + WS_WIN), 2048, 5184, 0, r}; r -= I0;
    if (r < I1) return TrItem{in[10], (bf16_t*)(ws + WS_WUQ), 512, 1536, 1, r}; r -= I1;
    if (r < I2) return TrItem{in[13], (bf16_t*)(ws + WS_WUK), 512, 1024, 2, r}; r -= I2;
    if (r < I3) return TrItem{in[14], (bf16_t*)(ws + WS_WUV), 512, 1024, 2, r}; r -= I3;
    if (r < I4) return TrItem{in[17], (bf16_t*)(ws + WS_WOUT), 2048, 2048, 2, r}; r -= I4;
    if (r < I5) return TrItem{in[18], (bf16_t*)(ws + WS_WFF1), 2048, 8192, 2, r}; r -= I5;
    return TrItem{in[19], (bf16_t*)(ws + WS_WFF2), 8192, 2048, 2, r};
}
__device__ __forceinline__ void phase0(const float* const* in, unsigned char* ws, unsigned char* lds) {
    const int tid = ltid(), lane = tid & 63, wave = tid >> 6, G = gridDim.x, bx = blockIdx.x;
    {
        float* sl = (float*)lds;
        float* MOD = (float*)(ws + WS_MOD);
        const float* wada = in[7];
        if (bx == 0 && tid < 2) __hip_atomic_store((unsigned*)(ws + WS_CTL) + tid * 64, 0u, __ATOMIC_RELAXED, __HIP_MEMORY_SCOPE_AGENT);
        for (int it = bx; it < 192; it += G) {
            const int grp = tid >> 6, col = it * 64 + lane;
            float acc[34];
#pragma unroll
            for (int r = 0; r < 34; ++r) acc[r] = 0.f;
            for (int pass = 0; pass < 4; ++pass) {
                __syncthreads();
                for (int e = tid; e < 34 * 512; e += 512) { const int r = e >> 9, kl = e & 511, kg = (kl >> 6) * 256 + pass * 64 + (kl & 63);
                    const float cv = r < 2 ? in[2][r * DM + kg] : in[3][(r - 2) * DM + kg]; sl[e] = silu_f(cv); }
                __syncthreads();
                const int k0 = grp * 256 + pass * 64;
                for (int kk = 0; kk < 64; kk += 8) {
                    float w[8];
#pragma unroll
                    for (int j = 0; j < 8; ++j) w[j] = wada[(size_t)(k0 + kk + j) * NMOD + col];
#pragma unroll
                    for (int r = 0; r < 34; ++r) { const f32x4 sv = *(const f32x4*)(sl + r * 512 + grp * 64 + kk), sw = *(const f32x4*)(sl + r * 512 + grp * 64 + kk + 4);
                        acc[r] += (sv[0] * w[0] + sv[1] * w[1] + sv[2] * w[2] + sv[3] * w[3]) + (sw[0] * w[4] + sw[1] * w[5] + sw[2] * w[6] + sw[3] * w[7]); }
                }
            }
            __syncthreads();
            float* red = (float*)lds;
#pragma unroll
            for (int r = 0; r < 34; ++r) red[(grp * 34 + r) * 64 + lane] = acc[r];
            __syncthreads();
            for (int e = tid; e < 34 * 64; e += 512) { const int r = e >> 6, c = e & 63; float sum = 0.f;
#pragma unroll
                for (int g2 = 0; g2 < 8; ++g2) sum += red[(g2 * 34 + r) * 64 + c];
                MOD[(size_t)r * NMOD + it * 64 + c] = sum; }
            __syncthreads();
        }
    }
    {
        LAS float* scr = (LAS float*)lds + wave * (64 * 33);
        const int gw = bx * 8 + wave, NGW = G * 8;
        constexpr int NIT = 32 * 162 + 8 * 48 + 8 * 32 + 8 * 32 + 32 * 64 + 32 * 256 + 128 * 64;
        float ta[32], tb[32];
        int it = gw;
        if (it < NIT) tr_load(tr_item(in, ws, it), lane, ta);
        for (; it < NIT; it += 2 * NGW) {
            if (it + NGW < NIT) tr_load(tr_item(in, ws, it + NGW), lane, tb);
            tr_store(tr_item(in, ws, it), lane, ta, scr);
            if (it + NGW < NIT) {
                if (it + 2 * NGW < NIT) tr_load(tr_item(in, ws, it + 2 * NGW), lane, ta);
                tr_store(tr_item(in, ws, it + NGW), lane, tb, scr);
            }
        }
    }
    const int gt = bx * 512 + tid, NGT = G * 512;
    { u32x4* z = (u32x4*)(ws + WS_WIN + (size_t)5184 * 2048 * 2); for (int i = gt; i < 192 * 2048 * 2 / 16; i += NGT) z[i] = (u32x4){0u, 0u, 0u, 0u}; }
    { const f32x4* s = (const f32x4*)in[13]; u32x2* d = (u32x2*)(ws + WS_WUKO); for (int i = gt; i < 512 * 1024 / 4; i += NGT) { const f32x4 v = s[i]; u32x2 w; w.x = pk2(v[0], v[1]); w.y = pk2(v[2], v[3]); d[i] = w; } }
    { f32x2* rp = (f32x2*)(ws + WS_ROPE);
      for (int i = gt; i < 8192 * 32; i += NGT) { const int pos = i >> 5, k = i & 31;
          const double invf = exp(-9.210340371976184 * (double)k / 32.0); const double t = (double)pos * invf * 0.15915494309189535; const float fr = (float)(t - rint(t));
          rp[i] = (f32x2){__builtin_amdgcn_cosf(fr), __builtin_amdgcn_sinf(fr)}; } }
}

template <int NSL>
__device__ __forceinline__ void adaln_rows(const float* xa, const float* xb, const float* mod, const float* bada, int off_sh, int off_sc, bf16_t* H,
                                           const float* part = nullptr, int off_gt = 0, float* xout = nullptr) {
    const int tid_ = ltid(), lane = tid_ & 63, gw = blockIdx.x * 8 + (tid_ >> 6), NGW = gridDim.x * 8;
    {
        f32x4 v[8], nx[8];
#pragma unroll
        for (int j = 0; j < 8; ++j) v[j] = *(const f32x4*)(xa + (size_t)gw * DM + 4 * lane + 256 * j);
        for (int row = gw; row < MP; row += NGW) {
            const int nrow = row + NGW;
            if (nrow < MP) {
#pragma unroll
                for (int j = 0; j < 8; ++j) nx[j] = *(const f32x4*)(xa + (size_t)nrow * DM + 4 * lane + 256 * j); }
            const int ci = row >> 13;
            float ss = 0.f;
#pragma unroll
            for (int j = 0; j < 8; ++j) ss += (v[j][0] * v[j][0] + v[j][1] * v[j][1]) + (v[j][2] * v[j][2] + v[j][3] * v[j][3]);
            const float* mr = mod + (size_t)ci * NMOD;
            const float rstd = 1.0f / sqrtf(wave_sum(ss) * (1.0f / DM) + EPSN);
#pragma unroll
            for (int j = 0; j < 8; ++j) { const int c = 4 * lane + 256 * j;
                const f32x4 scj = *(const f32x4*)(mr + off_sc + c) + *(const f32x4*)(bada + off_sc + c) + 1.0f;
                const f32x4 shj = *(const f32x4*)(mr + off_sh + c) + *(const f32x4*)(bada + off_sh + c);
                const f32x4 h = v[j] * rstd * scj + shj;
                u32x2 w; w.x = pk2(h[0], h[1]); w.y = pk2(h[2], h[3]);
                *(u32x2*)(H + (size_t)row * DM + c) = w; v[j] = nx[j]; }
        }
    }
    __builtin_amdgcn_sched_barrier(0);
    if (gw < MS) {
        const int row = MP + gw; const float* xr = xb + (size_t)gw * DM; const float* mr = mod + (size_t)row_ci(row) * NMOD;
        f32x4 v[8]; float ss = 0.f;
#pragma unroll
        for (int j = 0; j < 8; ++j) { const int c = 4 * lane + 256 * j; v[j] = *(const f32x4*)(xr + c);
            if (NSL > 0) { f32x4 a = (f32x4){0.f, 0.f, 0.f, 0.f};
#pragma unroll
                for (int s2 = 0; s2 < NSL; ++s2) a += *(const f32x4*)(part + ((size_t)s2 * MS + gw) * DM + c);
                const f32x4 gt = *(const f32x4*)(mr + off_gt + c) + *(const f32x4*)(bada + off_gt + c);
                v[j] += gt * a; *(f32x4*)(xout + (size_t)row * DM + c) = v[j]; }
            ss += (v[j][0] * v[j][0] + v[j][1] * v[j][1]) + (v[j][2] * v[j][2] + v[j][3] * v[j][3]); }
        const float rstd = 1.0f / sqrtf(wave_sum(ss) * (1.0f / DM) + EPSN);
#pragma unroll
        for (int j = 0; j < 8; ++j) { const int c = 4 * lane + 256 * j;
            const f32x4 sc = *(const f32x4*)(mr + off_sc + c) + *(const f32x4*)(bada + off_sc + c) + 1.0f;
            const f32x4 sh = *(const f32x4*)(mr + off_sh + c) + *(const f32x4*)(bada + off_sh + c);
            const f32x4 h = v[j] * rstd * sc + sh;
            u32x2 w; w.x = pk2(h[0], h[1]); w.y = pk2(h[2], h[3]);
            *(u32x2*)(H + (size_t)row * DM + c) = w; }
    }
}
template <int NSL>
__device__ __forceinline__ void final_rows(float* X, const float* gf, const float* part, const float* mod, const float* bada) {
    const int tid_ = ltid(), lane = tid_ & 63, gw = blockIdx.x * 8 + (tid_ >> 6), NGW = gridDim.x * 8;
    f32x4 v[8], nx[8], gn[8];
#pragma unroll
    for (int j = 0; j < 8; ++j) { gn[j] = *(const f32x4*)(gf + 4 * lane + 256 * j); v[j] = *(const f32x4*)(X + (size_t)gw * DM + 4 * lane + 256 * j); }
    for (int row = gw; row < MT; row += NGW) {
        const int nrow = row + NGW;
        if (nrow < MT) {
#pragma unroll
            for (int j = 0; j < 8; ++j) nx[j] = *(const f32x4*)(X + (size_t)nrow * DM + 4 * lane + 256 * j); }
        if (NSL > 0 && row >= MP) {
#pragma unroll
            for (int j = 0; j < 8; ++j) { const int c = 4 * lane + 256 * j; f32x4 a = (f32x4){0.f, 0.f, 0.f, 0.f};
#pragma unroll
                for (int s2 = 0; s2 < NSL; ++s2) a += *(const f32x4*)(part + ((size_t)s2 * MS + (row - MP)) * DM + c);
                const f32x4 gt = *(const f32x4*)(mod + (size_t)row_ci(row) * NMOD + 10240 + c) + *(const f32x4*)(bada + 10240 + c);
                v[j] += gt * a; }
        }
        float ss = 0.f;
#pragma unroll
        for (int j = 0; j < 8; ++j) ss += (v[j][0] * v[j][0] + v[j][1] * v[j][1]) + (v[j][2] * v[j][2] + v[j][3] * v[j][3]);
        const float rstd = 1.0f / sqrtf(wave_sum(ss) * (1.0f / DM) + EPSN);
#pragma unroll
        for (int j = 0; j < 8; ++j) { *(f32x4*)(X + (size_t)row * DM + 4 * lane + 256 * j) = v[j] * rstd * gn[j]; v[j] = nx[j]; }
    }
}
__device__ __forceinline__ void latent_rows(const float* cqkv, const float* gq, const float* gkv, bf16_t* cqn, bf16_t* ckv, float* ockp, float* ocks) {
    const int tid_ = ltid(), lane = tid_ & 63, gw = blockIdx.x * 8 + (tid_ >> 6), NGW = gridDim.x * 8;
    for (int row = gw; row < MT; row += NGW) {
        const float* sr = cqkv + (size_t)row * 1024;
        f32x4 a[2], b[2]; float sa = 0.f, sb = 0.f;
#pragma unroll
        for (int j = 0; j < 2; ++j) { a[j] = *(const f32x4*)(sr + 4 * lane + 256 * j); b[j] = *(const f32x4*)(sr + 512 + 4 * lane + 256 * j);
            sa += (a[j][0] * a[j][0] + a[j][1] * a[j][1]) + (a[j][2] * a[j][2] + a[j][3] * a[j][3]); sb += (b[j][0] * b[j][0] + b[j][1] * b[j][1]) + (b[j][2] * b[j][2] + b[j][3] * b[j][3]); }
        const float ra = 1.0f / sqrtf(wave_sum(sa) * (1.0f / 512) + EPSN), rb = 1.0f / sqrtf(wave_sum(sb) * (1.0f / 512) + EPSN);
        float* oc = row < MP ? ockp + (size_t)row * 512 : ocks + (size_t)(row - MP) * 512;
#pragma unroll
        for (int j = 0; j < 2; ++j) { const int c = 4 * lane + 256 * j;
            const f32x4 qa = a[j] * ra * *(const f32x4*)(gq + c), kb = b[j] * rb * *(const f32x4*)(gkv + c);
            u32x2 w; w.x = pk2(qa[0], qa[1]); w.y = pk2(qa[2], qa[3]); *(u32x2*)(cqn + (size_t)row * 512 + c) = w;
            *(f32x4*)(oc + c) = kb;
            w.x = pk2(kb[0], kb[1]); w.y = pk2(kb[2], kb[3]); *(u32x2*)(ckv + (size_t)row * 512 + c) = w; }
    }
}

template <int L>
__device__ __forceinline__ void hgrn_cumsum(const float* G, int row0, int h, int lreal, float* tot, float (&gv)[L / 4], float (&bv)[L / 4], float& blast) {
    constexpr int SEG = L / 4;
    const int tid = ltid(), k = tid & 127, seg = tid >> 7;
    float run = 0.f;
#pragma unroll
    for (int i = 0; i < SEG; ++i) { const int t = seg * SEG + i; gv[i] = t < lreal ? G[(size_t)(row0 + t) * 1024 + h * 128 + k] : 0.f; }
#pragma unroll
    for (int i = 0; i < SEG; ++i) { run += gv[i]; bv[i] = run; }
    tot[seg * 128 + k] = run;
    __syncthreads();
    const float t0 = tot[k], t1 = tot[128 + k], t2 = tot[256 + k], t3 = tot[384 + k];
    const float off = (seg > 0 ? t0 : 0.f) + (seg > 1 ? t1 : 0.f) + (seg > 2 ? t2 : 0.f);
#pragma unroll
    for (int i = 0; i < SEG; ++i) bv[i] += off;
    blast = ((t0 + t1) + t2) + t3;
}
template <int L>
__device__ __forceinline__ void hgrn_a(int it, int bh, int row0, int lreal, const float* G, const bf16_t* VH, bf16_t* U, float* DD, unsigned char* lds) {
    constexpr int SEG = L / 4, ST = L + 8;
    const int tid = ltid(), lane = tid & 63, wave = tid >> 6, k = tid & 127, seg = tid >> 7, h = bh & 7;
    float* Bs = (float*)lds; float* tot = (float*)(lds + 32768);
    bf16_t* KDT = (bf16_t*)(lds + 34816); bf16_t* VT = (bf16_t*)(lds + 34816 + 128 * ST * 2);
    float gv[SEG]; bf16_t vraw[SEG];
#pragma unroll
    for (int i = 0; i < SEG; ++i) { const int s = seg * SEG + i; vraw[i] = s < lreal ? VH[(size_t)(row0 + s) * 1024 + h * 128 + k] : (bf16_t)0; }
    float bv[SEG], blast;
    hgrn_cumsum<L>(G, row0, h, lreal, tot, gv, bv, blast);
#pragma unroll
    for (int i = 0; i < SEG; ++i) { const int s = seg * SEG + i;
        const float kd = (1.0f - __expf(gv[i])) * __expf(blast - bv[i]);
        KDT[k * ST + s] = (bf16_t)(pk2(kd, 0.f) & 0xffffu);
        VT[k * ST + s] = vraw[i]; }
    if (seg == 0) DD[(size_t)it * 128 + k] = __expf(blast);
    __syncthreads();
    const int r = lane & 15, g = lane >> 4;
#pragma unroll
    for (int vt = 0; vt < 8; ++vt) {
        f32x4 acc = (f32x4){0.f, 0.f, 0.f, 0.f};
#pragma unroll
        for (int ks = 0; ks < L / 32; ++ks) {
            const bf16x8 a = *(const bf16x8*)(KDT + (16 * wave + r) * ST + 32 * ks + 8 * g);
            const bf16x8 b = *(const bf16x8*)(VT + (16 * vt + r) * ST + 32 * ks + 8 * g);
            acc = __builtin_amdgcn_mfma_f32_16x16x32_bf16(a, b, acc, 0, 0, 0);
        }
        bf16_t* up = U + (size_t)it * 16384 + (16 * wave + 4 * g) * 128 + 16 * vt + r;
        const unsigned p01 = pk2(acc[0], acc[1]), p23 = pk2(acc[2], acc[3]);
        up[0] = (bf16_t)(p01 & 0xffffu); up[128] = (bf16_t)(p01 >> 16); up[256] = (bf16_t)(p23 & 0xffffu); up[384] = (bf16_t)(p23 >> 16);
    }
    __syncthreads();
}
__device__ __forceinline__ void hgrn_b(const bf16_t* U, const float* DD, bf16_t* Sn, const float* st0, float* ostp, float* osts) {
    const int gt = blockIdx.x * 512 + ltid(), NGT = gridDim.x * 512;
#ifdef HB_TEST
    for (int e = gt; e < 16 * 16384; e += NGT) { const int bh = e >> 14, kv = e & 16383; ostp[e] = bf2f(U[((size_t)bh * 128 + 127) * 16384 + kv]); }
    for (int e = gt; e < 256 * 16384; e += NGT) { const int bh = e >> 14, kv = e & 16383; osts[e] = bf2f(U[((size_t)2048 + bh) * 16384 + kv]) + DD[((size_t)2048 + bh) * 128 + (kv >> 7)]; }
    return;
#endif
    for (int e = gt; e < 16 * 16384; e += NGT) {
        const int bh = e >> 14, kv = e & 16383, k = kv >> 7;
        float S = 0.f;
        const bf16_t* up = U + (size_t)bh * 128 * 16384 + kv; const float* dp = DD + (size_t)bh * 128 * 128 + k; bf16_t* sp = Sn + (size_t)bh * 128 * 16384 + kv;
        for (int n0 = 0; n0 < 128; n0 += 16) {
            bf16_t ur[16]; float dr[16];
#pragma unroll
            for (int j = 0; j < 16; ++j) { ur[j] = up[(size_t)(n0 + j) * 16384]; dr[j] = dp[(n0 + j) * 128]; }
#pragma unroll
            for (int j = 0; j < 16; ++j) { sp[(size_t)(n0 + j) * 16384] = (bf16_t)(pk2(S, 0.f) & 0xffffu); S = dr[j] * S + bf2f(ur[j]); }
        }
        ostp[e] = S;
    }
    for (int e = gt; e < 256 * 16384; e += NGT) {
        const int bh = e >> 14, kv = e & 16383, k = kv >> 7; const size_t it = 2048 + bh;
        const float S0 = st0[e];
        Sn[it * 16384 + kv] = (bf16_t)(pk2(S0, 0.f) & 0xffffu);
        osts[e] = DD[it * 128 + k] * S0 + bf2f(U[it * 16384 + kv]);
    }
}
template <int L>
__device__ __forceinline__ void hgrn_c(int it, int bh, int row0, int lreal, const float* G, const bf16_t* QH, const bf16_t* VH, const bf16_t* GATE, const bf16_t* Sn, const float* ghg, bf16_t* MIX, unsigned char* lds) {
    constexpr int SEG = L / 4, VS = L + 8;
    const int tid = ltid(), lane = tid & 63, wave = tid >> 6, k = tid & 127, seg = tid >> 7, h = bh & 7;
    float* Bs = (float*)lds; float* tot = (float*)(lds + 32768);
    bf16_t* QT = (bf16_t*)(lds + 34816); bf16_t* KT = (bf16_t*)(lds + 52224); bf16_t* VT = (bf16_t*)(lds + 69632); bf16_t* ST = (bf16_t*)(lds + 88064);
    float gv[SEG];
    bf16_t qraw[SEG], vraw[SEG]; u32x4 sraw[4];
#pragma unroll
    for (int i = 0; i < SEG; ++i) { const int s = seg * SEG + i;
        qraw[i] = s < lreal ? QH[(size_t)(row0 + s) * 1024 + h * 128 + k] : (bf16_t)0;
        vraw[i] = s < lreal ? VH[(size_t)(row0 + s) * 1024 + h * 128 + k] : (bf16_t)0; }
#pragma unroll
    for (int i = 0; i < 4; ++i) sraw[i] = *(const u32x4*)(Sn + (size_t)it * 16384 + (size_t)k * 128 + (seg + 4 * i) * 8);
    float bv[SEG], blast;
    hgrn_cumsum<L>(G, row0, h, lreal, tot, gv, bv, blast);
#pragma unroll
    for (int i = 0; i < SEG; ++i) { const int s = seg * SEG + i; const float bs = bv[i];
        QT[s * 136 + k] = (bf16_t)(pk2(bf2f(qraw[i]) * __expf(bs), 0.f) & 0xffffu);
        KT[s * 136 + k] = (bf16_t)(pk2((1.0f - __expf(gv[i])) * __expf(-bs), 0.f) & 0xffffu);
        VT[k * VS + s] = vraw[i]; }
#pragma unroll
    for (int i = 0; i < 4; ++i) { const int kk = k, v0 = (seg + 4 * i) * 8;
        const unsigned w4[4] = {sraw[i].x, sraw[i].y, sraw[i].z, sraw[i].w};
#pragma unroll
        for (int e = 0; e < 4; ++e) { ST[(v0 + 2 * e) * 136 + kk] = (bf16_t)(w4[e] & 0xffffu); ST[(v0 + 2 * e + 1) * 136 + kk] = (bf16_t)(w4[e] >> 16); } }
    __syncthreads();
    const int tt = wave;
    if (tt * 16 < lreal) {
        const int r = lane & 15, g = lane >> 4;
        bf16x8 qf[4];
#pragma unroll
        for (int ks = 0; ks < 4; ++ks) qf[ks] = *(const bf16x8*)(QT + (16 * tt + r) * 136 + 32 * ks + 8 * g);
        bf16x8 pf[L / 32];
#pragma unroll
        for (int p = 0; p < L / 32; ++p) {
            unsigned pw[4];
#pragma unroll
            for (int hs = 0; hs < 2; ++hs) { const int st = 2 * p + hs;
                f32x4 acc = (f32x4){0.f, 0.f, 0.f, 0.f};
                if (st <= tt) {
#pragma unroll
                    for (int ks = 0; ks < 4; ++ks) { const bf16x8 a = *(const bf16x8*)(KT + (16 * st + r) * 136 + 32 * ks + 8 * g); acc = __builtin_amdgcn_mfma_f32_16x16x32_bf16(a, qf[ks], acc, 0, 0, 0); }
#pragma unroll
                    for (int e = 0; e < 4; ++e) if (16 * st + 4 * g + e > 16 * tt + r) acc[e] = 0.f;
                }
                pw[2 * hs] = pk2(acc[0], acc[1]); pw[2 * hs + 1] = pk2(acc[2], acc[3]); }
            u32x4 t4 = (u32x4){pw[0], pw[1], pw[2], pw[3]};
            pf[p] = __builtin_bit_cast(bf16x8, t4);
        }
        f32x4 o[8]; float ss = 0.f;
#pragma unroll
        for (int vt = 0; vt < 8; ++vt) {
            f32x4 acc = (f32x4){0.f, 0.f, 0.f, 0.f};
#pragma unroll
            for (int p = 0; p < L / 32; ++p) if (2 * p <= tt) {
                const u32x2 lo = *(const u32x2*)(VT + (16 * vt + r) * VS + 32 * p + 4 * g), hi = *(const u32x2*)(VT + (16 * vt + r) * VS + 32 * p + 16 + 4 * g);
                u32x4 t4 = (u32x4){lo.x, lo.y, hi.x, hi.y};
                acc = __builtin_amdgcn_mfma_f32_16x16x32_bf16(__builtin_bit_cast(bf16x8, t4), pf[p], acc, 0, 0, 0); }
#pragma unroll
            for (int ks = 0; ks < 4; ++ks) { const bf16x8 a = *(const bf16x8*)(ST + (16 * vt + r) * 136 + 32 * ks + 8 * g); acc = __builtin_amdgcn_mfma_f32_16x16x32_bf16(a, qf[ks], acc, 0, 0, 0); }
            o[vt] = acc; ss += (acc[0] * acc[0] + acc[1] * acc[1]) + (acc[2] * acc[2] + acc[3] * acc[3]);
        }
        ss += __shfl_xor(ss, 16); ss += __shfl_xor(ss, 32);
        const float rstd = 1.0f / sqrtf(ss * (1.0f / 128) + EPSN);
        const int t = 16 * tt + r;
        if (t < lreal) {
            const size_t row = (size_t)(row0 + t);
#pragma unroll
            for (int vt = 0; vt < 8; ++vt) { const int v0 = 16 * vt + 4 * g;
                const u32x2 gw2 = *(const u32x2*)(GATE + row * 1024 + h * 128 + v0); const f32x4 gh = *(const f32x4*)(ghg + v0);
                const float g0 = __uint_as_float(gw2.x << 16), g1 = __uint_as_float(gw2.x & 0xffff0000u), g2 = __uint_as_float(gw2.y << 16), g3 = __uint_as_float(gw2.y & 0xffff0000u);
                u32x2 w; w.x = pk2(o[vt][0] * rstd * gh[0] * g0, o[vt][1] * rstd * gh[1] * g1); w.y = pk2(o[vt][2] * rstd * gh[2] * g2, o[vt][3] * rstd * gh[3] * g3);
                *(u32x2*)(MIX + row * 2048 + 1024 + h * 128 + v0) = w; }
        }
    }
    __syncthreads();
}

template <int NKS, int NDT, int KSTR, int VSTR, bool QG, int NQF>
__device__ __forceinline__ void attn_step(const bf16x8 (&qf)[NQF], const bf16_t* qg, f32x4 (&o)[NDT], float& m, float& l, const LAS unsigned char* kimg, const LAS unsigned char* vimg, int lane, bool half_valid) {
    const int r = lane & 15, g = lane >> 4;
    f32x4 s0 = (f32x4){0.f, 0.f, 0.f, 0.f}, s1 = (f32x4){0.f, 0.f, 0.f, 0.f};
    const LAS unsigned char* kp = kimg + r * (KSTR * 2) + g * 16;
    if constexpr (QG) {
#pragma unroll 1
        for (int ks3 = 0; ks3 < NKS; ks3 += 3) {
#pragma unroll
            for (int k2 = 0; k2 < 3; ++k2) { const int ks = ks3 + k2;
                const bf16x8 a0 = *(const LAS bf16x8*)(kp + ks * 64), a1 = *(const LAS bf16x8*)(kp + 16 * KSTR * 2 + ks * 64);
                const bf16x8 qv = *(const bf16x8*)(qg + 32 * ks);
                s0 = __builtin_amdgcn_mfma_f32_16x16x32_bf16(a0, qv, s0, 0, 0, 0);
                s1 = __builtin_amdgcn_mfma_f32_16x16x32_bf16(a1, qv, s1, 0, 0, 0); }
        }
    } else {
#pragma unroll
        for (int ks = 0; ks < NKS; ++ks) {
            const bf16x8 a0 = *(const LAS bf16x8*)(kp + ks * 64), a1 = *(const LAS bf16x8*)(kp + 16 * KSTR * 2 + ks * 64);
            s0 = __builtin_amdgcn_mfma_f32_16x16x32_bf16(a0, qf[ks], s0, 0, 0, 0);
            s1 = __builtin_amdgcn_mfma_f32_16x16x32_bf16(a1, qf[ks], s1, 0, 0, 0);
        }
    }
    if (half_valid) s1 = (f32x4){-INFINITY, -INFINITY, -INFINITY, -INFINITY};
    float mx = fmaxf(fmaxf(fmaxf(s0[0], s0[1]), fmaxf(s0[2], s0[3])), fmaxf(fmaxf(s1[0], s1[1]), fmaxf(s1[2], s1[3])));
    mx = fmaxf(mx, __shfl_xor(mx, 16)); mx = fmaxf(mx, __shfl_xor(mx, 32));
    const float mn = fmaxf(m, mx), alpha = exp2f(m - mn);
    f32x4 p0, p1;
#pragma unroll
    for (int e = 0; e < 4; ++e) { p0[e] = exp2f(s0[e] - mn); p1[e] = exp2f(s1[e] - mn); }
    float ls = (p0[0] + p0[1]) + (p0[2] + p0[3]) + (p1[0] + p1[1]) + (p1[2] + p1[3]);
    ls += __shfl_xor(ls, 16); ls += __shfl_xor(ls, 32);
    l = l * alpha + ls; m = mn;
    u32x4 pw = (u32x4){pk2(p0[0], p0[1]), pk2(p0[2], p0[3]), pk2(p1[0], p1[1]), pk2(p1[2], p1[3])};
    const bf16x8 pf = __builtin_bit_cast(bf16x8, pw);
    const LAS unsigned char* vp = vimg + r * (VSTR * 2) + g * 8;
#pragma unroll
    for (int dt = 0; dt < NDT; ++dt) {
        const u32x2 lo = *(const LAS u32x2*)(vp + dt * 16 * VSTR * 2), hi = *(const LAS u32x2*)(vp + dt * 16 * VSTR * 2 + 32);
        u32x4 t4 = (u32x4){lo.x, lo.y, hi.x, hi.y};
        o[dt] = __builtin_amdgcn_mfma_f32_16x16x32_bf16(__builtin_bit_cast(bf16x8, t4), pf, o[dt] * alpha, 0, 0, 0);
        if ((dt & 3) == 3) __builtin_amdgcn_sched_barrier(0);
    }
}

typedef float f32x16 __attribute__((ext_vector_type(16)));
__device__ __forceinline__ void attn_prompt_item(int b, int h, int qb, const bf16_t* Q, const bf16_t* KN, const bf16_t* KPE, const bf16_t* VT, bf16_t* MIX, LAS unsigned char* lds) {
    constexpr int KSTR = 200, VSTR = 72, KIMG = 64 * KSTR * 2, BUFB = KIMG + 128 * VSTR * 2;
    const int tid = ltid(), lane = tid & 63, wave = tid >> 6, r = lane & 31, hh = lane >> 5;
    const int nkt = 4 * qb + 4, nkw = 4 * qb + (wave >> 1) + 1;
    const size_t qrow = (size_t)b * 8192 + 256 * qb + 32 * wave + r;
    bf16x8 qf[12];
#pragma unroll
    for (int ks = 0; ks < 12; ++ks) qf[ks] = *(const bf16x8*)(Q + qrow * 1536 + h * 192 + 16 * ks + 8 * hh);
    f32x16 o[4];
#pragma unroll
    for (int dt = 0; dt < 4; ++dt)
#pragma unroll
        for (int i = 0; i < 16; ++i) o[dt][i] = 0.f;
    float m = -INFINITY, l = 0.f;
    const bf16_t* kn_src = KN + ((size_t)b * 8192 + (tid >> 4)) * 1024 + h * 128 + 8 * (tid & 15);
    const bf16_t* kp_src = KPE + ((size_t)b * 8192 + (tid >> 3)) * 64 + 8 * (tid & 7);
    const bf16_t* vt_src = VT + ((size_t)h * 128 + (tid >> 3)) * 16384 + (size_t)b * 8192 + 8 * (tid & 7);
    const int wk = (tid >> 4) * (KSTR * 2) + (tid & 15) * 16, wp = (tid >> 3) * (KSTR * 2) + 256 + (tid & 7) * 16, wv = KIMG + (tid >> 3) * (VSTR * 2) + ((tid & 7) >> 1) * 32 + ((tid & 7) & 1) * 8;
    u32x4 ak0, ak1, ap, av0, av1;
#define AT_LOAD(S_, t) do { S_##k0 = *(const u32x4*)(kn_src + (size_t)(t) * 64 * 1024); S_##k1 = *(const u32x4*)(kn_src + ((size_t)(t) * 64 + 32) * 1024); S_##p = *(const u32x4*)(kp_src + (size_t)(t) * 64 * 64); \
        S_##v0 = *(const u32x4*)(vt_src + (t) * 64); S_##v1 = *(const u32x4*)(vt_src + (size_t)64 * 16384 + (t) * 64); } while (0)
#define AT_STORE(S_, t) do { const int bo_ = ((t) & 1) * BUFB; *(LAS u32x4*)(lds + bo_ + wk) = S_##k0; *(LAS u32x4*)(lds + bo_ + wk + 32 * KSTR * 2) = S_##k1; *(LAS u32x4*)(lds + bo_ + wp) = S_##p; \
        *(LAS u32x2*)(lds + bo_ + wv) = (u32x2){S_##v0.x, S_##v0.y}; *(LAS u32x2*)(lds + bo_ + wv + 16) = (u32x2){S_##v0.z, S_##v0.w}; \
        *(LAS u32x2*)(lds + bo_ + wv + 64 * VSTR * 2) = (u32x2){S_##v1.x, S_##v1.y}; *(LAS u32x2*)(lds + bo_ + wv + 64 * VSTR * 2 + 16) = (u32x2){S_##v1.z, S_##v1.w}; } while (0)
#define AT_SUB(kt, u) do { \
            const LAS unsigned char* kimg = lds + ((kt) & 1) * BUFB + (u) * 32 * KSTR * 2; const LAS unsigned char* vimg = lds + ((kt) & 1) * BUFB + KIMG + (u) * 64; \
            f32x16 sc; \
            _Pragma("unroll") for (int i = 0; i < 16; ++i) sc[i] = 0.f; \
            const LAS unsigned char* kp = kimg + r * (KSTR * 2) + hh * 16; \
            _Pragma("unroll") for (int ks = 0; ks < 12; ++ks) { const bf16x8 a = *(const LAS bf16x8*)(kp + ks * 32); sc = __builtin_amdgcn_mfma_f32_32x32x16_bf16(a, qf[ks], sc, 0, 0, 0); } \
            float mx = sc[0]; \
            _Pragma("unroll") for (int i = 1; i < 16; ++i) mx = fmaxf(mx, sc[i]); \
            mx = fmaxf(mx, __shfl_xor(mx, 32)); \
            const float mn = fmaxf(m, mx), alpha = __builtin_amdgcn_exp2f(m - mn); \
            float ls = 0.f; \
            _Pragma("unroll") for (int i = 0; i < 16; ++i) { sc[i] = __builtin_amdgcn_exp2f(sc[i] - mn); ls += sc[i]; } \
            ls += __shfl_xor(ls, 32); \
            l = l * alpha + ls; m = mn; \
            bf16x8 pf[2]; \
            _Pragma("unroll") for (int s2 = 0; s2 < 2; ++s2) { u32x4 pw = (u32x4){pk2(sc[8 * s2], sc[8 * s2 + 1]), pk2(sc[8 * s2 + 2], sc[8 * s2 + 3]), pk2(sc[8 * s2 + 4], sc[8 * s2 + 5]), pk2(sc[8 * s2 + 6], sc[8 * s2 + 7])}; pf[s2] = __builtin_bit_cast(bf16x8, pw); } \
            const LAS unsigned char* vp = vimg + r * (VSTR * 2) + hh * 16; \
            _Pragma("unroll") for (int dt = 0; dt < 4; ++dt) { \
                f32x16 acc = o[dt] * alpha; \
                _Pragma("unroll") for (int s2 = 0; s2 < 2; ++s2) { \
                    const bf16x8 va = *(const LAS bf16x8*)(vp + dt * 32 * VSTR * 2 + s2 * 32); \
                    acc = __builtin_amdgcn_mfma_f32_32x32x16_bf16(va, pf[s2], acc, 0, 0, 0); } \
                o[dt] = acc; } } while (0)
#define AT_COMPUTE(kt) do { if ((kt) < nkw) { AT_SUB(kt, 0); AT_SUB(kt, 1); } } while (0)
    AT_LOAD(a, 0); AT_STORE(a, 0); AT_LOAD(a, 1);
    __syncthreads();
    for (int kt = 0; kt < nkt; ++kt) {
        AT_COMPUTE(kt);
        if (kt + 1 < nkt) AT_STORE(a, kt + 1);
        if (kt + 2 < nkt) AT_LOAD(a, kt + 2);
        __syncthreads();
    }
#undef AT_LOAD
#undef AT_STORE
#undef AT_SUB
#undef AT_COMPUTE
    const float inv = 1.0f / l;
#pragma unroll
    for (int dt = 0; dt < 4; ++dt)
#pragma unroll
        for (int ig = 0; ig < 4; ++ig) { u32x2 w; w.x = pk2(o[dt][4 * ig] * inv, o[dt][4 * ig + 1] * inv); w.y = pk2(o[dt][4 * ig + 2] * inv, o[dt][4 * ig + 3] * inv);
            *(u32x2*)(MIX + qrow * 2048 + h * 128 + 32 * dt + 8 * ig + 4 * hh) = w; }
}

constexpr int NSPL = 8;
__device__ __forceinline__ void attn_sample_item(int b, int sp, const bf16_t* Q, const bf16_t* WUKO, const float* cckv, const float* ckpe, const bf16_t* CKV, const bf16_t* KPE, bf16_t* QLAT, bf16_t* PO, float* PML, LAS unsigned char* lds) {
    constexpr int KSTR = 584, VSTR = 36;
    const int tid = ltid(), lane = tid & 63, h = tid >> 6, r = lane & 15, g = lane >> 4;
    LAS unsigned char* kimg = lds; LAS unsigned char* vimg = lds + 32 * KSTR * 2;
    const size_t qrow0 = (size_t)MP + (size_t)b * 16;
    bf16_t* ql = QLAT + ((size_t)b * 8 + h) * 16 * 576;
    {
        bf16x8 aq[4];
#pragma unroll
        for (int ks = 0; ks < 4; ++ks) aq[ks] = *(const bf16x8*)(Q + (qrow0 + r) * 1536 + h * 192 + 32 * ks + 8 * g);
#pragma unroll 8
        for (int ct = 0; ct < 32; ++ct) {
            f32x4 acc = (f32x4){0.f, 0.f, 0.f, 0.f};
#pragma unroll
            for (int ks = 0; ks < 4; ++ks) { const bf16x8 bw = *(const bf16x8*)(WUKO + (size_t)(16 * ct + r) * 1024 + h * 128 + 32 * ks + 8 * g); acc = __builtin_amdgcn_mfma_f32_16x16x32_bf16(bw, aq[ks], acc, 0, 0, 0); }
            u32x2 w; w.x = pk2(acc[0], acc[1]); w.y = pk2(acc[2], acc[3]);
            *(u32x2*)(ql + r * 576 + 16 * ct + 4 * g) = w;
        }
#pragma unroll
        for (int i = 0; i < 2; ++i) { const int pc = lane + 64 * i, qq = pc >> 3, cc = pc & 7;
            *(u32x4*)(ql + qq * 576 + 512 + 8 * cc) = *(const u32x4*)(Q + (qrow0 + qq) * 1536 + h * 192 + 128 + 8 * cc); }
    }
    __threadfence(); __syncthreads();
    const bf16_t* qg = ql + r * 576 + 8 * g;
    f32x4 o[32];
#pragma unroll
    for (int dt = 0; dt < 32; ++dt) o[dt] = (f32x4){0.f, 0.f, 0.f, 0.f};
    float m = -INFINITY, l = 0.f;
    const float* cb = cckv + (size_t)b * 2048 * 512; const float* pb = ckpe + (size_t)b * 2048 * 64;
    const int kt0 = sp * 8, kt1 = (sp == NSPL - 1) ? 65 : kt0 + 8;
    for (int kt = kt0; kt < kt1; ++kt) {
        __syncthreads();
        if (kt < 64) {
            const int c = tid;
            float v[32];
#pragma unroll
            for (int kk = 0; kk < 32; ++kk) v[kk] = cb[(size_t)(32 * kt + kk) * 512 + c];
            const int key = tid >> 4, i4 = (tid & 15) * 4; const f32x4 pv = *(const f32x4*)(pb + (size_t)(32 * kt + key) * 64 + i4);
#pragma unroll
            for (int kk = 0; kk < 32; kk += 2) {
                const unsigned pw = pk2(v[kk], v[kk + 1]);
                *(LAS bf16_t*)(kimg + kk * (KSTR * 2) + c * 2) = (bf16_t)(pw & 0xffffu);
                *(LAS bf16_t*)(kimg + (kk + 1) * (KSTR * 2) + c * 2) = (bf16_t)(pw >> 16);
                *(LAS unsigned*)(vimg + c * (VSTR * 2) + kk * 2) = pw;
            }
#pragma unroll
            for (int e = 0; e < 4; ++e) { const int i = i4 + e, pi = i < 32 ? 2 * i : 2 * (i - 32) + 1;
                *(LAS bf16_t*)(kimg + key * (KSTR * 2) + (512 + pi) * 2) = (bf16_t)(pk2(pv[e], 0.f) & 0xffffu); }
        } else {
            const int c = tid;
#pragma unroll 4
            for (int kk = 0; kk < 32; kk += 2) {
                unsigned pw = 0u;
                if (kk < 16) { const unsigned a = CKV[(qrow0 + kk) * 512 + c], bb = CKV[(qrow0 + kk + 1) * 512 + c]; pw = a | (bb << 16); }
                *(LAS bf16_t*)(kimg + kk * (KSTR * 2) + c * 2) = (bf16_t)(pw & 0xffffu);
                *(LAS bf16_t*)(kimg + (kk + 1) * (KSTR * 2) + c * 2) = (bf16_t)(pw >> 16);
                *(LAS unsigned*)(vimg + c * (VSTR * 2) + kk * 2) = pw;
            }
            { const int key = tid >> 4, i4 = (tid & 15) * 4;
              u32x2 w = (u32x2){0u, 0u}; if (key < 16) w = *(const u32x2*)(KPE + (qrow0 + key) * 64 + i4);
              *(LAS u32x2*)(kimg + key * (KSTR * 2) + (512 + i4) * 2) = w; }
        }
        bf16x8 qv[18];
#pragma unroll
        for (int ks = 0; ks < 18; ++ks) qv[ks] = *(const bf16x8*)(qg + 32 * ks);
        __syncthreads();
        attn_step<18, 32, KSTR, VSTR, false, 18>(qv, nullptr, o, m, l, kimg, vimg, lane, kt == 64);
    }
    const float inv = 1.0f / l;
    const size_t pi = (((size_t)b * NSPL + sp) * 8 + h) * 16 + r;
    bf16_t* po = PO + pi * 512 + 4 * g;
#pragma unroll
    for (int dt = 0; dt < 32; ++dt) { u32x2 w; w.x = pk2(o[dt][0] * inv, o[dt][1] * inv); w.y = pk2(o[dt][2] * inv, o[dt][3] * inv); *(u32x2*)(po + 16 * dt) = w; }
    if (g == 0) *(f32x2*)(PML + pi * 2) = (f32x2){m, l};
    __syncthreads();
}
__device__ __forceinline__ void attn_sample_combine(int b, int h, const bf16_t* PO, const float* PML, const bf16_t* WUVT, bf16_t* MIX, int lane) {
    const int r = lane & 15, g = lane >> 4;
    float ms[NSPL], cs[NSPL], M = -INFINITY, L = 0.f;
#pragma unroll
    for (int sp = 0; sp < NSPL; ++sp) { const f32x2 ml = *(const f32x2*)(PML + ((((size_t)b * NSPL + sp) * 8 + h) * 16 + r) * 2); ms[sp] = ml.x; cs[sp] = ml.y; M = fmaxf(M, ml.x); }
#pragma unroll
    for (int sp = 0; sp < NSPL; ++sp) { cs[sp] *= __builtin_amdgcn_exp2f(ms[sp] - M); L += cs[sp]; }
    const float invL = 1.0f / L;
#pragma unroll
    for (int sp = 0; sp < NSPL; ++sp) cs[sp] *= invL;
    bf16x8 pfs[16];
#pragma unroll
    for (int s = 0; s < 16; ++s) {
        f32x4 a0 = (f32x4){0.f, 0.f, 0.f, 0.f}, a1 = (f32x4){0.f, 0.f, 0.f, 0.f};
#pragma unroll
        for (int sp = 0; sp < NSPL; ++sp) {
            const bf16_t* po = PO + ((((size_t)b * NSPL + sp) * 8 + h) * 16 + r) * 512 + 32 * s + 4 * g;
            const u32x2 w0 = *(const u32x2*)po, w1 = *(const u32x2*)(po + 16);
            a0 += cs[sp] * (f32x4){__uint_as_float(w0.x << 16), __uint_as_float(w0.x & 0xffff0000u), __uint_as_float(w0.y << 16), __uint_as_float(w0.y & 0xffff0000u)};
            a1 += cs[sp] * (f32x4){__uint_as_float(w1.x << 16), __uint_as_float(w1.x & 0xffff0000u), __uint_as_float(w1.y << 16), __uint_as_float(w1.y & 0xffff0000u)};
        }
        u32x4 pw = (u32x4){pk2(a0[0], a0[1]), pk2(a0[2], a0[3]), pk2(a1[0], a1[1]), pk2(a1[2], a1[3])};
        pfs[s] = __builtin_bit_cast(bf16x8, pw);
    }
    const size_t qrow0 = (size_t)MP + (size_t)b * 16;
#pragma unroll 1
    for (int dt = 0; dt < 8; ++dt) {
        f32x4 acc = (f32x4){0.f, 0.f, 0.f, 0.f};
        const bf16_t* wp = WUVT + (size_t)(h * 128 + 16 * dt + r) * 512 + 4 * g;
#pragma unroll
        for (int s = 0; s < 16; ++s) {
            const u32x2 lo = *(const u32x2*)(wp + 32 * s), hi = *(const u32x2*)(wp + 32 * s + 16);
            u32x4 t4 = (u32x4){lo.x, lo.y, hi.x, hi.y};
            acc = __builtin_amdgcn_mfma_f32_16x16x32_bf16(__builtin_bit_cast(bf16x8, t4), pfs[s], acc, 0, 0, 0);
        }
        u32x2 w; w.x = pk2(acc[0], acc[1]); w.y = pk2(acc[2], acc[3]);
        *(u32x2*)(MIX + (qrow0 + r) * 2048 + h * 128 + 16 * dt + 4 * g) = w;
    }
}

#define XB_TMO      128
#define XB_XCNT(j)  (256  + 64 * (j))
#define XB_XSUB(j)  (1280 + 64 * (j))
#define XB_XGEN(j)  (2304 + 64 * (j))
#define XB_TOP      3328
#define XB_TOPGEN   3392
#define XCD_BAR_WORDS 3456
#define XB_SPIN_CAP (1u << 18)
__device__ __forceinline__ unsigned xb_ld(unsigned* p)              { return __hip_atomic_load(p, __ATOMIC_RELAXED, __HIP_MEMORY_SCOPE_AGENT); }
__device__ __forceinline__ unsigned xb_add(unsigned* p, unsigned v) { return __hip_atomic_fetch_add(p, v, __ATOMIC_RELAXED, __HIP_MEMORY_SCOPE_AGENT); }
__device__ __forceinline__ unsigned xb_xcc_id() { return (unsigned)__builtin_amdgcn_s_getreg((3 << 11) | 20) & 0xFu; }
#define XB_SPIN(cond, bar) do { unsigned _sp = 0; while (cond) { __builtin_amdgcn_s_sleep(1); \
    if ((++_sp & 255u) == 0u) { if (xb_ld(&(bar)[XB_TMO])) break; if (_sp > XB_SPIN_CAP) { atomicAdd(&(bar)[XB_TMO], 1u); break; } } } } while (0)
struct XcdBarrier { unsigned* bar; unsigned x; volatile LAS unsigned* st; };
__device__ __forceinline__ XcdBarrier xcd_barrier_post(unsigned* bar, volatile LAS unsigned* st) {
    XcdBarrier b; b.bar = bar; b.x = xb_xcc_id(); b.st = st;
    if (threadIdx.x == 0) (void)xb_add(&bar[XB_XCNT(b.x)], 1u);
    return b;
}
__device__ __forceinline__ void xcd_barrier_complete(unsigned* bar, unsigned x, unsigned& nloc, unsigned& nx) {
    const unsigned G = gridDim.x * gridDim.y * gridDim.z;
    unsigned sum, cnt, mine, sp = 0u;
    for (;;) {
        sum = 0u; cnt = 0u; mine = 0u;
#pragma unroll
        for (unsigned j = 0; j < 16; ++j) { const unsigned c = xb_ld(&bar[XB_XCNT(j)]); sum += c; cnt += (c > 0u) ? 1u : 0u; mine = (j == x) ? c : mine; }
        if (sum == G) break;
        __builtin_amdgcn_s_sleep(1);
        if ((++sp & 255u) == 0u) { if (xb_ld(&bar[XB_TMO])) break; if (sp > XB_SPIN_CAP) { atomicAdd(&bar[XB_TMO], 1u); break; } }
    }
    nloc = mine > 0u ? mine : 1u; nx = cnt > 0u ? cnt : 1u;
}
__device__ __forceinline__ void xcd_barrier(const XcdBarrier& b) {
    asm volatile("s_waitcnt vmcnt(0)" ::: "memory");
    __syncthreads();
    if (threadIdx.x == 0) {
        unsigned* bar = b.bar;
        __builtin_amdgcn_s_waitcnt(0);
        unsigned nloc = b.st[0], nx = b.st[1];
        if (nloc == 0u) { xcd_barrier_complete(bar, b.x, nloc, nx); b.st[0] = nloc; b.st[1] = nx; }
        const unsigned old = xb_add(&bar[XB_XSUB(b.x)], 1u);
        const unsigned gen = old / nloc;
        if (old + 1u == (gen + 1u) * nloc) {
            __builtin_amdgcn_fence(__ATOMIC_RELEASE, "agent");
            asm volatile("s_waitcnt vmcnt(0)" ::: "memory");
            const unsigned og = xb_add(&bar[XB_TOP], 1u);
            const unsigned tg = og / nx;
            if (og + 1u == (tg + 1u) * nx) xb_add(&bar[XB_TOPGEN], 1u);
            else XB_SPIN(xb_ld(&bar[XB_TOPGEN]) == tg, bar);
            __builtin_amdgcn_fence(__ATOMIC_ACQUIRE, "agent");
            xb_add(&bar[XB_XGEN(b.x)], 1u);
            asm volatile("s_waitcnt vmcnt(0)" ::: "memory");
        } else {
            XB_SPIN(xb_ld(&bar[XB_XGEN(b.x)]) == gen, bar);
            __builtin_amdgcn_fence(__ATOMIC_ACQUIRE, "agent");
            asm volatile("s_waitcnt vmcnt(0)" ::: "memory");
        }
    }
    __syncthreads();
}

__device__ __forceinline__ void gsync(cg::grid_group& grid) {
    asm volatile("s_waitcnt vmcnt(0) lgkmcnt(0)" ::: "memory");
    grid.sync();
    __builtin_amdgcn_fence(__ATOMIC_ACQUIRE, "agent");
    asm volatile("s_waitcnt vmcnt(0)" ::: "memory");
}
struct Params { const float* in[21]; float* out; unsigned char* ws; };

__global__ void __launch_bounds__(512) mega(Params p) {
    extern __shared__ __attribute__((aligned(16))) unsigned char lds[];
    cg::grid_group grid = cg::this_grid();
    LAS unsigned char* ldsl = (LAS unsigned char*)lds;
    unsigned char* ws = p.ws; float* out = p.out; unsigned char* outb = (unsigned char*)p.out;
    const int G = gridDim.x, bx = blockIdx.x, tid = threadIdx.x;
    float* MOD = (float*)(ws + WS_MOD); const float* bada = p.in[8];
    const f32x2* ROPE = (const f32x2*)(ws + WS_ROPE);
    bf16_t* H = (bf16_t*)(ws + WS_H);
    float* Gb = (float*)(outb + OB_G); bf16_t* QH = (bf16_t*)(outb + OB_QH); bf16_t* VH = (bf16_t*)(outb + OB_VH);
    bf16_t* GATE = (bf16_t*)(ws + WS_GATE); bf16_t* KPE = (bf16_t*)(ws + WS_KPE); float* CQKV = (float*)(ws + WS_CQKV);
    bf16_t* Qb = (bf16_t*)(ws + WS_Q); bf16_t* CQN = (bf16_t*)(ws + WS_CQN); bf16_t* QLAT = (bf16_t*)(ws + WS_QLAT); bf16_t* CKV = (bf16_t*)(ws + WS_CKV);
    bf16_t* U = (bf16_t*)(ws + WS_U); bf16_t* MIX = (bf16_t*)(ws + WS_MIX); float* DD = (float*)(ws + WS_DD); bf16_t* Sn = (bf16_t*)(ws + WS_S);
    bf16_t* KN = (bf16_t*)(ws + WS_KN); bf16_t* VT = (bf16_t*)(ws + WS_VT); bf16_t* FFH = (bf16_t*)(ws + WS_FFH);
    float* X = out + O_Y;
    pg8::StaticOrder S;
    volatile LAS unsigned* xst = (volatile LAS unsigned*)(ldsl + LDS_Q + 16);
    if (tid == 0) { xst[0] = 0u; xst[1] = 0u; }
    __syncthreads();
    const XcdBarrier xbar = xcd_barrier_post((unsigned*)(ws + WS_BAR), xst);

#ifdef FILLTEST
    for (size_t i = (size_t)bx * 512 + tid; i < 48791552; i += (size_t)G * 512) out[i] = 0.5f;
#endif
    if (PHMASK & 1) phase0(p.in, ws, lds);
#ifdef PROBE_P0
    if (p.out == nullptr) gsync(grid);
    xcd_barrier(xbar);
    phase0(p.in, ws, lds);
#endif
    xcd_barrier(xbar);
#ifdef PROBE_SYNC
    for (int z = 0; z < 10; ++z) xcd_barrier(xbar);
#endif
    if (PHMASK & 2) adaln_rows<0>(p.in[0], p.in[1], MOD, bada, 0, 2048, H);
    xcd_barrier(xbar);
    if (PHMASK & 4) { EpiIn E{CQKV, QH, Gb, VH, GATE, KPE, ROPE, out + O_KPE_P, out + O_KPE_S, p.in[15]};
      S.init(MT, NINP, 2048, G, bx); pg8::gemm_phase(ldsl, pg8::Gemm{H, (const bf16_t*)(ws + WS_WIN), MT, NINP, 2048}, S, E); }
    xcd_barrier(xbar);
    if (PHMASK & 8) latent_rows(CQKV, p.in[11], p.in[12], CQN, CKV, out + O_CKV_P, out + O_CKV_S);
    if (PHMASK & 16) for (int it = bx; it < NCHUNK; it += G) {
        if (it < NCHUNK_P) hgrn_a<64>(it, it >> 7, (it >> 10) * 8192 + (it & 127) * 64, 64, Gb, VH, U, DD, lds);
        else hgrn_a<32>(it, it - NCHUNK_P, MP + ((it - NCHUNK_P) >> 3) * 16, 16, Gb, VH, U, DD, lds);
    }
#ifdef PROBE_MISC
    xcd_barrier(xbar);
    latent_rows(CQKV, p.in[11], p.in[12], CQN, CKV, out + O_CKV_P, out + O_CKV_S);
    for (int it = bx; it < NCHUNK; it += G) {
        if (it < NCHUNK_P) hgrn_a<64>(it, it >> 7, (it >> 10) * 8192 + (it & 127) * 64, 64, Gb, VH, U, DD, lds);
        else hgrn_a<32>(it, it - NCHUNK_P, MP + ((it - NCHUNK_P) >> 3) * 16, 16, Gb, VH, U, DD, lds);
    }
#endif
    xcd_barrier(xbar);
    if (PHMASK & 32) { EpiQ E{Qb, ROPE}; S.init(MT, 1536, 512, G, bx); pg8::gemm_phase(ldsl, pg8::Gemm{CQN, (const bf16_t*)(ws + WS_WUQ), MT, 1536, 512}, S, E); }
    if (PHMASK & 32) { EpiPlain E{KN, 1024}; S.init(MP, 1024, 512, G, bx); pg8::gemm_phase(ldsl, pg8::Gemm{CKV, (const bf16_t*)(ws + WS_WUK), MP, 1024, 512}, S, E); }
    if (PHMASK & 32) { EpiPlain E{VT, 16384}; S.init(1024, MP, 512, G, bx); pg8::gemm_phase(ldsl, pg8::Gemm{(const bf16_t*)(ws + WS_WUV), CKV, 1024, MP, 512}, S, E); }
    if (PHMASK & 64) hgrn_b(U, DD, Sn, p.in[6], out + O_ST_P, out + O_ST_S);
#ifdef PROBE_MISC
    xcd_barrier(xbar);
    hgrn_b(U, DD, Sn, p.in[6], out + O_ST_P, out + O_ST_S);
#endif
    xcd_barrier(xbar);
    for (int p5rep = 0; p5rep < P5REPS; ++p5rep) {
    if (p5rep) xcd_barrier(xbar);
    if (PHMASK & 0x380) {
        unsigned* ctr = (unsigned*)(ws + WS_CTL) + p5rep * 64;
        volatile int* qslot = (volatile int*)(lds + LDS_Q);
        for (;;) {
            __syncthreads();
            if (tid == 0) *qslot = (int)__hip_atomic_fetch_add(ctr, 1u, __ATOMIC_RELAXED, __HIP_MEMORY_SCOPE_AGENT);
            __syncthreads();
            const int it = *qslot;
            if (it >= 256 + 512 + NCHUNK) break;
            const int pm_ = p5rep ? (P5MASK2) : 0x380;
            if (it < 256) { if (pm_ & 128) attn_sample_item(it >> 3, it & 7, Qb, (const bf16_t*)(ws + WS_WUKO), p.in[4], p.in[5], CKV, KPE, QLAT, (bf16_t*)(ws + WS_PO), (float*)(ws + WS_PML), ldsl); }
            else if (it < 256 + 512) { if (pm_ & 256) { const int j = it - 256, qb = 31 - (j >> 4), bh = j & 15; attn_prompt_item(bh >> 3, bh & 7, qb, Qb, KN, KPE, VT, MIX, ldsl); } }
            else if (pm_ & 512) { const int c = it - 768;
                if (c < NCHUNK_P) hgrn_c<64>(c, c >> 7, (c >> 10) * 8192 + (c & 127) * 64, 64, Gb, QH, VH, GATE, Sn, p.in[16], MIX, lds);
                else hgrn_c<32>(c, c - NCHUNK_P, MP + ((c - NCHUNK_P) >> 3) * 16, 16, Gb, QH, VH, GATE, Sn, p.in[16], MIX, lds); }
        }
    }
    }
    xcd_barrier(xbar);
    { const int tl = ltid(), gw = bx * 8 + (tl >> 6); if (gw < 256) attn_sample_combine(gw >> 3, gw & 7, (const bf16_t*)(ws + WS_PO), (const float*)(ws + WS_PML), (const bf16_t*)(ws + WS_WUV), MIX, tl & 63); }
    xcd_barrier(xbar);
    if (PHMASK & 1024) { EpiRes E{p.in[0], p.in[1], X, MOD, bada, 4096, (float*)(ws + WS_CQKV)}; if (G == 256) S.init(MP, 2048, 2048, G, bx, 8, 64, 16); else S.init(MT, 2048, 2048, G, bx); pg8::gemm_phase(ldsl, pg8::Gemm{MIX, (const bf16_t*)(ws + WS_WOUT), MT, 2048, 2048}, S, E); }
    xcd_barrier(xbar);
    if (PHMASK & 2048) { if (G == 256) adaln_rows<8>(X, p.in[1], MOD, bada, 6144, 8192, H, (const float*)(ws + WS_CQKV), 4096, X); else adaln_rows<0>(X, X + (size_t)MP * DM, MOD, bada, 6144, 8192, H); }
    xcd_barrier(xbar);
#ifdef PROBE_P8
    { EpiRelu2 E{FFH}; S.init(MT, DFF, 2048, G, bx); pg8::gemm_phase(ldsl, pg8::Gemm{H, (const bf16_t*)(ws + WS_WFF1), MT, DFF, 2048}, S, E); }
    xcd_barrier(xbar);
#endif
    if (PHMASK & 4096) { EpiRelu2 E{FFH}; S.init(MT, DFF, 2048, G, bx); pg8::gemm_phase(ldsl, pg8::Gemm{H, (const bf16_t*)(ws + WS_WFF1), MT, DFF, 2048}, S, E); }
    xcd_barrier(xbar);
    if (PHMASK & 8192) { EpiRes E{X, X + (size_t)MP * DM, X, MOD, bada, 10240, (float*)(ws + WS_H)}; if (G == 256) S.init(MP, 2048, DFF, G, bx, 16, 64, 16); else S.init(MT, 2048, DFF, G, bx); pg8::gemm_phase(ldsl, pg8::Gemm{FFH, (const bf16_t*)(ws + WS_WFF2), MT, 2048, DFF}, S, E); }
    xcd_barrier(xbar);
    if (PHMASK & 16384) { if (G == 256) final_rows<16>(X, p.in[20], (const float*)(ws + WS_H), MOD, bada); else final_rows<0>(X, p.in[20], nullptr, MOD, bada); }
}

extern "C" void kernel_launch(void* const* d_in, const int* in_sizes, int n_in, void* d_out, int out_size, void* d_ws, size_t ws_size, hipStream_t stream) {
    static int grid_blocks = 0;
    if (grid_blocks == 0) {
        if (n_in != 21 || ws_size < WS_TOTAL) { fprintf(stderr, "kernel_launch: unexpected n_in %d or workspace %zu < %zu\n", n_in, ws_size, (size_t)WS_END); grid_blocks = -1; return; }
        int dev = 0, cus = 0, per_cu = 0;
        hipGetDevice(&dev);
        hipDeviceGetAttribute(&cus, hipDeviceAttributeMultiprocessorCount, dev);
        if (hipFuncSetAttribute((const void*)mega, hipFuncAttributeMaxDynamicSharedMemorySize, LDS_BYTES) != hipSuccess) { fprintf(stderr, "kernel_launch: hipFuncSetAttribute failed\n"); }
        if (hipOccupancyMaxActiveBlocksPerMultiprocessor(&per_cu, (const void*)mega, 512, LDS_BYTES) != hipSuccess || per_cu < 1) { fprintf(stderr, "kernel_launch: occupancy query gave %d\n", per_cu); per_cu = 1; }
        (void)hipGetLastError();
        grid_blocks = cus * 1;
    }
    if (grid_blocks < 0) return;
    (void)hipMemsetAsync((char*)d_ws + WS_BAR, 0, XCD_BAR_WORDS * 4, stream);
    Params p{};
    for (int i = 0; i < 21; ++i) p.in[i] = (const float*)d_in[i];
    p.out = (float*)d_out; p.ws = (unsigned char*)d_ws;
    void* args[] = {&p};
    hipError_t e = hipLaunchCooperativeKernel((const void*)mega, dim3(grid_blocks), dim3(512), args, LDS_BYTES, stream);
    if (e != hipSuccess) fprintf(stderr, "cooperative launch failed: %s (grid %d)\n", hipGetErrorString(e), grid_blocks);
}
```

```cpp
#include <hip/hip_runtime.h>
#include <hip/hip_cooperative_groups.h>
#include <cstdio>
namespace cg = cooperative_groups;

#define LAS __attribute__((address_space(3)))
typedef unsigned short bf16_t;
typedef short bf16x8 __attribute__((ext_vector_type(8)));
typedef float f32x4 __attribute__((ext_vector_type(4)));
typedef float f32x2 __attribute__((ext_vector_type(2)));
typedef unsigned u32x4 __attribute__((ext_vector_type(4)));
typedef unsigned u32x2 __attribute__((ext_vector_type(2)));

constexpr int MP = 16384, MS = 512, MT = MP + MS;
constexpr int DM = 2048, NMOD = 12288, NINP = 5376, DFF = 8192;
constexpr float EPSN = 1e-6f;
constexpr float QSCALE = 0.07216878364870322f * 1.4426950408889634f;
constexpr int NCHUNK_P = 2048, NCHUNK = 2304;

constexpr size_t O_Y = 0, O_CKV_P = 34603008, O_KPE_P = 42991616, O_ST_P = 44040192, O_CKV_S = 44302336, O_KPE_S = 44564480, O_ST_S = 44597248;
constexpr size_t OB_G = 0, OB_QH = 69206016, OB_VH = 103809024;
constexpr size_t WS_CTL = 0, WS_MOD = 4096, WS_ZERO_BYTES = 4096 + 34 * 12288 * 4;
constexpr size_t WS_ROPE = 1675264;
constexpr size_t WS_WIN = WS_ROPE + 2097152;
constexpr size_t WS_WUQ = WS_WIN + (size_t)NINP * 2048 * 2;
constexpr size_t WS_WUK = WS_WUQ + 1536 * 512 * 2;
constexpr size_t WS_WUV = WS_WUK + 1024 * 512 * 2;
constexpr size_t WS_WUKO = WS_WUV + 1024 * 512 * 2;
constexpr size_t WS_WOUT = WS_WUKO + 1024 * 512 * 2;
constexpr size_t WS_WFF1 = WS_WOUT + 2048 * 2048 * 2;
constexpr size_t WS_WFF2 = WS_WFF1 + (size_t)8192 * 2048 * 2;
constexpr size_t WS_H = WS_WFF2 + (size_t)8192 * 2048 * 2;
constexpr size_t WS_KN = WS_H, WS_VT = WS_H + (size_t)MP * 1024 * 2;
constexpr size_t WS_ARENA = WS_H + (size_t)MT * 2048 * 2;
constexpr size_t WS_GATE = WS_ARENA;
constexpr size_t WS_KPE = WS_GATE + (size_t)MT * 1024 * 2;
constexpr size_t WS_CQKV = WS_KPE + (size_t)MT * 64 * 2;
constexpr size_t WS_Q = WS_CQKV;
constexpr size_t WS_CQN = WS_CQKV + (size_t)MT * 1024 * 4;
constexpr size_t WS_QLAT = WS_WIN;
constexpr size_t WS_PO = WS_CQKV + (size_t)MT * 1536 * 2;
constexpr size_t WS_PML = WS_PO + (size_t)256 * 8 * 16 * 512 * 2;
constexpr size_t WS_CKV = WS_CQN + (size_t)MT * 512 * 2;
constexpr size_t WS_U = WS_CKV + (size_t)MT * 512 * 2;
constexpr size_t WS_MIX = WS_U;
constexpr size_t WS_DD = WS_U + (size_t)NCHUNK * 16384 * 2;
constexpr size_t WS_S = WS_DD + (size_t)NCHUNK * 128 * 4;
constexpr size_t WS_END = WS_S + (size_t)NCHUNK * 16384 * 2;
constexpr size_t WS_FFH = WS_ARENA;
constexpr size_t WS_BAR = WS_END, WS_TOTAL = WS_END + 16384;
static_assert(WS_ARENA + (size_t)MT * DFF * 2 <= WS_END, "ffh overlay");
static_assert(WS_PML + 256 * 8 * 16 * 2 * 4 <= WS_CKV, "sample partials");
static_assert((size_t)32 * 8 * 16 * 576 * 2 <= (size_t)NINP * 2048 * 2, "qlat");

#ifndef P5MASK2
#define P5MASK2 0x380
#endif
#ifndef P5REPS
#define P5REPS 1
#endif
#ifndef PHMASK
#define PHMASK 0xFFFF
#endif
constexpr int LDS_BYTES = 131072 + 256;
constexpr int LDS_Q = 131072;

typedef __bf16 bf16v2 __attribute__((ext_vector_type(2)));
__device__ __forceinline__ unsigned pk2(float lo, float hi) { const f32x2 v = (f32x2){lo, hi}; const bf16v2 b = __builtin_convertvector(v, bf16v2); return __builtin_bit_cast(unsigned, b); }
__device__ __forceinline__ float bf2f(bf16_t b) { return __uint_as_float(((unsigned)b) << 16); }
__device__ __forceinline__ float wave_sum(float v) {
#pragma unroll
    for (int o = 1; o < 64; o <<= 1) v += __shfl_xor(v, o);
    return v;
}
__device__ __forceinline__ int ltid() { int t = threadIdx.x; asm volatile("" : "+v"(t)); return t; }
__device__ __forceinline__ float silu_f(float v) { return v * __builtin_amdgcn_rcpf(1.0f + __expf(-v)); }
__device__ __forceinline__ int row_pos(int r) { return r < MP ? (r & 8191) : 2048 + ((r - MP) & 15); }
__device__ __forceinline__ int row_ci(int r) { return r < MP ? (r >> 13) : 2 + ((r - MP) >> 4); }

namespace pg8 {
constexpr int BM = 256, BK = 64, HALF = 128, HTB = HALF * BK * 2, STAGE_BYTES = 8 * HTB, NXCD = 8, WGM = 8;
__host__ __device__ __forceinline__ int lds_byte(int r, int c) { const int st = (r >> 4) * 2 + (c >> 5), rr = r & 15, cc = c & 31, ob = rr * 64 + cc * 2; return st * 1024 + (ob ^ (((ob >> 9) & 1) << 5)); }
__host__ __device__ __forceinline__ void stage_rc(int b, int& R, int& C) { const int st = b / 1024, sb = b % 1024, swz = sb ^ (((sb >> 9) & 1) << 5); R = (st >> 1) * 16 + swz / 64; C = (st & 1) * 32 + (swz % 64) / 2; }
struct Unit { int pm, pn, k0, nt, sl; };
struct Gemm { const bf16_t* A; const bf16_t* Bt; int M, N, K; };
struct StaticOrder {
    int nM, nN, nwg, G, c, ntK, ns, tail_pm0, ntail;
    __host__ __device__ void init(int M, int N, int K, int G_, int c_, int ns_ = 1, int tail_pm0_ = 0, int ntail_ = 0) { nM = M / BM; nN = N / BM; nwg = nM * nN; G = G_; c = c_; ntK = K / BK; ns = ns_; tail_pm0 = tail_pm0_; ntail = ntail_; }
    __host__ __device__ __forceinline__ void unit_of(int L, Unit& u) const {
        int wgid = L; { const int q = nwg / NXCD, r = nwg % NXCD, xcd = wgid % NXCD, off = wgid / NXCD; wgid = (xcd < r ? xcd * (q + 1) : r * (q + 1) + (xcd - r) * q) + off; }
        const int nig = WGM * nN, gid = wgid / nig, fm = gid * WGM, gsz = (nM - fm) < WGM ? (nM - fm) : WGM;
        u.pm = fm + ((wgid % nig) % gsz); u.pn = (wgid % nig) / gsz;
    }
    __host__ __device__ __forceinline__ bool next(int i, Unit& u) const {
        int L = i * G + c, k0 = 0, nt = ntK, sl = 0; bool ok = L < nwg;
        if (!ok) L = 0;
        unit_of(L, u);
        if (ns > 1) {
            const int rounds = nwg / G, idx = c / ns;
            const bool tail = (i == rounds) && (idx < ntail);
            if (tail) { nt = ntK / ns; k0 = (c % ns) * nt * BK; sl = 1; u.pm = tail_pm0 + idx / nN; u.pn = idx % nN; ok = true; }
        }
        u.k0 = k0; u.nt = nt; u.sl = sl; return ok;
    }
};
template <class Epi>
__device__ __forceinline__ void gemm_phase(LAS unsigned char* lds, const Gemm g, const StaticOrder& S, const Epi& E) {
    const int tid = ltid(), wid = __builtin_amdgcn_readfirstlane(tid >> 6), lane = tid & 63, wr = wid >> 2, wc = wid & 3, fr = lane & 15, fq = lane >> 4;
    const int K = g.K;
    unsigned voffA[2], voffB[2];
#pragma unroll
    for (int i = 0; i < 2; ++i) { int R, C; stage_rc(tid * 16 + i * 8192, R, C); voffA[i] = (unsigned)(R * K + C) * 2u; voffB[i] = (unsigned)(R * K + C) * 2u; }
    const size_t kstep = (size_t)(BK * 2);
    const size_t hstep = (size_t)HALF * K * 2;
    const size_t tstep = 2 * hstep;
    const unsigned ldsw = (unsigned)wid * 1024u;
    const int aoff = lds_byte(wr * 64 + fr, fq * 8), boff = lds_byte(wc * 32 + fr, fq * 8);
#define PG8_SA(b, h) (((b) * 2 + (h)) * HTB)
#define PG8_SB(b, h) ((4 + (b) * 2 + (h)) * HTB)
#define PG8_STAGE(bufoff, gbase, voff) do { _Pragma("unroll") for (int _i = 0; _i < 2; ++_i) \
        __builtin_amdgcn_global_load_lds((const unsigned*)((const char*)(gbase) + (voff)[_i]), (LAS unsigned*)(lds + (bufoff) + ldsw + _i * 8192), 16, 0, 0); } while (0)
#define PG8_LDA(dst, b, h) do { _Pragma("unroll") for (int m = 0; m < 4; ++m) _Pragma("unroll") for (int k = 0; k < 2; ++k) dst[m][k] = *(const LAS bf16x8*)(lds + PG8_SA(b, h) + aoff + m * 2048 + k * 1024); } while (0)
#define PG8_LDB(dst, b, h) do { _Pragma("unroll") for (int n = 0; n < 2; ++n) _Pragma("unroll") for (int k = 0; k < 2; ++k) dst[n][k] = *(const LAS bf16x8*)(lds + PG8_SB(b, h) + boff + n * 2048 + k * 1024); } while (0)
#define PG8_MMA(ai, bj, At, Bt) do { __builtin_amdgcn_s_setprio(1); _Pragma("unroll") for (int m = 0; m < 4; ++m) _Pragma("unroll") for (int n = 0; n < 2; ++n) _Pragma("unroll") for (int k = 0; k < 2; ++k) \
        acc[ai][bj][m][n] = __builtin_amdgcn_mfma_f32_16x16x32_bf16(Bt[n][k], At[m][k], acc[ai][bj][m][n], 0, 0, 0); __builtin_amdgcn_s_setprio(0); } while (0)
#define PG8_WAIT_V(n) asm volatile("s_waitcnt vmcnt(" #n ")" ::: "memory")
#define PG8_WAIT_L(n) asm volatile("s_waitcnt lgkmcnt(" #n ")" ::: "memory")
#define PG8_BAR __builtin_amdgcn_s_barrier()
#define PG8_SCHED __builtin_amdgcn_sched_barrier(0)
    Unit cur, nxt; int ui = 0;
    if (!S.next(0, cur)) return;
    f32x4 acc[2][2][4][2];
#pragma unroll
    for (int a = 0; a < 2; ++a)
#pragma unroll
        for (int b = 0; b < 2; ++b)
#pragma unroll
            for (int m = 0; m < 4; ++m)
#pragma unroll
                for (int n = 0; n < 2; ++n) acc[a][b][m][n] = (f32x4){0.f, 0.f, 0.f, 0.f};
    bf16x8 At[4][2], B0[2][2], B1[2][2];
    const char* cA = (const char*)g.A + (size_t)cur.pm * tstep + (size_t)cur.k0 * 2; const char* cB = (const char*)g.Bt + (size_t)cur.pn * tstep + (size_t)cur.k0 * 2;
    PG8_STAGE(PG8_SB(0, 0), cB, voffB); PG8_STAGE(PG8_SA(0, 0), cA, voffA); PG8_STAGE(PG8_SB(0, 1), cB + hstep, voffB); PG8_STAGE(PG8_SA(0, 1), cA + hstep, voffA);
    if (wr == 1) PG8_BAR;
    PG8_WAIT_V(4); PG8_BAR;
    PG8_STAGE(PG8_SB(1, 0), cB + kstep, voffB); PG8_STAGE(PG8_SA(1, 0), cA + kstep, voffA); PG8_STAGE(PG8_SB(1, 1), cB + hstep + kstep, voffB);
    PG8_WAIT_V(6); PG8_BAR;
    for (;;) {
        const bool has_next = S.next(ui + 1, nxt);
        const char* nA = has_next ? (const char*)g.A + (size_t)nxt.pm * tstep + (size_t)nxt.k0 * 2 : cA; const char* nB = has_next ? (const char*)g.Bt + (size_t)nxt.pn * tstep + (size_t)nxt.k0 * 2 : cB;
        const int nt = cur.nt;
        for (int t = 0; t < nt; t += 2) {
            const bool last = (t == nt - 2);
            const char* a1 = cA + (size_t)(t + 1) * kstep;
            const char* a2 = last ? nA : cA + (size_t)(t + 2) * kstep; const char* b2 = last ? nB : cB + (size_t)(t + 2) * kstep;
            const char* a3 = a2 + kstep; const char* b3 = b2 + kstep;
            PG8_LDB(B0, 0, 0); PG8_SCHED; PG8_LDA(At, 0, 0); PG8_STAGE(PG8_SA(1, 1), a1 + hstep, voffA);
            PG8_WAIT_L(8); PG8_BAR; PG8_WAIT_L(0); PG8_MMA(0, 0, At, B0); PG8_BAR; PG8_SCHED;
            PG8_LDB(B1, 0, 1); PG8_STAGE(PG8_SB(0, 0), b2, voffB);
            PG8_BAR; PG8_WAIT_L(0); PG8_MMA(0, 1, At, B1); PG8_BAR;
            PG8_LDA(At, 0, 1); PG8_STAGE(PG8_SA(0, 0), a2, voffA);
            PG8_BAR; PG8_WAIT_L(0); PG8_MMA(1, 0, At, B0); PG8_BAR; PG8_SCHED;
            PG8_STAGE(PG8_SB(0, 1), b2 + hstep, voffB);
            PG8_WAIT_V(6); PG8_BAR; PG8_MMA(1, 1, At, B1); PG8_BAR;
            PG8_LDB(B0, 1, 0); PG8_SCHED; PG8_LDA(At, 1, 0); PG8_STAGE(PG8_SA(0, 1), a2 + hstep, voffA);
            PG8_WAIT_L(8); PG8_BAR; PG8_WAIT_L(0); PG8_MMA(0, 0, At, B0); PG8_BAR; PG8_SCHED;
            PG8_LDB(B1, 1, 1); PG8_STAGE(PG8_SB(1, 0), b3, voffB);
            PG8_BAR; PG8_WAIT_L(0); PG8_MMA(0, 1, At, B1); PG8_BAR;
            PG8_LDA(At, 1, 1); PG8_STAGE(PG8_SA(1, 0), a3, voffA);
            PG8_BAR; PG8_WAIT_L(0); PG8_MMA(1, 0, At, B0); PG8_BAR; PG8_SCHED;
            PG8_STAGE(PG8_SB(1, 1), b3 + hstep, voffB);
            PG8_WAIT_V(6); PG8_BAR; PG8_MMA(1, 1, At, B1); PG8_BAR;
        }
        E(acc, cur, wr, wc, fr, fq);
        if (!has_next) break;
#pragma unroll
        for (int a = 0; a < 2; ++a)
#pragma unroll
            for (int b = 0; b < 2; ++b)
#pragma unroll
                for (int m = 0; m < 4; ++m)
#pragma unroll
                    for (int n = 0; n < 2; ++n) acc[a][b][m][n] = (f32x4){0.f, 0.f, 0.f, 0.f};
        cur = nxt; cA = nA; cB = nB; ++ui;
    }
    PG8_WAIT_V(0);
    if (wr == 0) PG8_BAR;
    PG8_BAR;
#undef PG8_SA
#undef PG8_SB
#undef PG8_STAGE
#undef PG8_LDA
#undef PG8_LDB
#undef PG8_MMA
#undef PG8_WAIT_V
#undef PG8_WAIT_L
#undef PG8_BAR
#undef PG8_SCHED
}
}

template <class F>
__device__ __forceinline__ void epi_walk(const f32x4 (&acc)[2][2][4][2], const pg8::Unit& u, int wr, int wc, int fr, int fq, const F& f) {
    const int row0 = u.pm * 256 + wr * 64 + fr;
#pragma unroll
    for (int ai = 0; ai < 2; ++ai)
#pragma unroll
        for (int m = 0; m < 4; ++m) {
            const int r = row0 + ai * 128 + m * 16;
#pragma unroll
            for (int bj = 0; bj < 2; ++bj)
#pragma unroll
                for (int n = 0; n < 2; ++n) f(r, bj * 128 + wc * 32 + n * 16 + 4 * fq, acc[ai][bj][m][n]);
        }
}

struct EpiIn {
    float* cqkv; bf16_t* qh; float* g; bf16_t* vh; bf16_t* gate; bf16_t* kpe; const f32x2* rope; float* okp; float* oks; const float* hglb;
    __device__ __forceinline__ void operator()(const f32x4 (&acc)[2][2][4][2], const pg8::Unit& u, int wr, int wc, int fr, int fq) const {
        const int pn = u.pn;
        epi_walk(acc, u, wr, wc, fr, fq, [&](int r, int cl, f32x4 v) {
            const int c = pn * 256 + cl;
            if (pn < 4) { *(f32x4*)(cqkv + (size_t)r * 1024 + c) = v; }
            else if (pn < 8) {
                const float sc = 0.08838834764831845f;
                u32x2 w; w.x = pk2(silu_f(v[0]) * sc, silu_f(v[1]) * sc); w.y = pk2(silu_f(v[2]) * sc, silu_f(v[3]) * sc);
                *(u32x2*)(qh + (size_t)r * 1024 + (c - 1024)) = w;
            } else if (pn < 12) {
                const int j = c - 2048;
                const f32x4 a0 = *(const f32x4*)(hglb + j), a1 = *(const f32x4*)(hglb + 1024 + j);
                f32x4 o;
#pragma unroll
                for (int e = 0; e < 4; ++e) { const float lb = __builtin_amdgcn_rcpf(1.0f + __expf(a1[e] - a0[e])); const float sg = __builtin_amdgcn_rcpf(1.0f + __expf(-v[e])); o[e] = __logf(lb + (1.0f - lb) * sg); }
                *(f32x4*)(g + (size_t)r * 1024 + j) = o;
            } else if (pn < 16) {
                u32x2 w; w.x = pk2(v[0], v[1]); w.y = pk2(v[2], v[3]);
                *(u32x2*)(vh + (size_t)r * 1024 + (c - 3072)) = w;
            } else if (pn < 20) {
                u32x2 w; w.x = pk2(silu_f(v[0]), silu_f(v[1])); w.y = pk2(silu_f(v[2]), silu_f(v[3]));
                *(u32x2*)(gate + (size_t)r * 1024 + (c - 4096)) = w;
            } else if (cl < 64) {
                const int i0 = cl >> 1, pos = row_pos(r);
                const f32x2 c0 = rope[pos * 32 + i0], c1 = rope[pos * 32 + i0 + 1];
                const float o1a = v[0] * c0.x - v[1] * c0.y, o2a = v[1] * c0.x + v[0] * c0.y;
                const float o1b = v[2] * c1.x - v[3] * c1.y, o2b = v[3] * c1.x + v[2] * c1.y;
                float* ob = r < MP ? okp + (size_t)r * 64 : oks + (size_t)(r - MP) * 64;
                *(f32x2*)(ob + i0) = (f32x2){o1a, o1b}; *(f32x2*)(ob + 32 + i0) = (f32x2){o2a, o2b};
                u32x2 w; w.x = pk2(o1a, o2a); w.y = pk2(o1b, o2b);
                *(u32x2*)(kpe + (size_t)r * 64 + cl) = w;
            }
        });
    }
};
struct EpiQ {
    bf16_t* q; const f32x2* rope;
    __device__ __forceinline__ void operator()(const f32x4 (&acc)[2][2][4][2], const pg8::Unit& u, int wr, int wc, int fr, int fq) const {
        const int pn = u.pn;
        epi_walk(acc, u, wr, wc, fr, fq, [&](int r, int cl, f32x4 v) {
            const int c = pn * 256 + cl, h = c / 192, j = c - h * 192;
            u32x2 w;
            if (j < 128) { w.x = pk2(v[0] * QSCALE, v[1] * QSCALE); w.y = pk2(v[2] * QSCALE, v[3] * QSCALE); }
            else {
                const int i0 = (j - 128) >> 1, pos = row_pos(r);
                const f32x2 c0 = rope[pos * 32 + i0], c1 = rope[pos * 32 + i0 + 1];
                const float o1a = v[0] * c0.x - v[1] * c0.y, o2a = v[1] * c0.x + v[0] * c0.y;
                const float o1b = v[2] * c1.x - v[3] * c1.y, o2b = v[3] * c1.x + v[2] * c1.y;
                w.x = pk2(o1a * QSCALE, o2a * QSCALE); w.y = pk2(o1b * QSCALE, o2b * QSCALE);
            }
            *(u32x2*)(q + (size_t)r * 1536 + c) = w;
        });
    }
};
struct EpiPlain {
    bf16_t* o; int ldc;
    __device__ __forceinline__ void operator()(const f32x4 (&acc)[2][2][4][2], const pg8::Unit& u, int wr, int wc, int fr, int fq) const {
        const int pn = u.pn;
        epi_walk(acc, u, wr, wc, fr, fq, [&](int r, int cl, f32x4 v) {
            u32x2 w; w.x = pk2(v[0], v[1]); w.y = pk2(v[2], v[3]);
            *(u32x2*)(o + (size_t)r * ldc + pn * 256 + cl) = w;
        });
    }
};
struct EpiRelu2 {
    bf16_t* o;
    __device__ __forceinline__ void operator()(const f32x4 (&acc)[2][2][4][2], const pg8::Unit& u, int wr, int wc, int fr, int fq) const {
        const int pn = u.pn;
        epi_walk(acc, u, wr, wc, fr, fq, [&](int r, int cl, f32x4 v) {
            f32x4 t;
#pragma unroll
            for (int e = 0; e < 4; ++e) { const float a = fmaxf(v[e], 0.f); t[e] = a * a; }
            u32x2 w; w.x = pk2(t[0], t[1]); w.y = pk2(t[2], t[3]);
            *(u32x2*)(o + (size_t)r * DFF + pn * 256 + cl) = w;
        });
    }
};
struct EpiRes {
    const float* xa; const float* xb; float* xo; const float* mod; const float* bada; int goff; float* part;
    __device__ __forceinline__ void operator()(const f32x4 (&acc)[2][2][4][2], const pg8::Unit& u, int wr, int wc, int fr, int fq) const {
        const int pn = u.pn, sl = u.sl, sidx = u.k0 / (u.nt * 64);
        epi_walk(acc, u, wr, wc, fr, fq, [&](int r, int cl, f32x4 v) {
            const int c = pn * 256 + cl;
            if (sl) { *(f32x4*)(part + ((size_t)sidx * MS + (r - MP)) * DM + c) = v; }
            else {
                const int ci = row_ci(r);
                const float* xi = r < MP ? xa + (size_t)r * DM : xb + (size_t)(r - MP) * DM;
                const f32x4 gt = *(const f32x4*)(mod + (size_t)ci * NMOD + goff + c) + *(const f32x4*)(bada + goff + c);
                const f32x4 x = *(const f32x4*)(xi + c);
                *(f32x4*)(xo + (size_t)r * DM + c) = x + gt * v;
            }
        });
    }
};

__device__ __forceinline__ int map_row(int mat, int n) {
    if (mat == 0) { if (n < 1024) return n; if (n < 1088) { const int i = n - 1024; return 5120 + (i < 32 ? 2 * i : 2 * (i - 32) + 1); } return n - 64; }
    if (mat == 1) { const int h = n / 192, j = n - h * 192; if (j < 128) return n; const int i = j - 128; return h * 192 + 128 + (i < 32 ? 2 * i : 2 * (i - 32) + 1); }
    return n;
}
struct TrItem { const float* W; bf16_t* WT; int K, N, mat, item; };
__device__ __forceinline__ void tr_load(const TrItem& t, int lane, float (&tv)[32]) {
    const int nblk = t.N / 32, kb = t.item / nblk, nb = t.item % nblk, k0 = 64 * kb, n0 = 32 * nb;
#pragma unroll
    for (int i = 0; i < 32; ++i) { const int kk = 2 * i + (lane >> 5); tv[i] = t.W[(size_t)(k0 + kk) * t.N + n0 + (lane & 31)]; }
}
__device__ __forceinline__ void tr_store(const TrItem& t, int lane, const float (&tv)[32], LAS float* scr) {
    const int nblk = t.N / 32, kb = t.item / nblk, nb = t.item % nblk, k0 = 64 * kb, n0 = 32 * nb;
#pragma unroll
    for (int i = 0; i < 32; ++i) { const int kk = 2 * i + (lane >> 5); scr[kk * 33 + (lane & 31)] = tv[i]; }
    asm volatile("s_waitcnt lgkmcnt(0)" ::: "memory");
    const int c = lane & 7;
#pragma unroll
    for (int j = 0; j < 4; ++j) { const int n = (lane >> 3) + 8 * j; const LAS float* sp = scr + (8 * c) * 33 + n;
        u32x4 o; o.x = pk2(sp[0 * 33], sp[1 * 33]); o.y = pk2(sp[2 * 33], sp[3 * 33]); o.z = pk2(sp[4 * 33], sp[5 * 33]); o.w = pk2(sp[6 * 33], sp[7 * 33]);
        *(u32x4*)(t.WT + (size_t)map_row(t.mat, n0 + n) * t.K + k0 + 8 * c) = o; }
    asm volatile("s_waitcnt lgkmcnt(0)" ::: "memory");
}
__device__ __forceinline__ TrItem tr_item(const float* const* in, unsigned char* ws, int it) {
    constexpr int I0 = 32 * 162, I1 = 8 * 48, I2 = 8 * 32, I3 = 8 * 32, I4 = 32 * 64, I5 = 32 * 256;
    int r = it;
    if (r < I0) return TrItem{in[9], (bf16_t*)(ws + WS_WIN), 2048, 5184, 0, r}; r -= I0;
    if (r < I1) return TrItem{in[10], (bf16_t*)(ws + WS_WUQ), 512, 1536, 1, r}; r -= I1;
    if (r < I2) return TrItem{in[13], (bf16_t*)(ws + WS_WUK), 512, 1024, 2, r}; r -= I2;
    if (r < I3) return TrItem{in[14], (bf16_t*)(ws + WS_WUV), 512, 1024, 2, r}; r -= I3;
    if (r < I4) return TrItem{in[17], (bf16_t*)(ws + WS_WOUT), 2048, 2048, 2, r}; r -= I4;
    if (r < I5) return TrItem{in[18], (bf16_t*)(ws + WS_WFF1), 2048, 8192, 2, r}; r -= I5;
    return TrItem{in[19], (bf16_t*)(ws + WS_WFF2), 8192, 2048, 2, r};
}
__device__ __forceinline__ void phase0(const float* const* in, unsigned char* ws, unsigned char* lds) {
    const int tid = ltid(), lane = tid & 63, wave = tid >> 6, G = gridDim.x, bx = blockIdx.x;
    {
        float* sl = (float*)lds;
        float* MOD = (float*)(ws + WS_MOD);
        const float* wada = in[7];
        if (bx == 0 && tid < 2) __hip_atomic_store((unsigned*)(ws + WS_CTL) + tid * 64, 0u, __ATOMIC_RELAXED, __HIP_MEMORY_SCOPE_AGENT);
        for (int it = bx; it < 192; it += G) {
            const int grp = tid >> 6, col = it * 64 + lane;
            float acc[34];
#pragma unroll
            for (int r = 0; r < 34; ++r) acc[r] = 0.f;
            for (int pass = 0; pass < 4; ++pass) {
                __syncthreads();
                for (int e = tid; e < 34 * 512; e += 512) { const int r = e >> 9, kl = e & 511, kg = (kl >> 6) * 256 + pass * 64 + (kl & 63);
                    const float cv = r < 2 ? in[2][r * DM + kg] : in[3][(r - 2) * DM + kg]; sl[e] = silu_f(cv); }
                __syncthreads();
                const int k0 = grp * 256 + pass * 64;
                for (int kk = 0; kk < 64; kk += 8) {
                    float w[8];
#pragma unroll
                    for (int j = 0; j < 8; ++j) w[j] = wada[(size_t)(k0 + kk + j) * NMOD + col];
#pragma unroll
                    for (int r = 0; r < 34; ++r) { const f32x4 sv = *(const f32x4*)(sl + r * 512 + grp * 64 + kk), sw = *(const f32x4*)(sl + r * 512 + grp * 64 + kk + 4);
                        acc[r] += (sv[0] * w[0] + sv[1] * w[1] + sv[2] * w[2] + sv[3] * w[3]) + (sw[0] * w[4] + sw[1] * w[5] + sw[2] * w[6] + sw[3] * w[7]); }
                }
            }
            __syncthreads();
            float* red = (float*)lds;
#pragma unroll
            for (int r = 0; r < 34; ++r) red[(grp * 34 + r) * 64 + lane] = acc[r];
            __syncthreads();
            for (int e = tid; e < 34 * 64; e += 512) { const int r = e >> 6, c = e & 63; float sum = 0.f;
#pragma unroll
                for (int g2 = 0; g2 < 8; ++g2) sum += red[(g2 * 34 + r) * 64 + c];
                MOD[(size_t)r * NMOD + it * 64 + c] = sum; }
            __syncthreads();
        }
    }
    {
        LAS float* scr = (LAS float*)lds + wave * (64 * 33);
        const int gw = bx * 8 + wave, NGW = G * 8;
        constexpr int NIT = 32 * 162 + 8 * 48 + 8 * 32 + 8 * 32 + 32 * 64 + 32 * 256 + 128 * 64;
        float ta[32], tb[32];
        int it = gw;
        if (it < NIT) tr_load(tr_item(in, ws, it), lane, ta);
        for (; it < NIT; it += 2 * NGW) {
            if (it + NGW < NIT) tr_load(tr_item(in, ws, it + NGW), lane, tb);
            tr_store(tr_item(in, ws, it), lane, ta, scr);
            if (it + NGW < NIT) {
                if (it + 2 * NGW < NIT) tr_load(tr_item(in, ws, it + 2 * NGW), lane, ta);
                tr_store(tr_item(in, ws, it + NGW), lane, tb, scr);
            }
        }
    }
    const int gt = bx * 512 + tid, NGT = G * 512;
    { u32x4* z = (u32x4*)(ws + WS_WIN + (size_t)5184 * 2048 * 2); for (int i = gt; i < 192 * 2048 * 2 / 16; i += NGT) z[i] = (u32x4){0u, 0u, 0u, 0u}; }
    { const f32x4* s = (const f32x4*)in[13]; u32x2* d = (u32x2*)(ws + WS_WUKO); for (int i = gt; i < 512 * 1024 / 4; i += NGT) { const f32x4 v = s[i]; u32x2 w; w.x = pk2(v[0], v[1]); w.y = pk2(v[2], v[3]); d[i] = w; } }
    { f32x2* rp = (f32x2*)(ws + WS_ROPE);
      for (int i = gt; i < 8192 * 32; i += NGT) { const int pos = i >> 5, k = i & 31;
          const double invf = exp(-9.210340371976184 * (double)k / 32.0); const double t = (double)pos * invf * 0.15915494309189535; const float fr = (float)(t - rint(t));
          rp[i] = (f32x2){__builtin_amdgcn_cosf(fr), __builtin_amdgcn_sinf(fr)}; } }
}

template <int NSL>
__device__ __forceinline__ void adaln_rows(const float* xa, const float* xb, const float* mod, const float* bada, int off_sh, int off_sc, bf16_t* H,
                                           const float* part = nullptr, int off_gt = 0, float* xout = nullptr) {
    const int tid_ = ltid(), lane = tid_ & 63, gw = blockIdx.x * 8 + (tid_ >> 6), NGW = gridDim.x * 8;
    {
        f32x4 v[8], nx[8];
#pragma unroll
        for (int j = 0; j < 8; ++j) v[j] = *(const f32x4*)(xa + (size_t)gw * DM + 4 * lane + 256 * j);
        for (int row = gw; row < MP; row += NGW) {
            const int nrow = row + NGW;
            if (nrow < MP) {
#pragma unroll
                for (int j = 0; j < 8; ++j) nx[j] = *(const f32x4*)(xa + (size_t)nrow * DM + 4 * lane + 256 * j); }
            const int ci = row >> 13;
            float ss = 0.f;
#pragma unroll
            for (int j = 0; j < 8; ++j) ss += (v[j][0] * v[j][0] + v[j][1] * v[j][1]) + (v[j][2] * v[j][2] + v[j][3] * v[j][3]);
            const float* mr = mod + (size_t)ci * NMOD;
            const float rstd = 1.0f / sqrtf(wave_sum(ss) * (1.0f / DM) + EPSN);
#pragma unroll
            for (int j = 0; j < 8; ++j) { const int c = 4 * lane + 256 * j;
                const f32x4 scj = *(const f32x4*)(mr + off_sc + c) + *(const f32x4*)(bada + off_sc + c) + 1.0f;
                const f32x4 shj = *(const f32x4*)(mr + off_sh + c) + *(const f32x4*)(bada + off_sh + c);
                const f32x4 h = v[j] * rstd * scj + shj;
                u32x2 w; w.x = pk2(h[0], h[1]); w.y = pk2(h[2], h[3]);
                *(u32x2*)(H + (size_t)row * DM + c) = w; v[j] = nx[j]; }
        }
    }
    __builtin_amdgcn_sched_barrier(0);
    if (gw < MS) {
        const int row = MP + gw; const float* xr = xb + (size_t)gw * DM; const float* mr = mod + (size_t)row_ci(row) * NMOD;
        f32x4 v[8]; float ss = 0.f;
#pragma unroll
        for (int j = 0; j < 8; ++j) { const int c = 4 * lane + 256 * j; v[j] = *(const f32x4*)(xr + c);
            if (NSL > 0) { f32x4 a = (f32x4){0.f, 0.f, 0.f, 0.f};
#pragma unroll
                for (int s2 = 0; s2 < NSL; ++s2) a += *(const f32x4*)(part + ((size_t)s2 * MS + gw) * DM + c);
                const f32x4 gt = *(const f32x4*)(mr + off_gt + c) + *(const f32x4*)(bada + off_gt + c);
                v[j] += gt * a; *(f32x4*)(xout + (size_t)row * DM + c) = v[j]; }
            ss += (v[j][0] * v[j][0] + v[j][1] * v[j][1]) + (v[j][2] * v[j][2] + v[j][3] * v[j][3]); }
        const float rstd = 1.0f / sqrtf(wave_sum(ss) * (1.0f / DM) + EPSN);
#pragma unroll
        for (int j = 0; j < 8; ++j) { const int c = 4 * lane + 256 * j;
            const f32x4 sc = *(const f32x4*)(mr + off_sc + c) + *(const f32x4*)(bada + off_sc + c) + 1.0f;
            const f32x4 sh = *(const f32x4*)(mr + off_sh + c) + *(const f32x4*)(bada + off_sh + c);
            const f32x4 h = v[j] * rstd * sc + sh;
            u32x2 w; w.x = pk2(h[0], h[1]); w.y = pk2(h[2], h[3]);
            *(u32x2*)(H + (size_t)row * DM + c) = w; }
    }
}
template <int NSL>
__device__ __forceinline__ void final_rows(float* X, const float* gf, const float* part, const float* mod, const float* bada) {
    const int tid_ = ltid(), lane = tid_ & 63, gw = blockIdx.x * 8 + (tid_ >> 6), NGW = gridDim.x * 8;
    f32x4 v[8], nx[8], gn[8];
#pragma unroll
    for (int j = 0; j < 8; ++j) { gn[j] = *(const f32x4*)(gf + 4 * lane + 256 * j); v[j] = *(const f32x4*)(X + (size_t)gw * DM + 4 * lane + 256 * j); }
    for (int row = gw; row < MT; row += NGW) {
        const int nrow = row + NGW;
        if (nrow < MT) {
#pragma unroll
            for (int j = 0; j < 8; ++j) nx[j] = *(const f32x4*)(X + (size_t)nrow * DM + 4 * lane + 256 * j); }
        if (NSL > 0 && row >= MP) {
#pragma unroll
            for (int j = 0; j < 8; ++j) { const int c = 4 * lane + 256 * j; f32x4 a = (f32x4){0.f, 0.f, 0.f, 0.f};
#pragma unroll
                for (int s2 = 0; s2 < NSL; ++s2) a += *(const f32x4*)(part + ((size_t)s2 * MS + (row - MP)) * DM + c);
                const f32x4 gt = *(const f32x4*)(mod + (size_t)row_ci(row) * NMOD + 10240 + c) + *(const f32x4*)(bada + 10240 + c);
                v[j] += gt * a; }
        }
        float ss = 0.f;
#pragma unroll
        for (int j = 0; j < 8; ++j) ss += (v[j][0] * v[j][0] + v[j][1] * v[j][1]) + (v[j][2] * v[j][2] + v[j][3] * v[j][3]);
        const float rstd = 1.0f / sqrtf(wave_sum(ss) * (1.0f / DM) + EPSN);
#pragma unroll
        for (int j = 0; j < 8; ++j) { *(f32x4*)(X + (size_t)row * DM + 4 * lane + 256 * j) = v[j] * rstd * gn[j]; v[j] = nx[j]; }
    }
}
__device__ __forceinline__ void latent_rows(const float* cqkv, const float* gq, const float* gkv, bf16_t* cqn, bf16_t* ckv, float* ockp, float* ocks) {
    const int tid_ = ltid(), lane = tid_ & 63, gw = blockIdx.x * 8 + (tid_ >> 6), NGW = gridDim.x * 8;
    for (int row = gw; row < MT; row += NGW) {
        const float* sr = cqkv + (size_t)row * 1024;
        f32x4 a[2], b[2]; float sa = 0.f, sb = 0.f;
#pragma unroll
        for (int j = 0; j < 2; ++j) { a[j] = *(const f32x4*)(sr + 4 * lane + 256 * j); b[j] = *(const f32x4*)(sr + 512 + 4 * lane + 256 * j);
            sa += (a[j][0] * a[j][0] + a[j][1] * a[j][1]) + (a[j][2] * a[j][2] + a[j][3] * a[j][3]); sb += (b[j][0] * b[j][0] + b[j][1] * b[j][1]) + (b[j][2] * b[j][2] + b[j][3] * b[j][3]); }
        const float ra = 1.0f / sqrtf(wave_sum(sa) * (1.0f / 512) + EPSN), rb = 1.0f / sqrtf(wave_sum(sb) * (1.0f / 512) + EPSN);
        float* oc = row < MP ? ockp + (size_t)row * 512 : ocks + (size_t)(row - MP) * 512;
#pragma unroll
        for (int j = 0; j < 2; ++j) { const int c = 4 * lane + 256 * j;
            const f32x4 qa = a[j] * ra * *(const f32x4*)(gq + c), kb = b[j] * rb * *(const f32x4*)(gkv + c);
            u32x2 w; w.x = pk2(qa[0], qa[1]); w.y = pk2(qa[2], qa[3]); *(u32x2*)(cqn + (size_t)row * 512 + c) = w;
            *(f32x4*)(oc + c) = kb;
            w.x = pk2(kb[0], kb[1]); w.y = pk2(kb[2], kb[3]); *(u32x2*)(ckv + (size_t)row * 512 + c) = w; }
    }
}

template <int L>
__device__ __forceinline__ void hgrn_cumsum(const float* G, int row0, int h, int lreal, float* Bs, float* tot, float (&gv)[L / 4]) {
    constexpr int SEG = L / 4;
    const int tid = ltid(), k = tid & 127, seg = tid >> 7;
    float run = 0.f;
#pragma unroll
    for (int i = 0; i < SEG; ++i) { const int t = seg * SEG + i; gv[i] = t < lreal ? G[(size_t)(row0 + t) * 1024 + h * 128 + k] : 0.f; }
#pragma unroll
    for (int i = 0; i < SEG; ++i) { run += gv[i]; Bs[(seg * SEG + i) * 128 + k] = run; }
    tot[seg * 128 + k] = run;
    __syncthreads();
    float off = 0.f;
#pragma unroll
    for (int s2 = 0; s2 < 3; ++s2) if (s2 < seg) off += tot[s2 * 128 + k];
#pragma unroll
    for (int i = 0; i < SEG; ++i) Bs[(seg * SEG + i) * 128 + k] += off;
    __syncthreads();
}
template <int L>
__device__ __forceinline__ void hgrn_a(int it, int bh, int row0, int lreal, const float* G, const bf16_t* VH, bf16_t* U, float* DD, unsigned char* lds) {
    constexpr int SEG = L / 4, ST = L + 8;
    const int tid = ltid(), lane = tid & 63, wave = tid >> 6, k = tid & 127, seg = tid >> 7, h = bh & 7;
    float* Bs = (float*)lds; float* tot = (float*)(lds + 32768);
    bf16_t* KDT = (bf16_t*)(lds + 34816); bf16_t* VT = (bf16_t*)(lds + 34816 + 128 * ST * 2);
    float gv[SEG]; bf16_t vraw[SEG];
#pragma unroll
    for (int i = 0; i < SEG; ++i) { const int s = seg * SEG + i; vraw[i] = s < lreal ? VH[(size_t)(row0 + s) * 1024 + h * 128 + k] : (bf16_t)0; }
    hgrn_cumsum<L>(G, row0, h, lreal, Bs, tot, gv);
    const float blast = Bs[(L - 1) * 128 + k];
#pragma unroll
    for (int i = 0; i < SEG; ++i) { const int s = seg * SEG + i;
        const float kd = (1.0f - __expf(gv[i])) * __expf(blast - Bs[s * 128 + k]);
        KDT[k * ST + s] = (bf16_t)(pk2(kd, 0.f) & 0xffffu);
        VT[k * ST + s] = vraw[i]; }
    if (seg == 0) DD[(size_t)it * 128 + k] = __expf(blast);
    __syncthreads();
    const int r = lane & 15, g = lane >> 4;
#pragma unroll
    for (int vt = 0; vt < 8; ++vt) {
        f32x4 acc = (f32x4){0.f, 0.f, 0.f, 0.f};
#pragma unroll
        for (int ks = 0; ks < L / 32; ++ks) {
            const bf16x8 a = *(const bf16x8*)(KDT + (16 * wave + r) * ST + 32 * ks + 8 * g);
            const bf16x8 b = *(const bf16x8*)(VT + (16 * vt + r) * ST + 32 * ks + 8 * g);
            acc = __builtin_amdgcn_mfma_f32_16x16x32_bf16(a, b, acc, 0, 0, 0);
        }
        bf16_t* up = U + (size_t)it * 16384 + (16 * wave + 4 * g) * 128 + 16 * vt + r;
        const unsigned p01 = pk2(acc[0], acc[1]), p23 = pk2(acc[2], acc[3]);
        up[0] = (bf16_t)(p01 & 0xffffu); up[128] = (bf16_t)(p01 >> 16); up[256] = (bf16_t)(p23 & 0xffffu); up[384] = (bf16_t)(p23 >> 16);
    }
    __syncthreads();
}
__device__ __forceinline__ void hgrn_b(const bf16_t* U, const float* DD, bf16_t* Sn, const float* st0, float* ostp, float* osts) {
    const int gt = blockIdx.x * 512 + ltid(), NGT = gridDim.x * 512;
#ifdef HB_TEST
    for (int e = gt; e < 16 * 16384; e += NGT) { const int bh = e >> 14, kv = e & 16383; ostp[e] = bf2f(U[((size_t)bh * 128 + 127) * 16384 + kv]); }
    for (int e = gt; e < 256 * 16384; e += NGT) { const int bh = e >> 14, kv = e & 16383; osts[e] = bf2f(U[((size_t)2048 + bh) * 16384 + kv]) + DD[((size_t)2048 + bh) * 128 + (kv >> 7)]; }
    return;
#endif
    for (int e = gt; e < 16 * 16384; e += NGT) {
        const int bh = e >> 14, kv = e & 16383, k = kv >> 7;
        float S = 0.f;
        const bf16_t* up = U + (size_t)bh * 128 * 16384 + kv; const float* dp = DD + (size_t)bh * 128 * 128 + k; bf16_t* sp = Sn + (size_t)bh * 128 * 16384 + kv;
        for (int n0 = 0; n0 < 128; n0 += 16) {
            bf16_t ur[16]; float dr[16];
#pragma unroll
            for (int j = 0; j < 16; ++j) { ur[j] = up[(size_t)(n0 + j) * 16384]; dr[j] = dp[(n0 + j) * 128]; }
#pragma unroll
            for (int j = 0; j < 16; ++j) { sp[(size_t)(n0 + j) * 16384] = (bf16_t)(pk2(S, 0.f) & 0xffffu); S = dr[j] * S + bf2f(ur[j]); }
        }
        ostp[e] = S;
    }
    for (int e = gt; e < 256 * 16384; e += NGT) {
        const int bh = e >> 14, kv = e & 16383, k = kv >> 7; const size_t it = 2048 + bh;
        const float S0 = st0[e];
        Sn[it * 16384 + kv] = (bf16_t)(pk2(S0, 0.f) & 0xffffu);
        osts[e] = DD[it * 128 + k] * S0 + bf2f(U[it * 16384 + kv]);
    }
}
template <int L>
__device__ __forceinline__ void hgrn_c(int it, int bh, int row0, int lreal, const float* G, const bf16_t* QH, const bf16_t* VH, const bf16_t* GATE, const bf16_t* Sn, const float* ghg, bf16_t* MIX, unsigned char* lds) {
    constexpr int SEG = L / 4, VS = L + 8;
    const int tid = ltid(), lane = tid & 63, wave = tid >> 6, k = tid & 127, seg = tid >> 7, h = bh & 7;
    float* Bs = (float*)lds; float* tot = (float*)(lds + 32768);
    bf16_t* QT = (bf16_t*)(lds + 34816); bf16_t* KT = (bf16_t*)(lds + 52224); bf16_t* VT = (bf16_t*)(lds + 69632); bf16_t* ST = (bf16_t*)(lds + 88064);
    float gv[SEG];
    bf16_t qraw[SEG], vraw[SEG]; u32x4 sraw[4];
#pragma unroll
    for (int i = 0; i < SEG; ++i) { const int s = seg * SEG + i;
        qraw[i] = s < lreal ? QH[(size_t)(row0 + s) * 1024 + h * 128 + k] : (bf16_t)0;
        vraw[i] = s < lreal ? VH[(size_t)(row0 + s) * 1024 + h * 128 + k] : (bf16_t)0; }
#pragma unroll
    for (int i = 0; i < 4; ++i) sraw[i] = *(const u32x4*)(Sn + (size_t)it * 16384 + (size_t)k * 128 + (seg + 4 * i) * 8);
    hgrn_cumsum<L>(G, row0, h, lreal, Bs, tot, gv);
#pragma unroll
    for (int i = 0; i < SEG; ++i) { const int s = seg * SEG + i; const float bs = Bs[s * 128 + k];
        QT[s * 136 + k] = (bf16_t)(pk2(bf2f(qraw[i]) * __expf(bs), 0.f) & 0xffffu);
        KT[s * 136 + k] = (bf16_t)(pk2((1.0f - __expf(gv[i])) * __expf(-bs), 0.f) & 0xffffu);
        VT[k * VS + s] = vraw[i]; }
#pragma unroll
    for (int i = 0; i < 4; ++i) { const int kk = k, v0 = (seg + 4 * i) * 8;
        const unsigned w4[4] = {sraw[i].x, sraw[i].y, sraw[i].z, sraw[i].w};
#pragma unroll
        for (int e = 0; e < 4; ++e) { ST[(v0 + 2 * e) * 136 + kk] = (bf16_t)(w4[e] & 0xffffu); ST[(v0 + 2 * e + 1) * 136 + kk] = (bf16_t)(w4[e] >> 16); } }
    __syncthreads();
    const int tt = wave;
    if (tt * 16 < lreal) {
        const int r = lane & 15, g = lane >> 4;
        bf16x8 qf[4];
#pragma unroll
        for (int ks = 0; ks < 4; ++ks) qf[ks] = *(const bf16x8*)(QT + (16 * tt + r) * 136 + 32 * ks + 8 * g);
        bf16x8 pf[L / 32];
#pragma unroll
        for (int p = 0; p < L / 32; ++p) {
            unsigned pw[4];
#pragma unroll
            for (int hs = 0; hs < 2; ++hs) { const int st = 2 * p + hs;
                f32x4 acc = (f32x4){0.f, 0.f, 0.f, 0.f};
                if (st <= tt) {
#pragma unroll
                    for (int ks = 0; ks < 4; ++ks) { const bf16x8 a = *(const bf16x8*)(KT + (16 * st + r) * 136 + 32 * ks + 8 * g); acc = __builtin_amdgcn_mfma_f32_16x16x32_bf16(a, qf[ks], acc, 0, 0, 0); }
#pragma unroll
                    for (int e = 0; e < 4; ++e) if (16 * st + 4 * g + e > 16 * tt + r) acc[e] = 0.f;
                }
                pw[2 * hs] = pk2(acc[0], acc[1]); pw[2 * hs + 1] = pk2(acc[2], acc[3]); }
            u32x4 t4 = (u32x4){pw[0], pw[1], pw[2], pw[3]};
            pf[p] = __builtin_bit_cast(bf16x8, t4);
        }
        f32x4 o[8]; float ss = 0.f;
#pragma unroll
        for (int vt = 0; vt < 8; ++vt) {
            f32x4 acc = (f32x4){0.f, 0.f, 0.f, 0.f};
#pragma unroll
            for (int p = 0; p < L / 32; ++p) if (2 * p <= tt) {
                const u32x2 lo = *(const u32x2*)(VT + (16 * vt + r) * VS + 32 * p + 4 * g), hi = *(const u32x2*)(VT + (16 * vt + r) * VS + 32 * p + 16 + 4 * g);
                u32x4 t4 = (u32x4){lo.x, lo.y, hi.x, hi.y};
                acc = __builtin_amdgcn_mfma_f32_16x16x32_bf16(__builtin_bit_cast(bf16x8, t4), pf[p], acc, 0, 0, 0); }
#pragma unroll
            for (int ks = 0; ks < 4; ++ks) { const bf16x8 a = *(const bf16x8*)(ST + (16 * vt + r) * 136 + 32 * ks + 8 * g); acc = __builtin_amdgcn_mfma_f32_16x16x32_bf16(a, qf[ks], acc, 0, 0, 0); }
            o[vt] = acc; ss += (acc[0] * acc[0] + acc[1] * acc[1]) + (acc[2] * acc[2] + acc[3] * acc[3]);
        }
        ss += __shfl_xor(ss, 16); ss += __shfl_xor(ss, 32);
        const float rstd = 1.0f / sqrtf(ss * (1.0f / 128) + EPSN);
        const int t = 16 * tt + r;
        if (t < lreal) {
            const size_t row = (size_t)(row0 + t);
#pragma unroll
            for (int vt = 0; vt < 8; ++vt) { const int v0 = 16 * vt + 4 * g;
                const u32x2 gw2 = *(const u32x2*)(GATE + row * 1024 + h * 128 + v0); const f32x4 gh = *(const f32x4*)(ghg + v0);
                const float g0 = __uint_as_float(gw2.x << 16), g1 = __uint_as_float(gw2.x & 0xffff0000u), g2 = __uint_as_float(gw2.y << 16), g3 = __uint_as_float(gw2.y & 0xffff0000u);
                u32x2 w; w.x = pk2(o[vt][0] * rstd * gh[0] * g0, o[vt][1] * rstd * gh[1] * g1); w.y = pk2(o[vt][2] * rstd * gh[2] * g2, o[vt][3] * rstd * gh[3] * g3);
                *(u32x2*)(MIX + row * 2048 + 1024 + h * 128 + v0) = w; }
        }
    }
    __syncthreads();
}

template <int NKS, int NDT, int KSTR, int VSTR, bool QG, int NQF>
__device__ __forceinline__ void attn_step(const bf16x8 (&qf)[NQF], const bf16_t* qg, f32x4 (&o)[NDT], float& m, float& l, const LAS unsigned char* kimg, const LAS unsigned char* vimg, int lane, bool half_valid) {
    const int r = lane & 15, g = lane >> 4;
    f32x4 s0 = (f32x4){0.f, 0.f, 0.f, 0.f}, s1 = (f32x4){0.f, 0.f, 0.f, 0.f};
    const LAS unsigned char* kp = kimg + r * (KSTR * 2) + g * 16;
    if constexpr (QG) {
#pragma unroll 1
        for (int ks3 = 0; ks3 < NKS; ks3 += 3) {
#pragma unroll
            for (int k2 = 0; k2 < 3; ++k2) { const int ks = ks3 + k2;
                const bf16x8 a0 = *(const LAS bf16x8*)(kp + ks * 64), a1 = *(const LAS bf16x8*)(kp + 16 * KSTR * 2 + ks * 64);
                const bf16x8 qv = *(const bf16x8*)(qg + 32 * ks);
                s0 = __builtin_amdgcn_mfma_f32_16x16x32_bf16(a0, qv, s0, 0, 0, 0);
                s1 = __builtin_amdgcn_mfma_f32_16x16x32_bf16(a1, qv, s1, 0, 0, 0); }
        }
    } else {
#pragma unroll
        for (int ks = 0; ks < NKS; ++ks) {
            const bf16x8 a0 = *(const LAS bf16x8*)(kp + ks * 64), a1 = *(const LAS bf16x8*)(kp + 16 * KSTR * 2 + ks * 64);
            s0 = __builtin_amdgcn_mfma_f32_16x16x32_bf16(a0, qf[ks], s0, 0, 0, 0);
            s1 = __builtin_amdgcn_mfma_f32_16x16x32_bf16(a1, qf[ks], s1, 0, 0, 0);
        }
    }
    if (half_valid) s1 = (f32x4){-INFINITY, -INFINITY, -INFINITY, -INFINITY};
    float mx = fmaxf(fmaxf(fmaxf(s0[0], s0[1]), fmaxf(s0[2], s0[3])), fmaxf(fmaxf(s1[0], s1[1]), fmaxf(s1[2], s1[3])));
    mx = fmaxf(mx, __shfl_xor(mx, 16)); mx = fmaxf(mx, __shfl_xor(mx, 32));
    const float mn = fmaxf(m, mx), alpha = exp2f(m - mn);
    f32x4 p0, p1;
#pragma unroll
    for (int e = 0; e < 4; ++e) { p0[e] = exp2f(s0[e] - mn); p1[e] = exp2f(s1[e] - mn); }
    float ls = (p0[0] + p0[1]) + (p0[2] + p0[3]) + (p1[0] + p1[1]) + (p1[2] + p1[3]);
    ls += __shfl_xor(ls, 16); ls += __shfl_xor(ls, 32);
    l = l * alpha + ls; m = mn;
    u32x4 pw = (u32x4){pk2(p0[0], p0[1]), pk2(p0[2], p0[3]), pk2(p1[0], p1[1]), pk2(p1[2], p1[3])};
    const bf16x8 pf = __builtin_bit_cast(bf16x8, pw);
    const LAS unsigned char* vp = vimg + r * (VSTR * 2) + g * 8;
#pragma unroll
    for (int dt = 0; dt < NDT; ++dt) {
        const u32x2 lo = *(const LAS u32x2*)(vp + dt * 16 * VSTR * 2), hi = *(const LAS u32x2*)(vp + dt * 16 * VSTR * 2 + 32);
        u32x4 t4 = (u32x4){lo.x, lo.y, hi.x, hi.y};
        o[dt] = __builtin_amdgcn_mfma_f32_16x16x32_bf16(__builtin_bit_cast(bf16x8, t4), pf, o[dt] * alpha, 0, 0, 0);
        if ((dt & 3) == 3) __builtin_amdgcn_sched_barrier(0);
    }
}

typedef float f32x16 __attribute__((ext_vector_type(16)));
__device__ __forceinline__ void attn_prompt_item(int b, int h, int qb, const bf16_t* Q, const bf16_t* KN, const bf16_t* KPE, const bf16_t* VT, bf16_t* MIX, LAS unsigned char* lds) {
    constexpr int KSTR = 200, VSTR = 72, KIMG = 64 * KSTR * 2, BUFB = KIMG + 128 * VSTR * 2;
    const int tid = ltid(), lane = tid & 63, wave = tid >> 6, r = lane & 31, hh = lane >> 5;
    const int nkt = 4 * qb + 4, nkw = 4 * qb + (wave >> 1) + 1;
    const size_t qrow = (size_t)b * 8192 + 256 * qb + 32 * wave + r;
    bf16x8 qf[12];
#pragma unroll
    for (int ks = 0; ks < 12; ++ks) qf[ks] = *(const bf16x8*)(Q + qrow * 1536 + h * 192 + 16 * ks + 8 * hh);
    f32x16 o[4];
#pragma unroll
    for (int dt = 0; dt < 4; ++dt)
#pragma unroll
        for (int i = 0; i < 16; ++i) o[dt][i] = 0.f;
    float m = -INFINITY, l = 0.f;
    const bf16_t* kn_src = KN + ((size_t)b * 8192 + (tid >> 4)) * 1024 + h * 128 + 8 * (tid & 15);
    const bf16_t* kp_src = KPE + ((size_t)b * 8192 + (tid >> 3)) * 64 + 8 * (tid & 7);
    const bf16_t* vt_src = VT + ((size_t)h * 128 + (tid >> 3)) * 16384 + (size_t)b * 8192 + 8 * (tid & 7);
    const int wk = (tid >> 4) * (KSTR * 2) + (tid & 15) * 16, wp = (tid >> 3) * (KSTR * 2) + 256 + (tid & 7) * 16, wv = KIMG + (tid >> 3) * (VSTR * 2) + ((tid & 7) >> 1) * 32 + ((tid & 7) & 1) * 8;
    u32x4 ak0, ak1, ap, av0, av1;
#define AT_LOAD(S_, t) do { S_##k0 = *(const u32x4*)(kn_src + (size_t)(t) * 64 * 1024); S_##k1 = *(const u32x4*)(kn_src + ((size_t)(t) * 64 + 32) * 1024); S_##p = *(const u32x4*)(kp_src + (size_t)(t) * 64 * 64); \
        S_##v0 = *(const u32x4*)(vt_src + (t) * 64); S_##v1 = *(const u32x4*)(vt_src + (size_t)64 * 16384 + (t) * 64); } while (0)
#define AT_STORE(S_, t) do { const int bo_ = ((t) & 1) * BUFB; *(LAS u32x4*)(lds + bo_ + wk) = S_##k0; *(LAS u32x4*)(lds + bo_ + wk + 32 * KSTR * 2) = S_##k1; *(LAS u32x4*)(lds + bo_ + wp) = S_##p; \
        *(LAS u32x2*)(lds + bo_ + wv) = (u32x2){S_##v0.x, S_##v0.y}; *(LAS u32x2*)(lds + bo_ + wv + 16) = (u32x2){S_##v0.z, S_##v0.w}; \
        *(LAS u32x2*)(lds + bo_ + wv + 64 * VSTR * 2) = (u32x2){S_##v1.x, S_##v1.y}; *(LAS u32x2*)(lds + bo_ + wv + 64 * VSTR * 2 + 16) = (u32x2){S_##v1.z, S_##v1.w}; } while (0)
#define AT_SUB(kt, u) do { \
            const LAS unsigned char* kimg = lds + ((kt) & 1) * BUFB + (u) * 32 * KSTR * 2; const LAS unsigned char* vimg = lds + ((kt) & 1) * BUFB + KIMG + (u) * 64; \
            f32x16 sc; \
            _Pragma("unroll") for (int i = 0; i < 16; ++i) sc[i] = 0.f; \
            const LAS unsigned char* kp = kimg + r * (KSTR * 2) + hh * 16; \
            _Pragma("unroll") for (int ks = 0; ks < 12; ++ks) { const bf16x8 a = *(const LAS bf16x8*)(kp + ks * 32); sc = __builtin_amdgcn_mfma_f32_32x32x16_bf16(a, qf[ks], sc, 0, 0, 0); } \
            float mx = sc[0]; \
            _Pragma("unroll") for (int i = 1; i < 16; ++i) mx = fmaxf(mx, sc[i]); \
            mx = fmaxf(mx, __shfl_xor(mx, 32)); \
            const float mn = fmaxf(m, mx), alpha = __builtin_amdgcn_exp2f(m - mn); \
            float ls = 0.f; \
            _Pragma("unroll") for (int i = 0; i < 16; ++i) { sc[i] = __builtin_amdgcn_exp2f(sc[i] - mn); ls += sc[i]; } \
            ls += __shfl_xor(ls, 32); \
            l = l * alpha + ls; m = mn; \
            bf16x8 pf[2]; \
            _Pragma("unroll") for (int s2 = 0; s2 < 2; ++s2) { u32x4 pw = (u32x4){pk2(sc[8 * s2], sc[8 * s2 + 1]), pk2(sc[8 * s2 + 2], sc[8 * s2 + 3]), pk2(sc[8 * s2 + 4], sc[8 * s2 + 5]), pk2(sc[8 * s2 + 6], sc[8 * s2 + 7])}; pf[s2] = __builtin_bit_cast(bf16x8, pw); } \
            const LAS unsigned char* vp = vimg + r * (VSTR * 2) + hh * 16; \
            _Pragma("unroll") for (int dt = 0; dt < 4; ++dt) { \
                f32x16 acc = o[dt] * alpha; \
                _Pragma("unroll") for (int s2 = 0; s2 < 2; ++s2) { \
                    const bf16x8 va = *(const LAS bf16x8*)(vp + dt * 32 * VSTR * 2 + s2 * 32); \
                    acc = __builtin_amdgcn_mfma_f32_32x32x16_bf16(va, pf[s2], acc, 0, 0, 0); } \
                o[dt] = acc; } } while (0)
#define AT_COMPUTE(kt) do { if ((kt) < nkw) { AT_SUB(kt, 0); AT_SUB(kt, 1); } } while (0)
    AT_LOAD(a, 0); AT_STORE(a, 0); AT_LOAD(a, 1);
    __syncthreads();
    for (int kt = 0; kt < nkt; ++kt) {
        AT_COMPUTE(kt);
        if (kt + 1 < nkt) AT_STORE(a, kt + 1);
        if (kt + 2 < nkt) AT_LOAD(a, kt + 2);
        __syncthreads();
    }
#undef AT_LOAD
#undef AT_STORE
#undef AT_SUB
#undef AT_COMPUTE
    const float inv = 1.0f / l;
#pragma unroll
    for (int dt = 0; dt < 4; ++dt)
#pragma unroll
        for (int ig = 0; ig < 4; ++ig) { u32x2 w; w.x = pk2(o[dt][4 * ig] * inv, o[dt][4 * ig + 1] * inv); w.y = pk2(o[dt][4 * ig + 2] * inv, o[dt][4 * ig + 3] * inv);
            *(u32x2*)(MIX + qrow * 2048 + h * 128 + 32 * dt + 8 * ig + 4 * hh) = w; }
}

constexpr int NSPL = 8;
__device__ __forceinline__ void attn_sample_item(int b, int sp, const bf16_t* Q, const bf16_t* WUKO, const float* cckv, const float* ckpe, const bf16_t* CKV, const bf16_t* KPE, bf16_t* QLAT, bf16_t* PO, float* PML, LAS unsigned char* lds) {
    constexpr int KSTR = 584, VSTR = 36;
    const int tid = ltid(), lane = tid & 63, h = tid >> 6, r = lane & 15, g = lane >> 4;
    LAS unsigned char* kimg = lds; LAS unsigned char* vimg = lds + 32 * KSTR * 2;
    const size_t qrow0 = (size_t)MP + (size_t)b * 16;
    bf16_t* ql = QLAT + ((size_t)b * 8 + h) * 16 * 576;
    {
        bf16x8 aq[4];
#pragma unroll
        for (int ks = 0; ks < 4; ++ks) aq[ks] = *(const bf16x8*)(Q + (qrow0 + r) * 1536 + h * 192 + 32 * ks + 8 * g);
#pragma unroll 8
        for (int ct = 0; ct < 32; ++ct) {
            f32x4 acc = (f32x4){0.f, 0.f, 0.f, 0.f};
#pragma unroll
            for (int ks = 0; ks < 4; ++ks) { const bf16x8 bw = *(const bf16x8*)(WUKO + (size_t)(16 * ct + r) * 1024 + h * 128 + 32 * ks + 8 * g); acc = __builtin_amdgcn_mfma_f32_16x16x32_bf16(bw, aq[ks], acc, 0, 0, 0); }
            u32x2 w; w.x = pk2(acc[0], acc[1]); w.y = pk2(acc[2], acc[3]);
            *(u32x2*)(ql + r * 576 + 16 * ct + 4 * g) = w;
        }
#pragma unroll
        for (int i = 0; i < 2; ++i) { const int pc = lane + 64 * i, qq = pc >> 3, cc = pc & 7;
            *(u32x4*)(ql + qq * 576 + 512 + 8 * cc) = *(const u32x4*)(Q + (qrow0 + qq) * 1536 + h * 192 + 128 + 8 * cc); }
    }
    __threadfence(); __syncthreads();
    const bf16_t* qg = ql + r * 576 + 8 * g;
    f32x4 o[32];
#pragma unroll
    for (int dt = 0; dt < 32; ++dt) o[dt] = (f32x4){0.f, 0.f, 0.f, 0.f};
    float m = -INFINITY, l = 0.f;
    const float* cb = cckv + (size_t)b * 2048 * 512; const float* pb = ckpe + (size_t)b * 2048 * 64;
    const int kt0 = sp * 8, kt1 = (sp == NSPL - 1) ? 65 : kt0 + 8;
    for (int kt = kt0; kt < kt1; ++kt) {
        __syncthreads();
        if (kt < 64) {
            const int c = tid;
            float v[32];
#pragma unroll
            for (int kk = 0; kk < 32; ++kk) v[kk] = cb[(size_t)(32 * kt + kk) * 512 + c];
            const int key = tid >> 4, i4 = (tid & 15) * 4; const f32x4 pv = *(const f32x4*)(pb + (size_t)(32 * kt + key) * 64 + i4);
#pragma unroll
            for (int kk = 0; kk < 32; kk += 2) {
                const unsigned pw = pk2(v[kk], v[kk + 1]);
                *(LAS bf16_t*)(kimg + kk * (KSTR * 2) + c * 2) = (bf16_t)(pw & 0xffffu);
                *(LAS bf16_t*)(kimg + (kk + 1) * (KSTR * 2) + c * 2) = (bf16_t)(pw >> 16);
                *(LAS unsigned*)(vimg + c * (VSTR * 2) + kk * 2) = pw;
            }
#pragma unroll
            for (int e = 0; e < 4; ++e) { const int i = i4 + e, pi = i < 32 ? 2 * i : 2 * (i - 32) + 1;
                *(LAS bf16_t*)(kimg + key * (KSTR * 2) + (512 + pi) * 2) = (bf16_t)(pk2(pv[e], 0.f) & 0xffffu); }
        } else {
            const int c = tid;
#pragma unroll 4
            for (int kk = 0; kk < 32; kk += 2) {
                unsigned pw = 0u;
                if (kk < 16) { const unsigned a = CKV[(qrow0 + kk) * 512 + c], bb = CKV[(qrow0 + kk + 1) * 512 + c]; pw = a | (bb << 16); }
                *(LAS bf16_t*)(kimg + kk * (KSTR * 2) + c * 2) = (bf16_t)(pw & 0xffffu);
                *(LAS bf16_t*)(kimg + (kk + 1) * (KSTR * 2) + c * 2) = (bf16_t)(pw >> 16);
                *(LAS unsigned*)(vimg + c * (VSTR * 2) + kk * 2) = pw;
            }
            { const int key = tid >> 4, i4 = (tid & 15) * 4;
              u32x2 w = (u32x2){0u, 0u}; if (key < 16) w = *(const u32x2*)(KPE + (qrow0 + key) * 64 + i4);
              *(LAS u32x2*)(kimg + key * (KSTR * 2) + (512 + i4) * 2) = w; }
        }
        bf16x8 qv[18];
#pragma unroll
        for (int ks = 0; ks < 18; ++ks) qv[ks] = *(const bf16x8*)(qg + 32 * ks);
        __syncthreads();
        attn_step<18, 32, KSTR, VSTR, false, 18>(qv, nullptr, o, m, l, kimg, vimg, lane, kt == 64);
    }
    const float inv = 1.0f / l;
    const size_t pi = (((size_t)b * NSPL + sp) * 8 + h) * 16 + r;
    bf16_t* po = PO + pi * 512 + 4 * g;
#pragma unroll
    for (int dt = 0; dt < 32; ++dt) { u32x2 w; w.x = pk2(o[dt][0] * inv, o[dt][1] * inv); w.y = pk2(o[dt][2] * inv, o[dt][3] * inv); *(u32x2*)(po + 16 * dt) = w; }
    if (g == 0) *(f32x2*)(PML + pi * 2) = (f32x2){m, l};
    __syncthreads();
}
__device__ __forceinline__ void attn_sample_combine(int b, int h, const bf16_t* PO, const float* PML, const bf16_t* WUVT, bf16_t* MIX, LAS unsigned char* lds) {
    const int tid = ltid(), lane = tid & 63, wave = tid >> 6, r = lane & 15, g = lane >> 4;
    float ms[NSPL], cs[NSPL], M = -INFINITY, L = 0.f;
#pragma unroll
    for (int sp = 0; sp < NSPL; ++sp) { const f32x2 ml = *(const f32x2*)(PML + ((((size_t)b * NSPL + sp) * 8 + h) * 16 + r) * 2); ms[sp] = ml.x; cs[sp] = ml.y; M = fmaxf(M, ml.x); }
#pragma unroll
    for (int sp = 0; sp < NSPL; ++sp) { cs[sp] *= __builtin_amdgcn_exp2f(ms[sp] - M); L += cs[sp]; }
    const float invL = 1.0f / L;
#pragma unroll
    for (int sp = 0; sp < NSPL; ++sp) cs[sp] *= invL;
#pragma unroll
    for (int s2 = 0; s2 < 2; ++s2) { const int s = 2 * wave + s2;
        f32x4 a0 = (f32x4){0.f, 0.f, 0.f, 0.f}, a1 = (f32x4){0.f, 0.f, 0.f, 0.f};
#pragma unroll
        for (int sp = 0; sp < NSPL; ++sp) {
            const bf16_t* po = PO + ((((size_t)b * NSPL + sp) * 8 + h) * 16 + r) * 512 + 32 * s + 4 * g;
            const u32x2 w0 = *(const u32x2*)po, w1 = *(const u32x2*)(po + 16);
            a0 += cs[sp] * (f32x4){__uint_as_float(w0.x << 16), __uint_as_float(w0.x & 0xffff0000u), __uint_as_float(w0.y << 16), __uint_as_float(w0.y & 0xffff0000u)};
            a1 += cs[sp] * (f32x4){__uint_as_float(w1.x << 16), __uint_as_float(w1.x & 0xffff0000u), __uint_as_float(w1.y << 16), __uint_as_float(w1.y & 0xffff0000u)};
        }
        *(LAS u32x4*)(lds + (s * 64 + lane) * 16) = (u32x4){pk2(a0[0], a0[1]), pk2(a0[2], a0[3]), pk2(a1[0], a1[1]), pk2(a1[2], a1[3])};
    }
    __syncthreads();
    const size_t qrow0 = (size_t)MP + (size_t)b * 16;
    const int dt = wave;
    f32x4 acc = (f32x4){0.f, 0.f, 0.f, 0.f};
    const bf16_t* wp = WUVT + (size_t)(h * 128 + 16 * dt + r) * 512 + 4 * g;
#pragma unroll
    for (int s = 0; s < 16; ++s) {
        const u32x2 lo = *(const u32x2*)(wp + 32 * s), hi = *(const u32x2*)(wp + 32 * s + 16);
        u32x4 t4 = (u32x4){lo.x, lo.y, hi.x, hi.y};
        const bf16x8 pf = *(const LAS bf16x8*)(lds + (s * 64 + lane) * 16);
        acc = __builtin_amdgcn_mfma_f32_16x16x32_bf16(__builtin_bit_cast(bf16x8, t4), pf, acc, 0, 0, 0);
    }
    u32x2 w; w.x = pk2(acc[0], acc[1]); w.y = pk2(acc[2], acc[3]);
    *(u32x2*)(MIX + (qrow0 + r) * 2048 + h * 128 + 16 * dt + 4 * g) = w;
    __syncthreads();
}

#define XB_TMO      128
#define XB_XCNT(j)  (256  + 64 * (j))
#define XB_XSUB(j)  (1280 + 64 * (j))
#define XB_XGEN(j)  (2304 + 64 * (j))
#define XB_TOP      3328
#define XB_TOPGEN   3392
#define XCD_BAR_WORDS 3456
#define XB_SPIN_CAP (1u << 18)
__device__ __forceinline__ unsigned xb_ld(unsigned* p)              { return __hip_atomic_load(p, __ATOMIC_RELAXED, __HIP_MEMORY_SCOPE_AGENT); }
__device__ __forceinline__ unsigned xb_add(unsigned* p, unsigned v) { return __hip_atomic_fetch_add(p, v, __ATOMIC_RELAXED, __HIP_MEMORY_SCOPE_AGENT); }
__device__ __forceinline__ unsigned xb_xcc_id() { return (unsigned)__builtin_amdgcn_s_getreg((3 << 11) | 20) & 0xFu; }
#define XB_SPIN(cond, bar) do { unsigned _sp = 0; while (cond) { __builtin_amdgcn_s_sleep(1); \
    if ((++_sp & 255u) == 0u) { if (xb_ld(&(bar)[XB_TMO])) break; if (_sp > XB_SPIN_CAP) { atomicAdd(&(bar)[XB_TMO], 1u); break; } } } } while (0)
struct XcdBarrier { unsigned* bar; unsigned x; volatile LAS unsigned* st; };
__device__ __forceinline__ XcdBarrier xcd_barrier_post(unsigned* bar, volatile LAS unsigned* st) {
    XcdBarrier b; b.bar = bar; b.x = xb_xcc_id(); b.st = st;
    if (threadIdx.x == 0) (void)xb_add(&bar[XB_XCNT(b.x)], 1u);
    return b;
}
__device__ __forceinline__ void xcd_barrier_complete(unsigned* bar, unsigned x, unsigned& nloc, unsigned& nx) {
    const unsigned G = gridDim.x * gridDim.y * gridDim.z;
    unsigned sum, cnt, mine, sp = 0u;
    for (;;) {
        sum = 0u; cnt = 0u; mine = 0u;
#pragma unroll
        for (unsigned j = 0; j < 16; ++j) { const unsigned c = xb_ld(&bar[XB_XCNT(j)]); sum += c; cnt += (c > 0u) ? 1u : 0u; mine = (j == x) ? c : mine; }
        if (sum == G) break;
        __builtin_amdgcn_s_sleep(1);
        if ((++sp & 255u) == 0u) { if (xb_ld(&bar[XB_TMO])) break; if (sp > XB_SPIN_CAP) { atomicAdd(&bar[XB_TMO], 1u); break; } }
    }
    nloc = mine > 0u ? mine : 1u; nx = cnt > 0u ? cnt : 1u;
}
__device__ __forceinline__ void xcd_barrier(const XcdBarrier& b) {
    asm volatile("s_waitcnt vmcnt(0)" ::: "memory");
    __syncthreads();
    if (threadIdx.x == 0) {
        unsigned* bar = b.bar;
        __builtin_amdgcn_s_waitcnt(0);
        unsigned nloc = b.st[0], nx = b.st[1];
        if (nloc == 0u) { xcd_barrier_complete(bar, b.x, nloc, nx); b.st[0] = nloc; b.st[1] = nx; }
        const unsigned old = xb_add(&bar[XB_XSUB(b.x)], 1u);
        const unsigned gen = old / nloc;
        if (old + 1u == (gen + 1u) * nloc) {
            __builtin_amdgcn_fence(__ATOMIC_RELEASE, "agent");
            asm volatile("s_waitcnt vmcnt(0)" ::: "memory");
            const unsigned og = xb_add(&bar[XB_TOP], 1u);
            const unsigned tg = og / nx;
            if (og + 1u == (tg + 1u) * nx) xb_add(&bar[XB_TOPGEN], 1u);
            else XB_SPIN(xb_ld(&bar[XB_TOPGEN]) == tg, bar);
            __builtin_amdgcn_fence(__ATOMIC_ACQUIRE, "agent");
            xb_add(&bar[XB_XGEN(b.x)], 1u);
            asm volatile("s_waitcnt vmcnt(0)" ::: "memory");
        } else {
            XB_SPIN(xb_ld(&bar[XB_XGEN(b.x)]) == gen, bar);
            __builtin_amdgcn_fence(__ATOMIC_ACQUIRE, "agent");
            asm volatile("s_waitcnt vmcnt(0)" ::: "memory");
        }
    }
    __syncthreads();
}

__device__ __forceinline__ void gsync(cg::grid_group& grid) {
    asm volatile("s_waitcnt vmcnt(0) lgkmcnt(0)" ::: "memory");
    grid.sync();
    __builtin_amdgcn_fence(__ATOMIC_ACQUIRE, "agent");
    asm volatile("s_waitcnt vmcnt(0)" ::: "memory");
}
struct Params { const float* in[21]; float* out; unsigned char* ws; };

__global__ void __launch_bounds__(512) mega(Params p) {
    extern __shared__ __attribute__((aligned(16))) unsigned char lds[];
    cg::grid_group grid = cg::this_grid();
    LAS unsigned char* ldsl = (LAS unsigned char*)lds;
    unsigned char* ws = p.ws; float* out = p.out; unsigned char* outb = (unsigned char*)p.out;
    const int G = gridDim.x, bx = blockIdx.x, tid = threadIdx.x;
    float* MOD = (float*)(ws + WS_MOD); const float* bada = p.in[8];
    const f32x2* ROPE = (const f32x2*)(ws + WS_ROPE);
    bf16_t* H = (bf16_t*)(ws + WS_H);
    float* Gb = (float*)(outb + OB_G); bf16_t* QH = (bf16_t*)(outb + OB_QH); bf16_t* VH = (bf16_t*)(outb + OB_VH);
    bf16_t* GATE = (bf16_t*)(ws + WS_GATE); bf16_t* KPE = (bf16_t*)(ws + WS_KPE); float* CQKV = (float*)(ws + WS_CQKV);
    bf16_t* Qb = (bf16_t*)(ws + WS_Q); bf16_t* CQN = (bf16_t*)(ws + WS_CQN); bf16_t* QLAT = (bf16_t*)(ws + WS_QLAT); bf16_t* CKV = (bf16_t*)(ws + WS_CKV);
    bf16_t* U = (bf16_t*)(ws + WS_U); bf16_t* MIX = (bf16_t*)(ws + WS_MIX); float* DD = (float*)(ws + WS_DD); bf16_t* Sn = (bf16_t*)(ws + WS_S);
    bf16_t* KN = (bf16_t*)(ws + WS_KN); bf16_t* VT = (bf16_t*)(ws + WS_VT); bf16_t* FFH = (bf16_t*)(ws + WS_FFH);
    float* X = out + O_Y;
    pg8::StaticOrder S;
    volatile LAS unsigned* xst = (volatile LAS unsigned*)(ldsl + LDS_Q + 16);
    if (tid == 0) { xst[0] = 0u; xst[1] = 0u; }
    __syncthreads();
    const XcdBarrier xbar = xcd_barrier_post((unsigned*)(ws + WS_BAR), xst);

#ifdef FILLTEST
    for (size_t i = (size_t)bx * 512 + tid; i < 48791552; i += (size_t)G * 512) out[i] = 0.5f;
#endif
    if (PHMASK & 1) phase0(p.in, ws, lds);
#ifdef PROBE_P0
    gsync(grid);
    phase0(p.in, ws, lds);
#endif
    xcd_barrier(xbar);
#ifdef PROBE_SYNC
    for (int z = 0; z < 10; ++z) xcd_barrier(xbar);
#endif
    if (PHMASK & 2) adaln_rows<0>(p.in[0], p.in[1], MOD, bada, 0, 2048, H);
    xcd_barrier(xbar);
    if (PHMASK & 4) { EpiIn E{CQKV, QH, Gb, VH, GATE, KPE, ROPE, out + O_KPE_P, out + O_KPE_S, p.in[15]};
      S.init(MT, NINP, 2048, G, bx); pg8::gemm_phase(ldsl, pg8::Gemm{H, (const bf16_t*)(ws + WS_WIN), MT, NINP, 2048}, S, E); }
    xcd_barrier(xbar);
    if (PHMASK & 8) latent_rows(CQKV, p.in[11], p.in[12], CQN, CKV, out + O_CKV_P, out + O_CKV_S);
    if (PHMASK & 16) for (int it = bx; it < NCHUNK; it += G) {
        if (it < NCHUNK_P) hgrn_a<64>(it, it >> 7, (it >> 10) * 8192 + (it & 127) * 64, 64, Gb, VH, U, DD, lds);
        else hgrn_a<32>(it, it - NCHUNK_P, MP + ((it - NCHUNK_P) >> 3) * 16, 16, Gb, VH, U, DD, lds);
    }
#ifdef PROBE_MISC
    xcd_barrier(xbar);
    latent_rows(CQKV, p.in[11], p.in[12], CQN, CKV, out + O_CKV_P, out + O_CKV_S);
    for (int it = bx; it < NCHUNK; it += G) {
        if (it < NCHUNK_P) hgrn_a<64>(it, it >> 7, (it >> 10) * 8192 + (it & 127) * 64, 64, Gb, VH, U, DD, lds);
        else hgrn_a<32>(it, it - NCHUNK_P, MP + ((it - NCHUNK_P) >> 3) * 16, 16, Gb, VH, U, DD, lds);
    }
#endif
    xcd_barrier(xbar);
    if (PHMASK & 32) { EpiQ E{Qb, ROPE}; S.init(MT, 1536, 512, G, bx); pg8::gemm_phase(ldsl, pg8::Gemm{CQN, (const bf16_t*)(ws + WS_WUQ), MT, 1536, 512}, S, E); }
    if (PHMASK & 32) { EpiPlain E{KN, 1024}; S.init(MP, 1024, 512, G, bx); pg8::gemm_phase(ldsl, pg8::Gemm{CKV, (const bf16_t*)(ws + WS_WUK), MP, 1024, 512}, S, E); }
    if (PHMASK & 32) { EpiPlain E{VT, 16384}; S.init(1024, MP, 512, G, bx); pg8::gemm_phase(ldsl, pg8::Gemm{(const bf16_t*)(ws + WS_WUV), CKV, 1024, MP, 512}, S, E); }
    if (PHMASK & 64) hgrn_b(U, DD, Sn, p.in[6], out + O_ST_P, out + O_ST_S);
#ifdef PROBE_MISC
    xcd_barrier(xbar);
    hgrn_b(U, DD, Sn, p.in[6], out + O_ST_P, out + O_ST_S);
#endif
    xcd_barrier(xbar);
    for (int p5rep = 0; p5rep < P5REPS; ++p5rep) {
    if (p5rep) xcd_barrier(xbar);
    if (PHMASK & 0x380) {
        unsigned* ctr = (unsigned*)(ws + WS_CTL) + p5rep * 64;
        volatile int* qslot = (volatile int*)(lds + LDS_Q);
        for (;;) {
            __syncthreads();
            if (tid == 0) *qslot = (int)__hip_atomic_fetch_add(ctr, 1u, __ATOMIC_RELAXED, __HIP_MEMORY_SCOPE_AGENT);
            __syncthreads();
            const int it = *qslot;
            if (it >= 256 + 512 + NCHUNK) break;
            const int pm_ = p5rep ? (P5MASK2) : 0x380;
            if (it < 256) { if (pm_ & 128) attn_sample_item(it >> 3, it & 7, Qb, (const bf16_t*)(ws + WS_WUKO), p.in[4], p.in[5], CKV, KPE, QLAT, (bf16_t*)(ws + WS_PO), (float*)(ws + WS_PML), ldsl); }
            else if (it < 256 + 512) { if (pm_ & 256) { const int j = it - 256, qb = 31 - (j >> 4), bh = j & 15; attn_prompt_item(bh >> 3, bh & 7, qb, Qb, KN, KPE, VT, MIX, ldsl); } }
            else if (pm_ & 512) { const int c = it - 768;
                if (c < NCHUNK_P) hgrn_c<64>(c, c >> 7, (c >> 10) * 8192 + (c & 127) * 64, 64, Gb, QH, VH, GATE, Sn, p.in[16], MIX, lds);
                else hgrn_c<32>(c, c - NCHUNK_P, MP + ((c - NCHUNK_P) >> 3) * 16, 16, Gb, QH, VH, GATE, Sn, p.in[16], MIX, lds); }
        }
    }
    }
    xcd_barrier(xbar);
    for (int ci = bx; ci < 256; ci += G) attn_sample_combine(ci >> 3, ci & 7, (const bf16_t*)(ws + WS_PO), (const float*)(ws + WS_PML), (const bf16_t*)(ws + WS_WUV), MIX, ldsl);
    xcd_barrier(xbar);
    if (PHMASK & 1024) { EpiRes E{p.in[0], p.in[1], X, MOD, bada, 4096, (float*)(ws + WS_CQKV)}; if (G == 256) S.init(MP, 2048, 2048, G, bx, 8, 64, 16); else S.init(MT, 2048, 2048, G, bx); pg8::gemm_phase(ldsl, pg8::Gemm{MIX, (const bf16_t*)(ws + WS_WOUT), MT, 2048, 2048}, S, E); }
    xcd_barrier(xbar);
    if (PHMASK & 2048) { if (G == 256) adaln_rows<8>(X, p.in[1], MOD, bada, 6144, 8192, H, (const float*)(ws + WS_CQKV), 4096, X); else adaln_rows<0>(X, X + (size_t)MP * DM, MOD, bada, 6144, 8192, H); }
    xcd_barrier(xbar);
#ifdef PROBE_P8
    { EpiRelu2 E{FFH}; S.init(MT, DFF, 2048, G, bx); pg8::gemm_phase(ldsl, pg8::Gemm{H, (const bf16_t*)(ws + WS_WFF1), MT, DFF, 2048}, S, E); }
    xcd_barrier(xbar);
#endif
    if (PHMASK & 4096) { EpiRelu2 E{FFH}; S.init(MT, DFF, 2048, G, bx); pg8::gemm_phase(ldsl, pg8::Gemm{H, (const bf16_t*)(ws + WS_WFF1), MT, DFF, 2048}, S, E); }
    xcd_barrier(xbar);
    if (PHMASK & 8192) { EpiRes E{X, X + (size_t)MP * DM, X, MOD, bada, 10240, (float*)(ws + WS_H)}; if (G == 256) S.init(MP, 2048, DFF, G, bx, 16, 64, 16); else S.init(MT, 2048, DFF, G, bx); pg8::gemm_phase(ldsl, pg8::Gemm{FFH, (const bf16_t*)(ws + WS_WFF2), MT, 2048, DFF}, S, E); }
    xcd_barrier(xbar);
    if (PHMASK & 16384) { if (G == 256) final_rows<16>(X, p.in[20], (const float*)(ws + WS_H), MOD, bada); else final_rows<0>(X, p.in[20], nullptr, MOD, bada); }
}

extern "C" void kernel_launch(void* const* d_in, const int* in_sizes, int n_in, void* d_out, int out_size, void* d_ws, size_t ws_size, hipStream_t stream) {
    static int grid_blocks = 0;
    if (grid_blocks == 0) {
        if (n_in != 21 || ws_size < WS_TOTAL) { fprintf(stderr, "kernel_launch: unexpected n_in %d or workspace %zu < %zu\n", n_in, ws_size, (size_t)WS_END); grid_blocks = -1; return; }
        int dev = 0, cus = 0, per_cu = 0;
        hipGetDevice(&dev);
        hipDeviceGetAttribute(&cus, hipDeviceAttributeMultiprocessorCount, dev);
        if (hipFuncSetAttribute((const void*)mega, hipFuncAttributeMaxDynamicSharedMemorySize, LDS_BYTES) != hipSuccess) { fprintf(stderr, "kernel_launch: hipFuncSetAttribute failed\n"); }
        if (hipOccupancyMaxActiveBlocksPerMultiprocessor(&per_cu, (const void*)mega, 512, LDS_BYTES) != hipSuccess || per_cu < 1) { fprintf(stderr, "kernel_launch: occupancy query gave %d\n", per_cu); per_cu = 1; }
        (void)hipGetLastError();
        grid_blocks = cus * 1;
    }
    if (grid_blocks < 0) return;
    (void)hipMemsetAsync((char*)d_ws + WS_BAR, 0, XCD_BAR_WORDS * 4, stream);
    Params p{};
    for (int i = 0; i < 21; ++i) p.in[i] = (const float*)d_in[i];
    p.out = (float*)d_out; p.ws = (unsigned char*)d_ws;
    void* args[] = {&p};
    hipError_t e = hipLaunchCooperativeKernel((const void*)mega, dim3(grid_blocks), dim3(512), args, LDS_BYTES, stream);
    if (e != hipSuccess) fprintf(stderr, "cooperative launch failed: %s (grid %d)\n", hipGetErrorString(e), grid_blocks);
}
```

```cpp
#include <hip/hip_runtime.h>
#include <hip/hip_cooperative_groups.h>
#include <cstdio>
namespace cg = cooperative_groups;

#define LAS __attribute__((address_space(3)))
typedef unsigned short bf16_t;
typedef short bf16x8 __attribute__((ext_vector_type(8)));
typedef float f32x4 __attribute__((ext_vector_type(4)));
typedef float f32x2 __attribute__((ext_vector_type(2)));
typedef unsigned u32x4 __attribute__((ext_vector_type(4)));
typedef unsigned u32x2 __attribute__((ext_vector_type(2)));

constexpr int MP = 16384, MS = 512, MT = MP + MS;
constexpr int DM = 2048, NMOD = 12288, NINP = 5376, DFF = 8192;
constexpr float EPSN = 1e-6f;
constexpr float QSCALE = 0.07216878364870322f * 1.4426950408889634f;
constexpr int NCHUNK_P = 2048, NCHUNK = 2304;

constexpr size_t O_Y = 0, O_CKV_P = 34603008, O_KPE_P = 42991616, O_ST_P = 44040192, O_CKV_S = 44302336, O_KPE_S = 44564480, O_ST_S = 44597248;
constexpr size_t OB_G = 0, OB_QH = 69206016, OB_VH = 103809024;
constexpr size_t WS_CTL = 0, WS_MOD = 4096, WS_ZERO_BYTES = 4096 + 34 * 12288 * 4;
constexpr size_t WS_ROPE = 1675264;
constexpr size_t WS_WIN = WS_ROPE + 2097152;
constexpr size_t WS_WUQ = WS_WIN + (size_t)NINP * 2048 * 2;
constexpr size_t WS_WUK = WS_WUQ + 1536 * 512 * 2;
constexpr size_t WS_WUV = WS_WUK + 1024 * 512 * 2;
constexpr size_t WS_WUKO = WS_WUV + 1024 * 512 * 2;
constexpr size_t WS_WOUT = WS_WUKO + 1024 * 512 * 2;
constexpr size_t WS_WFF1 = WS_WOUT + 2048 * 2048 * 2;
constexpr size_t WS_WFF2 = WS_WFF1 + (size_t)8192 * 2048 * 2;
constexpr size_t WS_H = WS_WFF2 + (size_t)8192 * 2048 * 2;
constexpr size_t WS_KN = WS_H, WS_VT = WS_H + (size_t)MP * 1024 * 2;
constexpr size_t WS_ARENA = WS_H + (size_t)MT * 2048 * 2;
constexpr size_t WS_GATE = WS_ARENA;
constexpr size_t WS_KPE = WS_GATE + (size_t)MT * 1024 * 2;
constexpr size_t WS_CQKV = WS_KPE + (size_t)MT * 64 * 2;
constexpr size_t WS_Q = WS_CQKV;
constexpr size_t WS_CQN = WS_CQKV + (size_t)MT * 1024 * 4;
constexpr size_t WS_QLAT = WS_WIN;
constexpr size_t WS_PO = WS_CQKV + (size_t)MT * 1536 * 2;
constexpr size_t WS_PML = WS_PO + (size_t)256 * 8 * 16 * 512 * 2;
constexpr size_t WS_CKV = WS_CQN + (size_t)MT * 512 * 2;
constexpr size_t WS_U = WS_CKV + (size_t)MT * 512 * 2;
constexpr size_t WS_MIX = WS_U;
constexpr size_t WS_DD = WS_U + (size_t)NCHUNK * 16384 * 2;
constexpr size_t WS_S = WS_DD + (size_t)NCHUNK * 128 * 4;
constexpr size_t WS_END = WS_S + (size_t)NCHUNK * 16384 * 2;
constexpr size_t WS_FFH = WS_ARENA;
constexpr size_t WS_BAR = WS_END, WS_TOTAL = WS_END + 16384;
static_assert(WS_ARENA + (size_t)MT * DFF * 2 <= WS_END, "ffh overlay");
static_assert(WS_PML + 256 * 8 * 16 * 2 * 4 <= WS_CKV, "sample partials");
static_assert((size_t)32 * 8 * 16 * 576 * 2 <= (size_t)NINP * 2048 * 2, "qlat");

#ifndef P5MASK2
#define P5MASK2 0x380
#endif
#ifndef P5REPS
#define P5REPS 1
#endif
#ifndef PHMASK
#define PHMASK 0xFFFF
#endif
constexpr int LDS_BYTES = 131072 + 256;
constexpr int LDS_Q = 131072;

typedef __bf16 bf16v2 __attribute__((ext_vector_type(2)));
__device__ __forceinline__ unsigned pk2(float lo, float hi) { const f32x2 v = (f32x2){lo, hi}; const bf16v2 b = __builtin_convertvector(v, bf16v2); return __builtin_bit_cast(unsigned, b); }
__device__ __forceinline__ float bf2f(bf16_t b) { return __uint_as_float(((unsigned)b) << 16); }
__device__ __forceinline__ float wave_sum(float v) {
#pragma unroll
    for (int o = 1; o < 64; o <<= 1) v += __shfl_xor(v, o);
    return v;
}
__device__ __forceinline__ int ltid() { int t = threadIdx.x; asm volatile("" : "+v"(t)); return t; }
__device__ __forceinline__ float silu_f(float v) { return v * __builtin_amdgcn_rcpf(1.0f + __expf(-v)); }
__device__ __forceinline__ int row_pos(int r) { return r < MP ? (r & 8191) : 2048 + ((r - MP) & 15); }
__device__ __forceinline__ int row_ci(int r) { return r < MP ? (r >> 13) : 2 + ((r - MP) >> 4); }

namespace pg8 {
constexpr int BM = 256, BK = 64, HALF = 128, HTB = HALF * BK * 2, STAGE_BYTES = 8 * HTB, NXCD = 8, WGM = 8;
__host__ __device__ __forceinline__ int lds_byte(int r, int c) { const int st = (r >> 4) * 2 + (c >> 5), rr = r & 15, cc = c & 31, ob = rr * 64 + cc * 2; return st * 1024 + (ob ^ (((ob >> 9) & 1) << 5)); }
__host__ __device__ __forceinline__ void stage_rc(int b, int& R, int& C) { const int st = b / 1024, sb = b % 1024, swz = sb ^ (((sb >> 9) & 1) << 5); R = (st >> 1) * 16 + swz / 64; C = (st & 1) * 32 + (swz % 64) / 2; }
struct Unit { int pm, pn, k0, nt, sl; };
struct Gemm { const bf16_t* A; const bf16_t* Bt; int M, N, K; };
struct StaticOrder {
    int nM, nN, nwg, G, c, ntK, ns, tail_pm0, ntail;
    __host__ __device__ void init(int M, int N, int K, int G_, int c_, int ns_ = 1, int tail_pm0_ = 0, int ntail_ = 0) { nM = M / BM; nN = N / BM; nwg = nM * nN; G = G_; c = c_; ntK = K / BK; ns = ns_; tail_pm0 = tail_pm0_; ntail = ntail_; }
    __host__ __device__ __forceinline__ void unit_of(int L, Unit& u) const {
        int wgid = L; { const int q = nwg / NXCD, r = nwg % NXCD, xcd = wgid % NXCD, off = wgid / NXCD; wgid = (xcd < r ? xcd * (q + 1) : r * (q + 1) + (xcd - r) * q) + off; }
        const int nig = WGM * nN, gid = wgid / nig, fm = gid * WGM, gsz = (nM - fm) < WGM ? (nM - fm) : WGM;
        u.pm = fm + ((wgid % nig) % gsz); u.pn = (wgid % nig) / gsz;
    }
    __host__ __device__ __forceinline__ bool next(int i, Unit& u) const {
        int L = i * G + c, k0 = 0, nt = ntK, sl = 0; bool ok = L < nwg;
        if (!ok) L = 0;
        unit_of(L, u);
        if (ns > 1) {
            const int rounds = nwg / G, idx = c / ns;
            const bool tail = (i == rounds) && (idx < ntail);
            if (tail) { nt = ntK / ns; k0 = (c % ns) * nt * BK; sl = 1; u.pm = tail_pm0 + idx / nN; u.pn = idx % nN; ok = true; }
        }
        u.k0 = k0; u.nt = nt; u.sl = sl; return ok;
    }
};
template <class Epi>
__device__ __forceinline__ void gemm_phase(LAS unsigned char* lds, const Gemm g, const StaticOrder& S, const Epi& E) {
    const int tid = ltid(), wid = __builtin_amdgcn_readfirstlane(tid >> 6), lane = tid & 63, wr = wid >> 2, wc = wid & 3, fr = lane & 15, fq = lane >> 4;
    const int K = g.K;
    unsigned voffA[2], voffB[2];
#pragma unroll
    for (int i = 0; i < 2; ++i) { int R, C; stage_rc(tid * 16 + i * 8192, R, C); voffA[i] = (unsigned)(R * K + C) * 2u; voffB[i] = (unsigned)(R * K + C) * 2u; }
    const size_t kstep = (size_t)(BK * 2);
    const size_t hstep = (size_t)HALF * K * 2;
    const size_t tstep = 2 * hstep;
    const unsigned ldsw = (unsigned)wid * 1024u;
    const int aoff = lds_byte(wr * 64 + fr, fq * 8), boff = lds_byte(wc * 32 + fr, fq * 8);
#define PG8_SA(b, h) (((b) * 2 + (h)) * HTB)
#define PG8_SB(b, h) ((4 + (b) * 2 + (h)) * HTB)
#define PG8_STAGE(bufoff, gbase, voff) do { _Pragma("unroll") for (int _i = 0; _i < 2; ++_i) \
        __builtin_amdgcn_global_load_lds((const unsigned*)((const char*)(gbase) + (voff)[_i]), (LAS unsigned*)(lds + (bufoff) + ldsw + _i * 8192), 16, 0, 0); } while (0)
#define PG8_LDA(dst, b, h) do { _Pragma("unroll") for (int m = 0; m < 4; ++m) _Pragma("unroll") for (int k = 0; k < 2; ++k) dst[m][k] = *(const LAS bf16x8*)(lds + PG8_SA(b, h) + aoff + m * 2048 + k * 1024); } while (0)
#define PG8_LDB(dst, b, h) do { _Pragma("unroll") for (int n = 0; n < 2; ++n) _Pragma("unroll") for (int k = 0; k < 2; ++k) dst[n][k] = *(const LAS bf16x8*)(lds + PG8_SB(b, h) + boff + n * 2048 + k * 1024); } while (0)
#define PG8_MMA(ai, bj, At, Bt) do { __builtin_amdgcn_s_setprio(1); _Pragma("unroll") for (int m = 0; m < 4; ++m) _Pragma("unroll") for (int n = 0; n < 2; ++n) _Pragma("unroll") for (int k = 0; k < 2; ++k) \
        acc[ai][bj][m][n] = __builtin_amdgcn_mfma_f32_16x16x32_bf16(Bt[n][k], At[m][k], acc[ai][bj][m][n], 0, 0, 0); __builtin_amdgcn_s_setprio(0); } while (0)
#define PG8_WAIT_V(n) asm volatile("s_waitcnt vmcnt(" #n ")" ::: "memory")
#define PG8_WAIT_L(n) asm volatile("s_waitcnt lgkmcnt(" #n ")" ::: "memory")
#define PG8_BAR __builtin_amdgcn_s_barrier()
#define PG8_SCHED __builtin_amdgcn_sched_barrier(0)
    Unit cur, nxt; int ui = 0;
    if (!S.next(0, cur)) return;
    f32x4 acc[2][2][4][2];
#pragma unroll
    for (int a = 0; a < 2; ++a)
#pragma unroll
        for (int b = 0; b < 2; ++b)
#pragma unroll
            for (int m = 0; m < 4; ++m)
#pragma unroll
                for (int n = 0; n < 2; ++n) acc[a][b][m][n] = (f32x4){0.f, 0.f, 0.f, 0.f};
    bf16x8 At[4][2], B0[2][2], B1[2][2];
    const char* cA = (const char*)g.A + (size_t)cur.pm * tstep + (size_t)cur.k0 * 2; const char* cB = (const char*)g.Bt + (size_t)cur.pn * tstep + (size_t)cur.k0 * 2;
    PG8_STAGE(PG8_SB(0, 0), cB, voffB); PG8_STAGE(PG8_SA(0, 0), cA, voffA); PG8_STAGE(PG8_SB(0, 1), cB + hstep, voffB); PG8_STAGE(PG8_SA(0, 1), cA + hstep, voffA);
    if (wr == 1) PG8_BAR;
    PG8_WAIT_V(4); PG8_BAR;
    PG8_STAGE(PG8_SB(1, 0), cB + kstep, voffB); PG8_STAGE(PG8_SA(1, 0), cA + kstep, voffA); PG8_STAGE(PG8_SB(1, 1), cB + hstep + kstep, voffB);
    PG8_WAIT_V(6); PG8_BAR;
    for (;;) {
        const bool has_next = S.next(ui + 1, nxt);
        const char* nA = has_next ? (const char*)g.A + (size_t)nxt.pm * tstep + (size_t)nxt.k0 * 2 : cA; const char* nB = has_next ? (const char*)g.Bt + (size_t)nxt.pn * tstep + (size_t)nxt.k0 * 2 : cB;
        const int nt = cur.nt;
        for (int t = 0; t < nt; t += 2) {
            const bool last = (t == nt - 2);
            const char* a1 = cA + (size_t)(t + 1) * kstep;
            const char* a2 = last ? nA : cA + (size_t)(t + 2) * kstep; const char* b2 = last ? nB : cB + (size_t)(t + 2) * kstep;
            const char* a3 = a2 + kstep; const char* b3 = b2 + kstep;
            PG8_LDB(B0, 0, 0); PG8_SCHED; PG8_LDA(At, 0, 0); PG8_STAGE(PG8_SA(1, 1), a1 + hstep, voffA);
            PG8_WAIT_L(8); PG8_BAR; PG8_WAIT_L(0); PG8_MMA(0, 0, At, B0); PG8_BAR; PG8_SCHED;
            PG8_LDB(B1, 0, 1); PG8_STAGE(PG8_SB(0, 0), b2, voffB);
            PG8_BAR; PG8_WAIT_L(0); PG8_MMA(0, 1, At, B1); PG8_BAR;
            PG8_LDA(At, 0, 1); PG8_STAGE(PG8_SA(0, 0), a2, voffA);
            PG8_BAR; PG8_WAIT_L(0); PG8_MMA(1, 0, At, B0); PG8_BAR; PG8_SCHED;
            PG8_STAGE(PG8_SB(0, 1), b2 + hstep, voffB);
            PG8_WAIT_V(6); PG8_BAR; PG8_MMA(1, 1, At, B1); PG8_BAR;
            PG8_LDB(B0, 1, 0); PG8_SCHED; PG8_LDA(At, 1, 0); PG8_STAGE(PG8_SA(0, 1), a2 + hstep, voffA);
            PG8_WAIT_L(8); PG8_BAR; PG8_WAIT_L(0); PG8_MMA(0, 0, At, B0); PG8_BAR; PG8_SCHED;
            PG8_LDB(B1, 1, 1); PG8_STAGE(PG8_SB(1, 0), b3, voffB);
            PG8_BAR; PG8_WAIT_L(0); PG8_MMA(0, 1, At, B1); PG8_BAR;
            PG8_LDA(At, 1, 1); PG8_STAGE(PG8_SA(1, 0), a3, voffA);
            PG8_BAR; PG8_WAIT_L(0); PG8_MMA(1, 0, At, B0); PG8_BAR; PG8_SCHED;
            PG8_STAGE(PG8_SB(1, 1), b3 + hstep, voffB);
            PG8_WAIT_V(6); PG8_BAR; PG8_MMA(1, 1, At, B1); PG8_BAR;
        }
        E(acc, cur, wr, wc, fr, fq);
        if (!has_next) break;
#pragma unroll
        for (int a = 0; a < 2; ++a)
#pragma unroll
            for (int b = 0; b < 2; ++b)
#pragma unroll
                for (int m = 0; m < 4; ++m)
#pragma unroll
                    for (int n = 0; n < 2; ++n) acc[a][b][m][n] = (f32x4){0.f, 0.f, 0.f, 0.f};
        cur = nxt; cA = nA; cB = nB; ++ui;
    }
    PG8_WAIT_V(0);
    if (wr == 0) PG8_BAR;
    PG8_BAR;
#undef PG8_SA
#undef PG8_SB
#undef PG8_STAGE
#undef PG8_LDA
#undef PG8_LDB
#undef PG8_MMA
#undef PG8_WAIT_V
#undef PG8_WAIT_L
#undef PG8_BAR
#undef PG8_SCHED
}
}

template <class F>
__device__ __forceinline__ void epi_walk(const f32x4 (&acc)[2][2][4][2], const pg8::Unit& u, int wr, int wc, int fr, int fq, const F& f) {
    const int row0 = u.pm * 256 + wr * 64 + fr;
#pragma unroll
    for (int ai = 0; ai < 2; ++ai)
#pragma unroll
        for (int m = 0; m < 4; ++m) {
            const int r = row0 + ai * 128 + m * 16;
#pragma unroll
            for (int bj = 0; bj < 2; ++bj)
#pragma unroll
                for (int n = 0; n < 2; ++n) f(r, bj * 128 + wc * 32 + n * 16 + 4 * fq, acc[ai][bj][m][n]);
        }
}

struct EpiIn {
    float* cqkv; bf16_t* qh; float* g; bf16_t* vh; bf16_t* gate; bf16_t* kpe; const f32x2* rope; float* okp; float* oks; const float* hglb;
    __device__ __forceinline__ void operator()(const f32x4 (&acc)[2][2][4][2], const pg8::Unit& u, int wr, int wc, int fr, int fq) const {
        const int pn = u.pn;
        epi_walk(acc, u, wr, wc, fr, fq, [&](int r, int cl, f32x4 v) {
            const int c = pn * 256 + cl;
            if (pn < 4) { *(f32x4*)(cqkv + (size_t)r * 1024 + c) = v; }
            else if (pn < 8) {
                const float sc = 0.08838834764831845f;
                u32x2 w; w.x = pk2(silu_f(v[0]) * sc, silu_f(v[1]) * sc); w.y = pk2(silu_f(v[2]) * sc, silu_f(v[3]) * sc);
                *(u32x2*)(qh + (size_t)r * 1024 + (c - 1024)) = w;
            } else if (pn < 12) {
                const int j = c - 2048;
                const f32x4 a0 = *(const f32x4*)(hglb + j), a1 = *(const f32x4*)(hglb + 1024 + j);
                f32x4 o;
#pragma unroll
                for (int e = 0; e < 4; ++e) { const float lb = __builtin_amdgcn_rcpf(1.0f + __expf(a1[e] - a0[e])); const float sg = __builtin_amdgcn_rcpf(1.0f + __expf(-v[e])); o[e] = __logf(lb + (1.0f - lb) * sg); }
                *(f32x4*)(g + (size_t)r * 1024 + j) = o;
            } else if (pn < 16) {
                u32x2 w; w.x = pk2(v[0], v[1]); w.y = pk2(v[2], v[3]);
                *(u32x2*)(vh + (size_t)r * 1024 + (c - 3072)) = w;
            } else if (pn < 20) {
                u32x2 w; w.x = pk2(silu_f(v[0]), silu_f(v[1])); w.y = pk2(silu_f(v[2]), silu_f(v[3]));
                *(u32x2*)(gate + (size_t)r * 1024 + (c - 4096)) = w;
            } else if (cl < 64) {
                const int i0 = cl >> 1, pos = row_pos(r);
                const f32x2 c0 = rope[pos * 32 + i0], c1 = rope[pos * 32 + i0 + 1];
                const float o1a = v[0] * c0.x - v[1] * c0.y, o2a = v[1] * c0.x + v[0] * c0.y;
                const float o1b = v[2] * c1.x - v[3] * c1.y, o2b = v[3] * c1.x + v[2] * c1.y;
                float* ob = r < MP ? okp + (size_t)r * 64 : oks + (size_t)(r - MP) * 64;
                *(f32x2*)(ob + i0) = (f32x2){o1a, o1b}; *(f32x2*)(ob + 32 + i0) = (f32x2){o2a, o2b};
                u32x2 w; w.x = pk2(o1a, o2a); w.y = pk2(o1b, o2b);
                *(u32x2*)(kpe + (size_t)r * 64 + cl) = w;
            }
        });
    }
};
struct EpiQ {
    bf16_t* q; const f32x2* rope;
    __device__ __forceinline__ void operator()(const f32x4 (&acc)[2][2][4][2], const pg8::Unit& u, int wr, int wc, int fr, int fq) const {
        const int pn = u.pn;
        epi_walk(acc, u, wr, wc, fr, fq, [&](int r, int cl, f32x4 v) {
            const int c = pn * 256 + cl, h = c / 192, j = c - h * 192;
            u32x2 w;
            if (j < 128) { w.x = pk2(v[0] * QSCALE, v[1] * QSCALE); w.y = pk2(v[2] * QSCALE, v[3] * QSCALE); }
            else {
                const int i0 = (j - 128) >> 1, pos = row_pos(r);
                const f32x2 c0 = rope[pos * 32 + i0], c1 = rope[pos * 32 + i0 + 1];
                const float o1a = v[0] * c0.x - v[1] * c0.y, o2a = v[1] * c0.x + v[0] * c0.y;
                const float o1b = v[2] * c1.x - v[3] * c1.y, o2b = v[3] * c1.x + v[2] * c1.y;
                w.x = pk2(o1a * QSCALE, o2a * QSCALE); w.y = pk2(o1b * QSCALE, o2b * QSCALE);
            }
            *(u32x2*)(q + (size_t)r * 1536 + c) = w;
        });
    }
};
struct EpiPlain {
    bf16_t* o; int ldc;
    __device__ __forceinline__ void operator()(const f32x4 (&acc)[2][2][4][2], const pg8::Unit& u, int wr, int wc, int fr, int fq) const {
        const int pn = u.pn;
        epi_walk(acc, u, wr, wc, fr, fq, [&](int r, int cl, f32x4 v) {
            u32x2 w; w.x = pk2(v[0], v[1]); w.y = pk2(v[2], v[3]);
            *(u32x2*)(o + (size_t)r * ldc + pn * 256 + cl) = w;
        });
    }
};
struct EpiRelu2 {
    bf16_t* o;
    __device__ __forceinline__ void operator()(const f32x4 (&acc)[2][2][4][2], const pg8::Unit& u, int wr, int wc, int fr, int fq) const {
        const int pn = u.pn;
        epi_walk(acc, u, wr, wc, fr, fq, [&](int r, int cl, f32x4 v) {
            f32x4 t;
#pragma unroll
            for (int e = 0; e < 4; ++e) { const float a = fmaxf(v[e], 0.f); t[e] = a * a; }
            u32x2 w; w.x = pk2(t[0], t[1]); w.y = pk2(t[2], t[3]);
            *(u32x2*)(o + (size_t)r * DFF + pn * 256 + cl) = w;
        });
    }
};
struct EpiRes {
    const float* xa; const float* xb; float* xo; const float* mod; const float* bada; int goff; float* part;
    __device__ __forceinline__ void operator()(const f32x4 (&acc)[2][2][4][2], const pg8::Unit& u, int wr, int wc, int fr, int fq) const {
        const int pn = u.pn, sl = u.sl, sidx = u.k0 / (u.nt * 64);
        epi_walk(acc, u, wr, wc, fr, fq, [&](int r, int cl, f32x4 v) {
            const int c = pn * 256 + cl;
            if (sl) { *(f32x4*)(part + ((size_t)sidx * MS + (r - MP)) * DM + c) = v; }
            else {
                const int ci = row_ci(r);
                const float* xi = r < MP ? xa + (size_t)r * DM : xb + (size_t)(r - MP) * DM;
                const f32x4 gt = *(const f32x4*)(mod + (size_t)ci * NMOD + goff + c) + *(const f32x4*)(bada + goff + c);
                const f32x4 x = *(const f32x4*)(xi + c);
                *(f32x4*)(xo + (size_t)r * DM + c) = x + gt * v;
            }
        });
    }
};

__device__ __forceinline__ int map_row(int mat, int n) {
    if (mat == 0) { if (n < 1024) return n; if (n < 1088) { const int i = n - 1024; return 5120 + (i < 32 ? 2 * i : 2 * (i - 32) + 1); } return n - 64; }
    if (mat == 1) { const int h = n / 192, j = n - h * 192; if (j < 128) return n; const int i = j - 128; return h * 192 + 128 + (i < 32 ? 2 * i : 2 * (i - 32) + 1); }
    return n;
}
struct TrItem { const float* W; bf16_t* WT; int K, N, mat, item; };
__device__ __forceinline__ void tr_load(const TrItem& t, int lane, float (&tv)[32]) {
    const int nblk = t.N / 32, kb = t.item / nblk, nb = t.item % nblk, k0 = 64 * kb, n0 = 32 * nb;
#pragma unroll
    for (int i = 0; i < 32; ++i) { const int kk = 2 * i + (lane >> 5); tv[i] = t.W[(size_t)(k0 + kk) * t.N + n0 + (lane & 31)]; }
}
__device__ __forceinline__ void tr_store(const TrItem& t, int lane, const float (&tv)[32], LAS float* scr) {
    const int nblk = t.N / 32, kb = t.item / nblk, nb = t.item % nblk, k0 = 64 * kb, n0 = 32 * nb;
#pragma unroll
    for (int i = 0; i < 32; ++i) { const int kk = 2 * i + (lane >> 5); scr[kk * 33 + (lane & 31)] = tv[i]; }
    asm volatile("s_waitcnt lgkmcnt(0)" ::: "memory");
    const int c = lane & 7;
#pragma unroll
    for (int j = 0; j < 4; ++j) { const int n = (lane >> 3) + 8 * j; const LAS float* sp = scr + (8 * c) * 33 + n;
        u32x4 o; o.x = pk2(sp[0 * 33], sp[1 * 33]); o.y = pk2(sp[2 * 33], sp[3 * 33]); o.z = pk2(sp[4 * 33], sp[5 * 33]); o.w = pk2(sp[6 * 33], sp[7 * 33]);
        *(u32x4*)(t.WT + (size_t)map_row(t.mat, n0 + n) * t.K + k0 + 8 * c) = o; }
    asm volatile("s_waitcnt lgkmcnt(0)" ::: "memory");
}
__device__ __forceinline__ TrItem tr_item(const float* const* in, unsigned char* ws, int it) {
    constexpr int I0 = 32 * 162, I1 = 8 * 48, I2 = 8 * 32, I3 = 8 * 32, I4 = 32 * 64, I5 = 32 * 256;
    int r = it;
    if (r < I0) return TrItem{in[9], (bf16_t*)(ws + WS_WIN), 2048, 5184, 0, r}; r -= I0;
    if (r < I1) return TrItem{in[10], (bf16_t*)(ws + WS_WUQ), 512, 1536, 1, r}; r -= I1;
    if (r < I2) return TrItem{in[13], (bf16_t*)(ws + WS_WUK), 512, 1024, 2, r}; r -= I2;
    if (r < I3) return TrItem{in[14], (bf16_t*)(ws + WS_WUV), 512, 1024, 2, r}; r -= I3;
    if (r < I4) return TrItem{in[17], (bf16_t*)(ws + WS_WOUT), 2048, 2048, 2, r}; r -= I4;
    if (r < I5) return TrItem{in[18], (bf16_t*)(ws + WS_WFF1), 2048, 8192, 2, r}; r -= I5;
    return TrItem{in[19], (bf16_t*)(ws + WS_WFF2), 8192, 2048, 2, r};
}
__device__ __forceinline__ void phase0(const float* const* in, unsigned char* ws, unsigned char* lds) {
    const int tid = ltid(), lane = tid & 63, wave = tid >> 6, G = gridDim.x, bx = blockIdx.x;
    {
        float* sl = (float*)lds;
        float* MOD = (float*)(ws + WS_MOD);
        const float* wada = in[7];
        if (bx == 0 && tid < 2) __hip_atomic_store((unsigned*)(ws + WS_CTL) + tid * 64, 0u, __ATOMIC_RELAXED, __HIP_MEMORY_SCOPE_AGENT);
        for (int it = bx; it < 192; it += G) {
            const int grp = tid >> 6, col = it * 64 + lane;
            float acc[34];
#pragma unroll
            for (int r = 0; r < 34; ++r) acc[r] = 0.f;
            for (int pass = 0; pass < 4; ++pass) {
                __syncthreads();
                for (int e = tid; e < 34 * 512; e += 512) { const int r = e >> 9, kl = e & 511, kg = (kl >> 6) * 256 + pass * 64 + (kl & 63);
                    const float cv = r < 2 ? in[2][r * DM + kg] : in[3][(r - 2) * DM + kg]; sl[e] = silu_f(cv); }
                __syncthreads();
                const int k0 = grp * 256 + pass * 64;
                for (int kk = 0; kk < 64; kk += 8) {
                    float w[8];
#pragma unroll
                    for (int j = 0; j < 8; ++j) w[j] = wada[(size_t)(k0 + kk + j) * NMOD + col];
#pragma unroll
                    for (int r = 0; r < 34; ++r) { const f32x4 sv = *(const f32x4*)(sl + r * 512 + grp * 64 + kk), sw = *(const f32x4*)(sl + r * 512 + grp * 64 + kk + 4);
                        acc[r] += (sv[0] * w[0] + sv[1] * w[1] + sv[2] * w[2] + sv[3] * w[3]) + (sw[0] * w[4] + sw[1] * w[5] + sw[2] * w[6] + sw[3] * w[7]); }
                }
            }
            __syncthreads();
            float* red = (float*)lds;
#pragma unroll
            for (int r = 0; r < 34; ++r) red[(grp * 34 + r) * 64 + lane] = acc[r];
            __syncthreads();
            for (int e = tid; e < 34 * 64; e += 512) { const int r = e >> 6, c = e & 63; float sum = 0.f;
#pragma unroll
                for (int g2 = 0; g2 < 8; ++g2) sum += red[(g2 * 34 + r) * 64 + c];
                MOD[(size_t)r * NMOD + it * 64 + c] = sum; }
            __syncthreads();
        }
    }
    {
        LAS float* scr = (LAS float*)lds + wave * (64 * 33);
        const int gw = bx * 8 + wave, NGW = G * 8;
        constexpr int NIT = 32 * 162 + 8 * 48 + 8 * 32 + 8 * 32 + 32 * 64 + 32 * 256 + 128 * 64;
        float ta[32], tb[32];
        int it = gw;
        if (it < NIT) tr_load(tr_item(in, ws, it), lane, ta);
        for (; it < NIT; it += 2 * NGW) {
            if (it + NGW < NIT) tr_load(tr_item(in, ws, it + NGW), lane, tb);
            tr_store(tr_item(in, ws, it), lane, ta, scr);
            if (it + NGW < NIT) {
                if (it + 2 * NGW < NIT) tr_load(tr_item(in, ws, it + 2 * NGW), lane, ta);
                tr_store(tr_item(in, ws, it + NGW), lane, tb, scr);
            }
        }
    }
    const int gt = bx * 512 + tid, NGT = G * 512;
    { u32x4* z = (u32x4*)(ws + WS_WIN + (size_t)5184 * 2048 * 2); for (int i = gt; i < 192 * 2048 * 2 / 16; i += NGT) z[i] = (u32x4){0u, 0u, 0u, 0u}; }
    { const f32x4* s = (const f32x4*)in[13]; u32x2* d = (u32x2*)(ws + WS_WUKO); for (int i = gt; i < 512 * 1024 / 4; i += NGT) { const f32x4 v = s[i]; u32x2 w; w.x = pk2(v[0], v[1]); w.y = pk2(v[2], v[3]); d[i] = w; } }
    { f32x2* rp = (f32x2*)(ws + WS_ROPE);
      for (int i = gt; i < 8192 * 32; i += NGT) { const int pos = i >> 5, k = i & 31;
          const double invf = exp(-9.210340371976184 * (double)k / 32.0); const double t = (double)pos * invf * 0.15915494309189535; const float fr = (float)(t - rint(t));
          rp[i] = (f32x2){__builtin_amdgcn_cosf(fr), __builtin_amdgcn_sinf(fr)}; } }
}

template <int NSL>
__device__ __forceinline__ void adaln_rows(float* xch, const float* xa, const float* xb, const float* mod, const float* bada, int off_sh, int off_sc, bf16_t* H,
                                           const float* part = nullptr, int off_gt = 0, float* xout = nullptr) {
    const int tid_ = ltid(), lane = tid_ & 63, gw = blockIdx.x * 8 + (tid_ >> 6), NGW = gridDim.x * 8;
    {
        f32x4 v[8], nx[8];
#pragma unroll
        for (int j = 0; j < 8; ++j) v[j] = *(const f32x4*)(xa + (size_t)gw * DM + 4 * lane + 256 * j);
        for (int row = gw; row < MP; row += NGW) {
            const int nrow = row + NGW;
            if (nrow < MP) {
#pragma unroll
                for (int j = 0; j < 8; ++j) nx[j] = *(const f32x4*)(xa + (size_t)nrow * DM + 4 * lane + 256 * j); }
            const int ci = row >> 13;
            float ss = 0.f;
#pragma unroll
            for (int j = 0; j < 8; ++j) ss += (v[j][0] * v[j][0] + v[j][1] * v[j][1]) + (v[j][2] * v[j][2] + v[j][3] * v[j][3]);
            const float* mr = mod + (size_t)ci * NMOD;
            const float rstd = 1.0f / sqrtf(wave_sum(ss) * (1.0f / DM) + EPSN);
#pragma unroll
            for (int j = 0; j < 8; ++j) { const int c = 4 * lane + 256 * j;
                const f32x4 scj = *(const f32x4*)(mr + off_sc + c) + *(const f32x4*)(bada + off_sc + c) + 1.0f;
                const f32x4 shj = *(const f32x4*)(mr + off_sh + c) + *(const f32x4*)(bada + off_sh + c);
                const f32x4 h = v[j] * rstd * scj + shj;
                u32x2 w; w.x = pk2(h[0], h[1]); w.y = pk2(h[2], h[3]);
                *(u32x2*)(H + (size_t)row * DM + c) = w; v[j] = nx[j]; }
        }
    }
    __builtin_amdgcn_sched_barrier(0);
    {
        const int wave = tid_ >> 6, q4 = wave & 3;
        for (int rp = blockIdx.x; rp < MS / 2; rp += gridDim.x) {
            const int sr = 2 * rp + (wave >> 2), row = MP + sr; const float* xr = xb + (size_t)sr * DM; const float* mr = mod + (size_t)row_ci(row) * NMOD;
            f32x4 v[2]; float ss = 0.f;
#pragma unroll
            for (int j = 0; j < 2; ++j) { const int c = q4 * 512 + 4 * lane + 256 * j; v[j] = *(const f32x4*)(xr + c);
                if (NSL > 0) { f32x4 a = (f32x4){0.f, 0.f, 0.f, 0.f};
#pragma unroll
                    for (int s2 = 0; s2 < NSL; ++s2) a += *(const f32x4*)(part + ((size_t)s2 * MS + sr) * DM + c);
                    const f32x4 gt = *(const f32x4*)(mr + off_gt + c) + *(const f32x4*)(bada + off_gt + c);
                    v[j] += gt * a; *(f32x4*)(xout + (size_t)row * DM + c) = v[j]; }
                ss += (v[j][0] * v[j][0] + v[j][1] * v[j][1]) + (v[j][2] * v[j][2] + v[j][3] * v[j][3]); }
            ss = wave_sum(ss);
            __syncthreads();
            if (lane == 0) xch[wave] = ss;
            __syncthreads();
            const int w0 = wave & 4;
            const float rstd = 1.0f / sqrtf(((xch[w0] + xch[w0 + 1]) + (xch[w0 + 2] + xch[w0 + 3])) * (1.0f / DM) + EPSN);
#pragma unroll
            for (int j = 0; j < 2; ++j) { const int c = q4 * 512 + 4 * lane + 256 * j;
                const f32x4 sc = *(const f32x4*)(mr + off_sc + c) + *(const f32x4*)(bada + off_sc + c) + 1.0f;
                const f32x4 sh = *(const f32x4*)(mr + off_sh + c) + *(const f32x4*)(bada + off_sh + c);
                const f32x4 h = v[j] * rstd * sc + sh;
                u32x2 w; w.x = pk2(h[0], h[1]); w.y = pk2(h[2], h[3]);
                *(u32x2*)(H + (size_t)row * DM + c) = w; }
        }
    }
}
template <int NSL>
__device__ __forceinline__ void final_rows(float* xch, float* X, const float* gf, const float* part, const float* mod, const float* bada) {
    const int tid_ = ltid(), lane = tid_ & 63, gw = blockIdx.x * 8 + (tid_ >> 6), NGW = gridDim.x * 8;
    {
        f32x4 v[8], nx[8], gn[8];
#pragma unroll
        for (int j = 0; j < 8; ++j) { gn[j] = *(const f32x4*)(gf + 4 * lane + 256 * j); v[j] = *(const f32x4*)(X + (size_t)gw * DM + 4 * lane + 256 * j); }
        for (int row = gw; row < MP; row += NGW) {
            const int nrow = row + NGW;
            if (nrow < MP) {
#pragma unroll
                for (int j = 0; j < 8; ++j) nx[j] = *(const f32x4*)(X + (size_t)nrow * DM + 4 * lane + 256 * j); }
            float ss = 0.f;
#pragma unroll
            for (int j = 0; j < 8; ++j) ss += (v[j][0] * v[j][0] + v[j][1] * v[j][1]) + (v[j][2] * v[j][2] + v[j][3] * v[j][3]);
            const float rstd = 1.0f / sqrtf(wave_sum(ss) * (1.0f / DM) + EPSN);
#pragma unroll
            for (int j = 0; j < 8; ++j) { *(f32x4*)(X + (size_t)row * DM + 4 * lane + 256 * j) = v[j] * rstd * gn[j]; v[j] = nx[j]; }
        }
    }
    __builtin_amdgcn_sched_barrier(0);
    {
        const int wave = tid_ >> 6, q4 = wave & 3;
        for (int rp = blockIdx.x; rp < MS / 2; rp += gridDim.x) {
            const int sr = 2 * rp + (wave >> 2), row = MP + sr;
            f32x4 v[2]; float ss = 0.f;
#pragma unroll
            for (int j = 0; j < 2; ++j) { const int c = q4 * 512 + 4 * lane + 256 * j; v[j] = *(const f32x4*)(X + (size_t)row * DM + c);
                if (NSL > 0) { f32x4 a = (f32x4){0.f, 0.f, 0.f, 0.f};
#pragma unroll
                    for (int s2 = 0; s2 < NSL; ++s2) a += *(const f32x4*)(part + ((size_t)s2 * MS + sr) * DM + c);
                    const f32x4 gt = *(const f32x4*)(mod + (size_t)row_ci(row) * NMOD + 10240 + c) + *(const f32x4*)(bada + 10240 + c);
                    v[j] += gt * a; }
                ss += (v[j][0] * v[j][0] + v[j][1] * v[j][1]) + (v[j][2] * v[j][2] + v[j][3] * v[j][3]); }
            ss = wave_sum(ss);
            __syncthreads();
            if (lane == 0) xch[wave] = ss;
            __syncthreads();
            const int w0 = wave & 4;
            const float rstd = 1.0f / sqrtf(((xch[w0] + xch[w0 + 1]) + (xch[w0 + 2] + xch[w0 + 3])) * (1.0f / DM) + EPSN);
#pragma unroll
            for (int j = 0; j < 2; ++j) { const int c = q4 * 512 + 4 * lane + 256 * j; *(f32x4*)(X + (size_t)row * DM + c) = v[j] * rstd * *(const f32x4*)(gf + c); }
        }
    }
}
__device__ __forceinline__ void latent_rows(const float* cqkv, const float* gq, const float* gkv, bf16_t* cqn, bf16_t* ckv, float* ockp, float* ocks) {
    const int tid_ = ltid(), lane = tid_ & 63, gw = blockIdx.x * 8 + (tid_ >> 6), NGW = gridDim.x * 8;
    for (int row = gw; row < MT; row += NGW) {
        const float* sr = cqkv + (size_t)row * 1024;
        f32x4 a[2], b[2]; float sa = 0.f, sb = 0.f;
#pragma unroll
        for (int j = 0; j < 2; ++j) { a[j] = *(const f32x4*)(sr + 4 * lane + 256 * j); b[j] = *(const f32x4*)(sr + 512 + 4 * lane + 256 * j);
            sa += (a[j][0] * a[j][0] + a[j][1] * a[j][1]) + (a[j][2] * a[j][2] + a[j][3] * a[j][3]); sb += (b[j][0] * b[j][0] + b[j][1] * b[j][1]) + (b[j][2] * b[j][2] + b[j][3] * b[j][3]); }
        const float ra = 1.0f / sqrtf(wave_sum(sa) * (1.0f / 512) + EPSN), rb = 1.0f / sqrtf(wave_sum(sb) * (1.0f / 512) + EPSN);
        float* oc = row < MP ? ockp + (size_t)row * 512 : ocks + (size_t)(row - MP) * 512;
#pragma unroll
        for (int j = 0; j < 2; ++j) { const int c = 4 * lane + 256 * j;
            const f32x4 qa = a[j] * ra * *(const f32x4*)(gq + c), kb = b[j] * rb * *(const f32x4*)(gkv + c);
            u32x2 w; w.x = pk2(qa[0], qa[1]); w.y = pk2(qa[2], qa[3]); *(u32x2*)(cqn + (size_t)row * 512 + c) = w;
            *(f32x4*)(oc + c) = kb;
            w.x = pk2(kb[0], kb[1]); w.y = pk2(kb[2], kb[3]); *(u32x2*)(ckv + (size_t)row * 512 + c) = w; }
    }
}

template <int L>
__device__ __forceinline__ void hgrn_cumsum(const float* G, int row0, int h, int lreal, float* Bs, float* tot, float (&gv)[L / 4]) {
    constexpr int SEG = L / 4;
    const int tid = ltid(), k = tid & 127, seg = tid >> 7;
    float run = 0.f;
#pragma unroll
    for (int i = 0; i < SEG; ++i) { const int t = seg * SEG + i; gv[i] = t < lreal ? G[(size_t)(row0 + t) * 1024 + h * 128 + k] : 0.f; }
#pragma unroll
    for (int i = 0; i < SEG; ++i) { run += gv[i]; Bs[(seg * SEG + i) * 128 + k] = run; }
    tot[seg * 128 + k] = run;
    __syncthreads();
    float off = 0.f;
#pragma unroll
    for (int s2 = 0; s2 < 3; ++s2) if (s2 < seg) off += tot[s2 * 128 + k];
#pragma unroll
    for (int i = 0; i < SEG; ++i) Bs[(seg * SEG + i) * 128 + k] += off;
    __syncthreads();
}
template <int L>
__device__ __forceinline__ void hgrn_a(int it, int bh, int row0, int lreal, const float* G, const bf16_t* VH, bf16_t* U, float* DD, unsigned char* lds) {
    constexpr int SEG = L / 4, ST = L + 8;
    const int tid = ltid(), lane = tid & 63, wave = tid >> 6, k = tid & 127, seg = tid >> 7, h = bh & 7;
    float* Bs = (float*)lds; float* tot = (float*)(lds + 32768);
    bf16_t* KDT = (bf16_t*)(lds + 34816); bf16_t* VT = (bf16_t*)(lds + 34816 + 128 * ST * 2);
    float gv[SEG]; bf16_t vraw[SEG];
#pragma unroll
    for (int i = 0; i < SEG; ++i) { const int s = seg * SEG + i; vraw[i] = s < lreal ? VH[(size_t)(row0 + s) * 1024 + h * 128 + k] : (bf16_t)0; }
    hgrn_cumsum<L>(G, row0, h, lreal, Bs, tot, gv);
    const float blast = Bs[(L - 1) * 128 + k];
#pragma unroll
    for (int i = 0; i < SEG; ++i) { const int s = seg * SEG + i;
        const float kd = (1.0f - __expf(gv[i])) * __expf(blast - Bs[s * 128 + k]);
        KDT[k * ST + s] = (bf16_t)(pk2(kd, 0.f) & 0xffffu);
        VT[k * ST + s] = vraw[i]; }
    if (seg == 0) DD[(size_t)it * 128 + k] = __expf(blast);
    __syncthreads();
    const int r = lane & 15, g = lane >> 4;
#pragma unroll
    for (int vt = 0; vt < 8; ++vt) {
        f32x4 acc = (f32x4){0.f, 0.f, 0.f, 0.f};
#pragma unroll
        for (int ks = 0; ks < L / 32; ++ks) {
            const bf16x8 a = *(const bf16x8*)(KDT + (16 * wave + r) * ST + 32 * ks + 8 * g);
            const bf16x8 b = *(const bf16x8*)(VT + (16 * vt + r) * ST + 32 * ks + 8 * g);
            acc = __builtin_amdgcn_mfma_f32_16x16x32_bf16(a, b, acc, 0, 0, 0);
        }
        bf16_t* up = U + (size_t)it * 16384 + (16 * wave + 4 * g) * 128 + 16 * vt + r;
        const unsigned p01 = pk2(acc[0], acc[1]), p23 = pk2(acc[2], acc[3]);
        up[0] = (bf16_t)(p01 & 0xffffu); up[128] = (bf16_t)(p01 >> 16); up[256] = (bf16_t)(p23 & 0xffffu); up[384] = (bf16_t)(p23 >> 16);
    }
    __syncthreads();
}
__device__ __forceinline__ void hgrn_b(const bf16_t* U, const float* DD, bf16_t* Sn, const float* st0, float* ostp, float* osts) {
    const int gt = blockIdx.x * 512 + ltid(), NGT = gridDim.x * 512;
#ifdef HB_TEST
    for (int e = gt; e < 16 * 16384; e += NGT) { const int bh = e >> 14, kv = e & 16383; ostp[e] = bf2f(U[((size_t)bh * 128 + 127) * 16384 + kv]); }
    for (int e = gt; e < 256 * 16384; e += NGT) { const int bh = e >> 14, kv = e & 16383; osts[e] = bf2f(U[((size_t)2048 + bh) * 16384 + kv]) + DD[((size_t)2048 + bh) * 128 + (kv >> 7)]; }
    return;
#endif
    for (int e = gt; e < 16 * 16384; e += NGT) {
        const int bh = e >> 14, kv = e & 16383, k = kv >> 7;
        float S = 0.f;
        const bf16_t* up = U + (size_t)bh * 128 * 16384 + kv; const float* dp = DD + (size_t)bh * 128 * 128 + k; bf16_t* sp = Sn + (size_t)bh * 128 * 16384 + kv;
        for (int n0 = 0; n0 < 128; n0 += 16) {
            bf16_t ur[16]; float dr[16];
#pragma unroll
            for (int j = 0; j < 16; ++j) { ur[j] = up[(size_t)(n0 + j) * 16384]; dr[j] = dp[(n0 + j) * 128]; }
#pragma unroll
            for (int j = 0; j < 16; ++j) { sp[(size_t)(n0 + j) * 16384] = (bf16_t)(pk2(S, 0.f) & 0xffffu); S = dr[j] * S + bf2f(ur[j]); }
        }
        ostp[e] = S;
    }
    for (int e = gt; e < 256 * 16384; e += NGT) {
        const int bh = e >> 14, kv = e & 16383, k = kv >> 7; const size_t it = 2048 + bh;
        const float S0 = st0[e];
        Sn[it * 16384 + kv] = (bf16_t)(pk2(S0, 0.f) & 0xffffu);
        osts[e] = DD[it * 128 + k] * S0 + bf2f(U[it * 16384 + kv]);
    }
}
template <int L>
__device__ __forceinline__ void hgrn_c(int it, int bh, int row0, int lreal, const float* G, const bf16_t* QH, const bf16_t* VH, const bf16_t* GATE, const bf16_t* Sn, const float* ghg, bf16_t* MIX, unsigned char* lds) {
    constexpr int SEG = L / 4, VS = L + 8;
    const int tid = ltid(), lane = tid & 63, wave = tid >> 6, k = tid & 127, seg = tid >> 7, h = bh & 7;
    float* Bs = (float*)lds; float* tot = (float*)(lds + 32768);
    bf16_t* QT = (bf16_t*)(lds + 34816); bf16_t* KT = (bf16_t*)(lds + 52224); bf16_t* VT = (bf16_t*)(lds + 69632); bf16_t* ST = (bf16_t*)(lds + 88064);
    float gv[SEG];
    bf16_t qraw[SEG], vraw[SEG]; u32x4 sraw[4];
#pragma unroll
    for (int i = 0; i < SEG; ++i) { const int s = seg * SEG + i;
        qraw[i] = s < lreal ? QH[(size_t)(row0 + s) * 1024 + h * 128 + k] : (bf16_t)0;
        vraw[i] = s < lreal ? VH[(size_t)(row0 + s) * 1024 + h * 128 + k] : (bf16_t)0; }
#pragma unroll
    for (int i = 0; i < 4; ++i) sraw[i] = *(const u32x4*)(Sn + (size_t)it * 16384 + (size_t)k * 128 + (seg + 4 * i) * 8);
    hgrn_cumsum<L>(G, row0, h, lreal, Bs, tot, gv);
#pragma unroll
    for (int i = 0; i < SEG; ++i) { const int s = seg * SEG + i; const float bs = Bs[s * 128 + k];
        QT[s * 136 + k] = (bf16_t)(pk2(bf2f(qraw[i]) * __expf(bs), 0.f) & 0xffffu);
        KT[s * 136 + k] = (bf16_t)(pk2((1.0f - __expf(gv[i])) * __expf(-bs), 0.f) & 0xffffu);
        VT[k * VS + s] = vraw[i]; }
#pragma unroll
    for (int i = 0; i < 4; ++i) { const int kk = k, v0 = (seg + 4 * i) * 8;
        const unsigned w4[4] = {sraw[i].x, sraw[i].y, sraw[i].z, sraw[i].w};
#pragma unroll
        for (int e = 0; e < 4; ++e) { ST[(v0 + 2 * e) * 136 + kk] = (bf16_t)(w4[e] & 0xffffu); ST[(v0 + 2 * e + 1) * 136 + kk] = (bf16_t)(w4[e] >> 16); } }
    __syncthreads();
    const int tt = wave;
    if (tt * 16 < lreal) {
        const int r = lane & 15, g = lane >> 4;
        bf16x8 qf[4];
#pragma unroll
        for (int ks = 0; ks < 4; ++ks) qf[ks] = *(const bf16x8*)(QT + (16 * tt + r) * 136 + 32 * ks + 8 * g);
        bf16x8 pf[L / 32];
#pragma unroll
        for (int p = 0; p < L / 32; ++p) {
            unsigned pw[4];
#pragma unroll
            for (int hs = 0; hs < 2; ++hs) { const int st = 2 * p + hs;
                f32x4 acc = (f32x4){0.f, 0.f, 0.f, 0.f};
                if (st <= tt) {
#pragma unroll
                    for (int ks = 0; ks < 4; ++ks) { const bf16x8 a = *(const bf16x8*)(KT + (16 * st + r) * 136 + 32 * ks + 8 * g); acc = __builtin_amdgcn_mfma_f32_16x16x32_bf16(a, qf[ks], acc, 0, 0, 0); }
#pragma unroll
                    for (int e = 0; e < 4; ++e) if (16 * st + 4 * g + e > 16 * tt + r) acc[e] = 0.f;
                }
                pw[2 * hs] = pk2(acc[0], acc[1]); pw[2 * hs + 1] = pk2(acc[2], acc[3]); }
            u32x4 t4 = (u32x4){pw[0], pw[1], pw[2], pw[3]};
            pf[p] = __builtin_bit_cast(bf16x8, t4);
        }
        f32x4 o[8]; float ss = 0.f;
#pragma unroll
        for (int vt = 0; vt < 8; ++vt) {
            f32x4 acc = (f32x4){0.f, 0.f, 0.f, 0.f};
#pragma unroll
            for (int p = 0; p < L / 32; ++p) if (2 * p <= tt) {
                const u32x2 lo = *(const u32x2*)(VT + (16 * vt + r) * VS + 32 * p + 4 * g), hi = *(const u32x2*)(VT + (16 * vt + r) * VS + 32 * p + 16 + 4 * g);
                u32x4 t4 = (u32x4){lo.x, lo.y, hi.x, hi.y};
                acc = __builtin_amdgcn_mfma_f32_16x16x32_bf16(__builtin_bit_cast(bf16x8, t4), pf[p], acc, 0, 0, 0); }
#pragma unroll
            for (int ks = 0; ks < 4; ++ks) { const bf16x8 a = *(const bf16x8*)(ST + (16 * vt + r) * 136 + 32 * ks + 8 * g); acc = __builtin_amdgcn_mfma_f32_16x16x32_bf16(a, qf[ks], acc, 0, 0, 0); }
            o[vt] = acc; ss += (acc[0] * acc[0] + acc[1] * acc[1]) + (acc[2] * acc[2] + acc[3] * acc[3]);
        }
        ss += __shfl_xor(ss, 16); ss += __shfl_xor(ss, 32);
        const float rstd = 1.0f / sqrtf(ss * (1.0f / 128) + EPSN);
        const int t = 16 * tt + r;
        if (t < lreal) {
            const size_t row = (size_t)(row0 + t);
#pragma unroll
            for (int vt = 0; vt < 8; ++vt) { const int v0 = 16 * vt + 4 * g;
                const u32x2 gw2 = *(const u32x2*)(GATE + row * 1024 + h * 128 + v0); const f32x4 gh = *(const f32x4*)(ghg + v0);
                const float g0 = __uint_as_float(gw2.x << 16), g1 = __uint_as_float(gw2.x & 0xffff0000u), g2 = __uint_as_float(gw2.y << 16), g3 = __uint_as_float(gw2.y & 0xffff0000u);
                u32x2 w; w.x = pk2(o[vt][0] * rstd * gh[0] * g0, o[vt][1] * rstd * gh[1] * g1); w.y = pk2(o[vt][2] * rstd * gh[2] * g2, o[vt][3] * rstd * gh[3] * g3);
                *(u32x2*)(MIX + row * 2048 + 1024 + h * 128 + v0) = w; }
        }
    }
    __syncthreads();
}

template <int NKS, int NDT, int KSTR, int VSTR, bool QG, int NQF>
__device__ __forceinline__ void attn_step(const bf16x8 (&qf)[NQF], const bf16_t* qg, f32x4 (&o)[NDT], float& m, float& l, const LAS unsigned char* kimg, const LAS unsigned char* vimg, int lane, bool half_valid) {
    const int r = lane & 15, g = lane >> 4;
    f32x4 s0 = (f32x4){0.f, 0.f, 0.f, 0.f}, s1 = (f32x4){0.f, 0.f, 0.f, 0.f};
    const LAS unsigned char* kp = kimg + r * (KSTR * 2) + g * 16;
    if constexpr (QG) {
#pragma unroll 1
        for (int ks3 = 0; ks3 < NKS; ks3 += 3) {
#pragma unroll
            for (int k2 = 0; k2 < 3; ++k2) { const int ks = ks3 + k2;
                const bf16x8 a0 = *(const LAS bf16x8*)(kp + ks * 64), a1 = *(const LAS bf16x8*)(kp + 16 * KSTR * 2 + ks * 64);
                const bf16x8 qv = *(const bf16x8*)(qg + 32 * ks);
                s0 = __builtin_amdgcn_mfma_f32_16x16x32_bf16(a0, qv, s0, 0, 0, 0);
                s1 = __builtin_amdgcn_mfma_f32_16x16x32_bf16(a1, qv, s1, 0, 0, 0); }
        }
    } else {
#pragma unroll
        for (int ks = 0; ks < NKS; ++ks) {
            const bf16x8 a0 = *(const LAS bf16x8*)(kp + ks * 64), a1 = *(const LAS bf16x8*)(kp + 16 * KSTR * 2 + ks * 64);
            s0 = __builtin_amdgcn_mfma_f32_16x16x32_bf16(a0, qf[ks], s0, 0, 0, 0);
            s1 = __builtin_amdgcn_mfma_f32_16x16x32_bf16(a1, qf[ks], s1, 0, 0, 0);
        }
    }
    if (half_valid) s1 = (f32x4){-INFINITY, -INFINITY, -INFINITY, -INFINITY};
    float mx = fmaxf(fmaxf(fmaxf(s0[0], s0[1]), fmaxf(s0[2], s0[3])), fmaxf(fmaxf(s1[0], s1[1]), fmaxf(s1[2], s1[3])));
    mx = fmaxf(mx, __shfl_xor(mx, 16)); mx = fmaxf(mx, __shfl_xor(mx, 32));
    const float mn = fmaxf(m, mx), alpha = exp2f(m - mn);
    f32x4 p0, p1;
#pragma unroll
    for (int e = 0; e < 4; ++e) { p0[e] = exp2f(s0[e] - mn); p1[e] = exp2f(s1[e] - mn); }
    float ls = (p0[0] + p0[1]) + (p0[2] + p0[3]) + (p1[0] + p1[1]) + (p1[2] + p1[3]);
    ls += __shfl_xor(ls, 16); ls += __shfl_xor(ls, 32);
    l = l * alpha + ls; m = mn;
    u32x4 pw = (u32x4){pk2(p0[0], p0[1]), pk2(p0[2], p0[3]), pk2(p1[0], p1[1]), pk2(p1[2], p1[3])};
    const bf16x8 pf = __builtin_bit_cast(bf16x8, pw);
    const LAS unsigned char* vp = vimg + r * (VSTR * 2) + g * 8;
#pragma unroll
    for (int dt = 0; dt < NDT; ++dt) {
        const u32x2 lo = *(const LAS u32x2*)(vp + dt * 16 * VSTR * 2), hi = *(const LAS u32x2*)(vp + dt * 16 * VSTR * 2 + 32);
        u32x4 t4 = (u32x4){lo.x, lo.y, hi.x, hi.y};
        o[dt] = __builtin_amdgcn_mfma_f32_16x16x32_bf16(__builtin_bit_cast(bf16x8, t4), pf, o[dt] * alpha, 0, 0, 0);
        if ((dt & 3) == 3) __builtin_amdgcn_sched_barrier(0);
    }
}

typedef float f32x16 __attribute__((ext_vector_type(16)));
__device__ __forceinline__ void attn_prompt_item(int b, int h, int qb, const bf16_t* Q, const bf16_t* KN, const bf16_t* KPE, const bf16_t* VT, bf16_t* MIX, LAS unsigned char* lds) {
    constexpr int KSTR = 200, VSTR = 72, KIMG = 64 * KSTR * 2, BUFB = KIMG + 128 * VSTR * 2;
    const int tid = ltid(), lane = tid & 63, wave = tid >> 6, r = lane & 31, hh = lane >> 5;
    const int nkt = 4 * qb + 4, nkw = 4 * qb + (wave >> 1) + 1;
    const size_t qrow = (size_t)b * 8192 + 256 * qb + 32 * wave + r;
    bf16x8 qf[12];
#pragma unroll
    for (int ks = 0; ks < 12; ++ks) qf[ks] = *(const bf16x8*)(Q + qrow * 1536 + h * 192 + 16 * ks + 8 * hh);
    f32x16 o[4];
#pragma unroll
    for (int dt = 0; dt < 4; ++dt)
#pragma unroll
        for (int i = 0; i < 16; ++i) o[dt][i] = 0.f;
    float m = -INFINITY, l = 0.f;
    const bf16_t* kn_src = KN + ((size_t)b * 8192 + (tid >> 4)) * 1024 + h * 128 + 8 * (tid & 15);
    const bf16_t* kp_src = KPE + ((size_t)b * 8192 + (tid >> 3)) * 64 + 8 * (tid & 7);
    const bf16_t* vt_src = VT + ((size_t)h * 128 + (tid >> 3)) * 16384 + (size_t)b * 8192 + 8 * (tid & 7);
    const int wk = (tid >> 4) * (KSTR * 2) + (tid & 15) * 16, wp = (tid >> 3) * (KSTR * 2) + 256 + (tid & 7) * 16, wv = KIMG + (tid >> 3) * (VSTR * 2) + ((tid & 7) >> 1) * 32 + ((tid & 7) & 1) * 8;
    u32x4 ak0, ak1, ap, av0, av1;
#define AT_LOAD(S_, t) do { S_##k0 = *(const u32x4*)(kn_src + (size_t)(t) * 64 * 1024); S_##k1 = *(const u32x4*)(kn_src + ((size_t)(t) * 64 + 32) * 1024); S_##p = *(const u32x4*)(kp_src + (size_t)(t) * 64 * 64); \
        S_##v0 = *(const u32x4*)(vt_src + (t) * 64); S_##v1 = *(const u32x4*)(vt_src + (size_t)64 * 16384 + (t) * 64); } while (0)
#define AT_STORE(S_, t) do { const int bo_ = ((t) & 1) * BUFB; *(LAS u32x4*)(lds + bo_ + wk) = S_##k0; *(LAS u32x4*)(lds + bo_ + wk + 32 * KSTR * 2) = S_##k1; *(LAS u32x4*)(lds + bo_ + wp) = S_##p; \
        *(LAS u32x2*)(lds + bo_ + wv) = (u32x2){S_##v0.x, S_##v0.y}; *(LAS u32x2*)(lds + bo_ + wv + 16) = (u32x2){S_##v0.z, S_##v0.w}; \
        *(LAS u32x2*)(lds + bo_ + wv + 64 * VSTR * 2) = (u32x2){S_##v1.x, S_##v1.y}; *(LAS u32x2*)(lds + bo_ + wv + 64 * VSTR * 2 + 16) = (u32x2){S_##v1.z, S_##v1.w}; } while (0)
#define AT_SUB(kt, u) do { \
            const LAS unsigned char* kimg = lds + ((kt) & 1) * BUFB + (u) * 32 * KSTR * 2; const LAS unsigned char* vimg = lds + ((kt) & 1) * BUFB + KIMG + (u) * 64; \
            f32x16 sc; \
            _Pragma("unroll") for (int i = 0; i < 16; ++i) sc[i] = 0.f; \
            const LAS unsigned char* kp = kimg + r * (KSTR * 2) + hh * 16; \
            _Pragma("unroll") for (int ks = 0; ks < 12; ++ks) { const bf16x8 a = *(const LAS bf16x8*)(kp + ks * 32); sc = __builtin_amdgcn_mfma_f32_32x32x16_bf16(a, qf[ks], sc, 0, 0, 0); } \
            float mx = sc[0]; \
            _Pragma("unroll") for (int i = 1; i < 16; ++i) mx = fmaxf(mx, sc[i]); \
            mx = fmaxf(mx, __shfl_xor(mx, 32)); \
            const float mn = fmaxf(m, mx), alpha = __builtin_amdgcn_exp2f(m - mn); \
            float ls = 0.f; \
            _Pragma("unroll") for (int i = 0; i < 16; ++i) { sc[i] = __builtin_amdgcn_exp2f(sc[i] - mn); ls += sc[i]; } \
            ls += __shfl_xor(ls, 32); \
            l = l * alpha + ls; m = mn; \
            bf16x8 pf[2]; \
            _Pragma("unroll") for (int s2 = 0; s2 < 2; ++s2) { u32x4 pw = (u32x4){pk2(sc[8 * s2], sc[8 * s2 + 1]), pk2(sc[8 * s2 + 2], sc[8 * s2 + 3]), pk2(sc[8 * s2 + 4], sc[8 * s2 + 5]), pk2(sc[8 * s2 + 6], sc[8 * s2 + 7])}; pf[s2] = __builtin_bit_cast(bf16x8, pw); } \
            const LAS unsigned char* vp = vimg + r * (VSTR * 2) + hh * 16; \
            _Pragma("unroll") for (int dt = 0; dt < 4; ++dt) { \
                f32x16 acc = o[dt] * alpha; \
                _Pragma("unroll") for (int s2 = 0; s2 < 2; ++s2) { \
                    const bf16x8 va = *(const LAS bf16x8*)(vp + dt * 32 * VSTR * 2 + s2 * 32); \
                    acc = __builtin_amdgcn_mfma_f32_32x32x16_bf16(va, pf[s2], acc, 0, 0, 0); } \
                o[dt] = acc; } } while (0)
#define AT_COMPUTE(kt) do { if ((kt) < nkw) { AT_SUB(kt, 0); AT_SUB(kt, 1); } } while (0)
    AT_LOAD(a, 0); AT_STORE(a, 0); AT_LOAD(a, 1);
    __syncthreads();
    for (int kt = 0; kt < nkt; ++kt) {
        AT_COMPUTE(kt);
        if (kt + 1 < nkt) AT_STORE(a, kt + 1);
        if (kt + 2 < nkt) AT_LOAD(a, kt + 2);
        __syncthreads();
    }
#undef AT_LOAD
#undef AT_STORE
#undef AT_SUB
#undef AT_COMPUTE
    const float inv = 1.0f / l;
#pragma unroll
    for (int dt = 0; dt < 4; ++dt)
#pragma unroll
        for (int ig = 0; ig < 4; ++ig) { u32x2 w; w.x = pk2(o[dt][4 * ig] * inv, o[dt][4 * ig + 1] * inv); w.y = pk2(o[dt][4 * ig + 2] * inv, o[dt][4 * ig + 3] * inv);
            *(u32x2*)(MIX + qrow * 2048 + h * 128 + 32 * dt + 8 * ig + 4 * hh) = w; }
}

constexpr int NSPL = 8;
__device__ __forceinline__ void attn_sample_item(int b, int sp, const bf16_t* Q, const bf16_t* WUKO, const float* cckv, const float* ckpe, const bf16_t* CKV, const bf16_t* KPE, bf16_t* QLAT, bf16_t* PO, float* PML, LAS unsigned char* lds) {
    constexpr int KSTR = 584, VSTR = 36;
    const int tid = ltid(), lane = tid & 63, h = tid >> 6, r = lane & 15, g = lane >> 4;
    LAS unsigned char* kimg = lds; LAS unsigned char* vimg = lds + 32 * KSTR * 2;
    const size_t qrow0 = (size_t)MP + (size_t)b * 16;
    bf16_t* ql = QLAT + ((size_t)b * 8 + h) * 16 * 576;
    {
        bf16x8 aq[4];
#pragma unroll
        for (int ks = 0; ks < 4; ++ks) aq[ks] = *(const bf16x8*)(Q + (qrow0 + r) * 1536 + h * 192 + 32 * ks + 8 * g);
#pragma unroll 8
        for (int ct = 0; ct < 32; ++ct) {
            f32x4 acc = (f32x4){0.f, 0.f, 0.f, 0.f};
#pragma unroll
            for (int ks = 0; ks < 4; ++ks) { const bf16x8 bw = *(const bf16x8*)(WUKO + (size_t)(16 * ct + r) * 1024 + h * 128 + 32 * ks + 8 * g); acc = __builtin_amdgcn_mfma_f32_16x16x32_bf16(bw, aq[ks], acc, 0, 0, 0); }
            u32x2 w; w.x = pk2(acc[0], acc[1]); w.y = pk2(acc[2], acc[3]);
            *(u32x2*)(ql + r * 576 + 16 * ct + 4 * g) = w;
        }
#pragma unroll
        for (int i = 0; i < 2; ++i) { const int pc = lane + 64 * i, qq = pc >> 3, cc = pc & 7;
            *(u32x4*)(ql + qq * 576 + 512 + 8 * cc) = *(const u32x4*)(Q + (qrow0 + qq) * 1536 + h * 192 + 128 + 8 * cc); }
    }
    __threadfence(); __syncthreads();
    const bf16_t* qg = ql + r * 576 + 8 * g;
    f32x4 o[32];
#pragma unroll
    for (int dt = 0; dt < 32; ++dt) o[dt] = (f32x4){0.f, 0.f, 0.f, 0.f};
    float m = -INFINITY, l = 0.f;
    const float* cb = cckv + (size_t)b * 2048 * 512; const float* pb = ckpe + (size_t)b * 2048 * 64;
    const int kt0 = sp * 8, kt1 = (sp == NSPL - 1) ? 65 : kt0 + 8;
    for (int kt = kt0; kt < kt1; ++kt) {
        __syncthreads();
        if (kt < 64) {
            const int c = tid;
            float v[32];
#pragma unroll
            for (int kk = 0; kk < 32; ++kk) v[kk] = cb[(size_t)(32 * kt + kk) * 512 + c];
            const int key = tid >> 4, i4 = (tid & 15) * 4; const f32x4 pv = *(const f32x4*)(pb + (size_t)(32 * kt + key) * 64 + i4);
#pragma unroll
            for (int kk = 0; kk < 32; kk += 2) {
                const unsigned pw = pk2(v[kk], v[kk + 1]);
                *(LAS bf16_t*)(kimg + kk * (KSTR * 2) + c * 2) = (bf16_t)(pw & 0xffffu);
                *(LAS bf16_t*)(kimg + (kk + 1) * (KSTR * 2) + c * 2) = (bf16_t)(pw >> 16);
                *(LAS unsigned*)(vimg + c * (VSTR * 2) + kk * 2) = pw;
            }
#pragma unroll
            for (int e = 0; e < 4; ++e) { const int i = i4 + e, pi = i < 32 ? 2 * i : 2 * (i - 32) + 1;
                *(LAS bf16_t*)(kimg + key * (KSTR * 2) + (512 + pi) * 2) = (bf16_t)(pk2(pv[e], 0.f) & 0xffffu); }
        } else {
            const int c = tid;
#pragma unroll 4
            for (int kk = 0; kk < 32; kk += 2) {
                unsigned pw = 0u;
                if (kk < 16) { const unsigned a = CKV[(qrow0 + kk) * 512 + c], bb = CKV[(qrow0 + kk + 1) * 512 + c]; pw = a | (bb << 16); }
                *(LAS bf16_t*)(kimg + kk * (KSTR * 2) + c * 2) = (bf16_t)(pw & 0xffffu);
                *(LAS bf16_t*)(kimg + (kk + 1) * (KSTR * 2) + c * 2) = (bf16_t)(pw >> 16);
                *(LAS unsigned*)(vimg + c * (VSTR * 2) + kk * 2) = pw;
            }
            { const int key = tid >> 4, i4 = (tid & 15) * 4;
              u32x2 w = (u32x2){0u, 0u}; if (key < 16) w = *(const u32x2*)(KPE + (qrow0 + key) * 64 + i4);
              *(LAS u32x2*)(kimg + key * (KSTR * 2) + (512 + i4) * 2) = w; }
        }
        bf16x8 qv[18];
#pragma unroll
        for (int ks = 0; ks < 18; ++ks) qv[ks] = *(const bf16x8*)(qg + 32 * ks);
        __syncthreads();
        attn_step<18, 32, KSTR, VSTR, false, 18>(qv, nullptr, o, m, l, kimg, vimg, lane, kt == 64);
    }
    const float inv = 1.0f / l;
    const size_t pi = (((size_t)b * NSPL + sp) * 8 + h) * 16 + r;
    bf16_t* po = PO + pi * 512 + 4 * g;
#pragma unroll
    for (int dt = 0; dt < 32; ++dt) { u32x2 w; w.x = pk2(o[dt][0] * inv, o[dt][1] * inv); w.y = pk2(o[dt][2] * inv, o[dt][3] * inv); *(u32x2*)(po + 16 * dt) = w; }
    if (g == 0) *(f32x2*)(PML + pi * 2) = (f32x2){m, l};
    __syncthreads();
}
__device__ __forceinline__ void attn_sample_combine(int b, int h, const bf16_t* PO, const float* PML, const bf16_t* WUVT, bf16_t* MIX, LAS unsigned char* lds) {
    const int tid = ltid(), lane = tid & 63, wave = tid >> 6, r = lane & 15, g = lane >> 4;
    float ms[NSPL], cs[NSPL], M = -INFINITY, L = 0.f;
#pragma unroll
    for (int sp = 0; sp < NSPL; ++sp) { const f32x2 ml = *(const f32x2*)(PML + ((((size_t)b * NSPL + sp) * 8 + h) * 16 + r) * 2); ms[sp] = ml.x; cs[sp] = ml.y; M = fmaxf(M, ml.x); }
#pragma unroll
    for (int sp = 0; sp < NSPL; ++sp) { cs[sp] *= __builtin_amdgcn_exp2f(ms[sp] - M); L += cs[sp]; }
    const float invL = 1.0f / L;
#pragma unroll
    for (int sp = 0; sp < NSPL; ++sp) cs[sp] *= invL;
#pragma unroll
    for (int s2 = 0; s2 < 2; ++s2) { const int s = 2 * wave + s2;
        f32x4 a0 = (f32x4){0.f, 0.f, 0.f, 0.f}, a1 = (f32x4){0.f, 0.f, 0.f, 0.f};
#pragma unroll
        for (int sp = 0; sp < NSPL; ++sp) {
            const bf16_t* po = PO + ((((size_t)b * NSPL + sp) * 8 + h) * 16 + r) * 512 + 32 * s + 4 * g;
            const u32x2 w0 = *(const u32x2*)po, w1 = *(const u32x2*)(po + 16);
            a0 += cs[sp] * (f32x4){__uint_as_float(w0.x << 16), __uint_as_float(w0.x & 0xffff0000u), __uint_as_float(w0.y << 16), __uint_as_float(w0.y & 0xffff0000u)};
            a1 += cs[sp] * (f32x4){__uint_as_float(w1.x << 16), __uint_as_float(w1.x & 0xffff0000u), __uint_as_float(w1.y << 16), __uint_as_float(w1.y & 0xffff0000u)};
        }
        *(LAS u32x4*)(lds + (s * 64 + lane) * 16) = (u32x4){pk2(a0[0], a0[1]), pk2(a0[2], a0[3]), pk2(a1[0], a1[1]), pk2(a1[2], a1[3])};
    }
    __syncthreads();
    const size_t qrow0 = (size_t)MP + (size_t)b * 16;
    const int dt = wave;
    f32x4 acc = (f32x4){0.f, 0.f, 0.f, 0.f};
    const bf16_t* wp = WUVT + (size_t)(h * 128 + 16 * dt + r) * 512 + 4 * g;
#pragma unroll
    for (int s = 0; s < 16; ++s) {
        const u32x2 lo = *(const u32x2*)(wp + 32 * s), hi = *(const u32x2*)(wp + 32 * s + 16);
        u32x4 t4 = (u32x4){lo.x, lo.y, hi.x, hi.y};
        const bf16x8 pf = *(const LAS bf16x8*)(lds + (s * 64 + lane) * 16);
        acc = __builtin_amdgcn_mfma_f32_16x16x32_bf16(__builtin_bit_cast(bf16x8, t4), pf, acc, 0, 0, 0);
    }
    u32x2 w; w.x = pk2(acc[0], acc[1]); w.y = pk2(acc[2], acc[3]);
    *(u32x2*)(MIX + (qrow0 + r) * 2048 + h * 128 + 16 * dt + 4 * g) = w;
    __syncthreads();
}

#define XB_TMO      128
#define XB_XCNT(j)  (256  + 64 * (j))
#define XB_XSUB(j)  (1280 + 64 * (j))
#define XB_XGEN(j)  (2304 + 64 * (j))
#define XB_TOP      3328
#define XB_TOPGEN   3392
#define XCD_BAR_WORDS 3456
#define XB_SPIN_CAP (1u << 18)
__device__ __forceinline__ unsigned xb_ld(unsigned* p)              { return __hip_atomic_load(p, __ATOMIC_RELAXED, __HIP_MEMORY_SCOPE_AGENT); }
__device__ __forceinline__ unsigned xb_add(unsigned* p, unsigned v) { return __hip_atomic_fetch_add(p, v, __ATOMIC_RELAXED, __HIP_MEMORY_SCOPE_AGENT); }
__device__ __forceinline__ unsigned xb_xcc_id() { return (unsigned)__builtin_amdgcn_s_getreg((3 << 11) | 20) & 0xFu; }
#define XB_SPIN(cond, bar) do { unsigned _sp = 0; while (cond) { __builtin_amdgcn_s_sleep(1); \
    if ((++_sp & 255u) == 0u) { if (xb_ld(&(bar)[XB_TMO])) break; if (_sp > XB_SPIN_CAP) { atomicAdd(&(bar)[XB_TMO], 1u); break; } } } } while (0)
struct XcdBarrier { unsigned* bar; unsigned x; volatile LAS unsigned* st; };
__device__ __forceinline__ XcdBarrier xcd_barrier_post(unsigned* bar, volatile LAS unsigned* st) {
    XcdBarrier b; b.bar = bar; b.x = xb_xcc_id(); b.st = st;
    if (threadIdx.x == 0) (void)xb_add(&bar[XB_XCNT(b.x)], 1u);
    return b;
}
__device__ __forceinline__ void xcd_barrier_complete(unsigned* bar, unsigned x, unsigned& nloc, unsigned& nx) {
    const unsigned G = gridDim.x * gridDim.y * gridDim.z;
    unsigned sum, cnt, mine, sp = 0u;
    for (;;) {
        sum = 0u; cnt = 0u; mine = 0u;
#pragma unroll
        for (unsigned j = 0; j < 16; ++j) { const unsigned c = xb_ld(&bar[XB_XCNT(j)]); sum += c; cnt += (c > 0u) ? 1u : 0u; mine = (j == x) ? c : mine; }
        if (sum == G) break;
        __builtin_amdgcn_s_sleep(1);
        if ((++sp & 255u) == 0u) { if (xb_ld(&bar[XB_TMO])) break; if (sp > XB_SPIN_CAP) { atomicAdd(&bar[XB_TMO], 1u); break; } }
    }
    nloc = mine > 0u ? mine : 1u; nx = cnt > 0u ? cnt : 1u;
}
__device__ __forceinline__ void xcd_barrier(const XcdBarrier& b) {
    asm volatile("s_waitcnt vmcnt(0)" ::: "memory");
    __syncthreads();
    if (threadIdx.x == 0) {
        unsigned* bar = b.bar;
        __builtin_amdgcn_s_waitcnt(0);
        unsigned nloc = b.st[0], nx = b.st[1];
        if (nloc == 0u) { xcd_barrier_complete(bar, b.x, nloc, nx); b.st[0] = nloc; b.st[1] = nx; }
        const unsigned old = xb_add(&bar[XB_XSUB(b.x)], 1u);
        const unsigned gen = old / nloc;
        if (old + 1u == (gen + 1u) * nloc) {
            __builtin_amdgcn_fence(__ATOMIC_RELEASE, "agent");
            asm volatile("s_waitcnt vmcnt(0)" ::: "memory");
            const unsigned og = xb_add(&bar[XB_TOP], 1u);
            const unsigned tg = og / nx;
            if (og + 1u == (tg + 1u) * nx) xb_add(&bar[XB_TOPGEN], 1u);
            else XB_SPIN(xb_ld(&bar[XB_TOPGEN]) == tg, bar);
            __builtin_amdgcn_fence(__ATOMIC_ACQUIRE, "agent");
            xb_add(&bar[XB_XGEN(b.x)], 1u);
            asm volatile("s_waitcnt vmcnt(0)" ::: "memory");
        } else {
            XB_SPIN(xb_ld(&bar[XB_XGEN(b.x)]) == gen, bar);
            __builtin_amdgcn_fence(__ATOMIC_ACQUIRE, "agent");
            asm volatile("s_waitcnt vmcnt(0)" ::: "memory");
        }
    }
    __syncthreads();
}

__device__ __forceinline__ void gsync(cg::grid_group& grid) {
    asm volatile("s_waitcnt vmcnt(0) lgkmcnt(0)" ::: "memory");
    grid.sync();
    __builtin_amdgcn_fence(__ATOMIC_ACQUIRE, "agent");
    asm volatile("s_waitcnt vmcnt(0)" ::: "memory");
}
struct Params { const float* in[21]; float* out; unsigned char* ws; };

__global__ void __launch_bounds__(512) mega(Params p) {
    extern __shared__ __attribute__((aligned(16))) unsigned char lds[];
    cg::grid_group grid = cg::this_grid();
    LAS unsigned char* ldsl = (LAS unsigned char*)lds;
    unsigned char* ws = p.ws; float* out = p.out; unsigned char* outb = (unsigned char*)p.out;
    const int G = gridDim.x, bx = blockIdx.x, tid = threadIdx.x;
    float* MOD = (float*)(ws + WS_MOD); const float* bada = p.in[8];
    const f32x2* ROPE = (const f32x2*)(ws + WS_ROPE);
    bf16_t* H = (bf16_t*)(ws + WS_H);
    float* Gb = (float*)(outb + OB_G); bf16_t* QH = (bf16_t*)(outb + OB_QH); bf16_t* VH = (bf16_t*)(outb + OB_VH);
    bf16_t* GATE = (bf16_t*)(ws + WS_GATE); bf16_t* KPE = (bf16_t*)(ws + WS_KPE); float* CQKV = (float*)(ws + WS_CQKV);
    bf16_t* Qb = (bf16_t*)(ws + WS_Q); bf16_t* CQN = (bf16_t*)(ws + WS_CQN); bf16_t* QLAT = (bf16_t*)(ws + WS_QLAT); bf16_t* CKV = (bf16_t*)(ws + WS_CKV);
    bf16_t* U = (bf16_t*)(ws + WS_U); bf16_t* MIX = (bf16_t*)(ws + WS_MIX); float* DD = (float*)(ws + WS_DD); bf16_t* Sn = (bf16_t*)(ws + WS_S);
    bf16_t* KN = (bf16_t*)(ws + WS_KN); bf16_t* VT = (bf16_t*)(ws + WS_VT); bf16_t* FFH = (bf16_t*)(ws + WS_FFH);
    float* X = out + O_Y;
    pg8::StaticOrder S;
    volatile LAS unsigned* xst = (volatile LAS unsigned*)(ldsl + LDS_Q + 16);
    if (tid == 0) { xst[0] = 0u; xst[1] = 0u; }
    __syncthreads();
    const XcdBarrier xbar = xcd_barrier_post((unsigned*)(ws + WS_BAR), xst);

#ifdef FILLTEST
    for (size_t i = (size_t)bx * 512 + tid; i < 48791552; i += (size_t)G * 512) out[i] = 0.5f;
#endif
    if (PHMASK & 1) phase0(p.in, ws, lds);
#ifdef PROBE_P0
    gsync(grid);
    phase0(p.in, ws, lds);
#endif
    xcd_barrier(xbar);
#ifdef PROBE_SYNC
    for (int z = 0; z < 10; ++z) xcd_barrier(xbar);
#endif
    if (PHMASK & 2) adaln_rows<0>((float*)lds, p.in[0], p.in[1], MOD, bada, 0, 2048, H);
    xcd_barrier(xbar);
    if (PHMASK & 4) { EpiIn E{CQKV, QH, Gb, VH, GATE, KPE, ROPE, out + O_KPE_P, out + O_KPE_S, p.in[15]};
      S.init(MT, NINP, 2048, G, bx); pg8::gemm_phase(ldsl, pg8::Gemm{H, (const bf16_t*)(ws + WS_WIN), MT, NINP, 2048}, S, E); }
    xcd_barrier(xbar);
    if (PHMASK & 8) latent_rows(CQKV, p.in[11], p.in[12], CQN, CKV, out + O_CKV_P, out + O_CKV_S);
    if (PHMASK & 16) for (int it = bx; it < NCHUNK; it += G) {
        if (it < NCHUNK_P) hgrn_a<64>(it, it >> 7, (it >> 10) * 8192 + (it & 127) * 64, 64, Gb, VH, U, DD, lds);
        else hgrn_a<32>(it, it - NCHUNK_P, MP + ((it - NCHUNK_P) >> 3) * 16, 16, Gb, VH, U, DD, lds);
    }
#ifdef PROBE_MISC
    xcd_barrier(xbar);
    latent_rows(CQKV, p.in[11], p.in[12], CQN, CKV, out + O_CKV_P, out + O_CKV_S);
    for (int it = bx; it < NCHUNK; it += G) {
        if (it < NCHUNK_P) hgrn_a<64>(it, it >> 7, (it >> 10) * 8192 + (it & 127) * 64, 64, Gb, VH, U, DD, lds);
        else hgrn_a<32>(it, it - NCHUNK_P, MP + ((it - NCHUNK_P) >> 3) * 16, 16, Gb, VH, U, DD, lds);
    }
#endif
    xcd_barrier(xbar);
    if (PHMASK & 32) { EpiQ E{Qb, ROPE}; S.init(MT, 1536, 512, G, bx); pg8::gemm_phase(ldsl, pg8::Gemm{CQN, (const bf16_t*)(ws + WS_WUQ), MT, 1536, 512}, S, E); }
    if (PHMASK & 32) { EpiPlain E{KN, 1024}; S.init(MP, 1024, 512, G, bx); pg8::gemm_phase(ldsl, pg8::Gemm{CKV, (const bf16_t*)(ws + WS_WUK), MP, 1024, 512}, S, E); }
    if (PHMASK & 32) { EpiPlain E{VT, 16384}; S.init(1024, MP, 512, G, bx); pg8::gemm_phase(ldsl, pg8::Gemm{(const bf16_t*)(ws + WS_WUV), CKV, 1024, MP, 512}, S, E); }
    if (PHMASK & 64) hgrn_b(U, DD, Sn, p.in[6], out + O_ST_P, out + O_ST_S);
#ifdef PROBE_MISC
    xcd_barrier(xbar);
    hgrn_b(U, DD, Sn, p.in[6], out + O_ST_P, out + O_ST_S);
#endif
    xcd_barrier(xbar);
    for (int p5rep = 0; p5rep < P5REPS; ++p5rep) {
    if (p5rep) xcd_barrier(xbar);
    if (PHMASK & 0x380) {
        unsigned* ctr = (unsigned*)(ws + WS_CTL) + p5rep * 64;
        volatile int* qslot = (volatile int*)(lds + LDS_Q);
        for (;;) {
            __syncthreads();
            if (tid == 0) *qslot = (int)__hip_atomic_fetch_add(ctr, 1u, __ATOMIC_RELAXED, __HIP_MEMORY_SCOPE_AGENT);
            __syncthreads();
            const int it = *qslot;
            if (it >= 256 + 512 + NCHUNK) break;
            const int pm_ = p5rep ? (P5MASK2) : 0x380;
            if (it < 256) { if (pm_ & 128) attn_sample_item(it >> 3, it & 7, Qb, (const bf16_t*)(ws + WS_WUKO), p.in[4], p.in[5], CKV, KPE, QLAT, (bf16_t*)(ws + WS_PO), (float*)(ws + WS_PML), ldsl); }
            else if (it < 256 + 512) { if (pm_ & 256) { const int j = it - 256, qb = 31 - (j >> 4), bh = j & 15; attn_prompt_item(bh >> 3, bh & 7, qb, Qb, KN, KPE, VT, MIX, ldsl); } }
            else if (pm_ & 512) { const int c = it - 768;
                if (c < NCHUNK_P) hgrn_c<64>(c, c >> 7, (c >> 10) * 8192 + (c & 127) * 64, 64, Gb, QH, VH, GATE, Sn, p.in[16], MIX, lds);
                else hgrn_c<32>(c, c - NCHUNK_P, MP + ((c - NCHUNK_P) >> 3) * 16, 16, Gb, QH, VH, GATE, Sn, p.in[16], MIX, lds); }
        }
    }
    }
    xcd_barrier(xbar);
    for (int ci = bx; ci < 256; ci += G) attn_sample_combine(ci >> 3, ci & 7, (const bf16_t*)(ws + WS_PO), (const float*)(ws + WS_PML), (const bf16_t*)(ws + WS_WUV), MIX, ldsl);
    xcd_barrier(xbar);
    if (PHMASK & 1024) { EpiRes E{p.in[0], p.in[1], X, MOD, bada, 4096, (float*)(ws + WS_CQKV)}; if (G == 256) S.init(MP, 2048, 2048, G, bx, 8, 64, 16); else S.init(MT, 2048, 2048, G, bx); pg8::gemm_phase(ldsl, pg8::Gemm{MIX, (const bf16_t*)(ws + WS_WOUT), MT, 2048, 2048}, S, E); }
    xcd_barrier(xbar);
    if (PHMASK & 2048) { if (G == 256) adaln_rows<8>((float*)lds, X, p.in[1], MOD, bada, 6144, 8192, H, (const float*)(ws + WS_CQKV), 4096, X); else adaln_rows<0>((float*)lds, X, X + (size_t)MP * DM, MOD, bada, 6144, 8192, H); }
    xcd_barrier(xbar);
#ifdef PROBE_P8
    { EpiRelu2 E{FFH}; S.init(MT, DFF, 2048, G, bx); pg8::gemm_phase(ldsl, pg8::Gemm{H, (const bf16_t*)(ws + WS_WFF1), MT, DFF, 2048}, S, E); }
    xcd_barrier(xbar);
#endif
    if (PHMASK & 4096) { EpiRelu2 E{FFH}; S.init(MT, DFF, 2048, G, bx); pg8::gemm_phase(ldsl, pg8::Gemm{H, (const bf16_t*)(ws + WS_WFF1), MT, DFF, 2048}, S, E); }
    xcd_barrier(xbar);
    if (PHMASK & 8192) { EpiRes E{X, X + (size_t)MP * DM, X, MOD, bada, 10240, (float*)(ws + WS_H)}; if (G == 256) S.init(MP, 2048, DFF, G, bx, 16, 64, 16); else S.init(MT, 2048, DFF, G, bx); pg8::gemm_phase(ldsl, pg8::Gemm{FFH, (const bf16_t*)(ws + WS_WFF2), MT, 2048, DFF}, S, E); }
    xcd_barrier(xbar);
    if (PHMASK & 16384) { if (G == 256) final_rows<16>((float*)lds, X, p.in[20], (const float*)(ws + WS_H), MOD, bada); else final_rows<0>((float*)lds, X, p.in[20], nullptr, MOD, bada); }
}

extern "C" void kernel_launch(void* const* d_in, const int* in_sizes, int n_in, void* d_out, int out_size, void* d_ws, size_t ws_size, hipStream_t stream) {
    static int grid_blocks = 0;
    if (grid_blocks == 0) {
        if (n_in != 21 || ws_size < WS_TOTAL) { fprintf(stderr, "kernel_launch: unexpected n_in %d or workspace %zu < %zu\n", n_in, ws_size, (size_t)WS_END); grid_blocks = -1; return; }
        int dev = 0, cus = 0, per_cu = 0;
        hipGetDevice(&dev);
        hipDeviceGetAttribute(&cus, hipDeviceAttributeMultiprocessorCount, dev);
        if (hipFuncSetAttribute((const void*)mega, hipFuncAttributeMaxDynamicSharedMemorySize, LDS_BYTES) != hipSuccess) { fprintf(stderr, "kernel_launch: hipFuncSetAttribute failed\n"); }
        if (hipOccupancyMaxActiveBlocksPerMultiprocessor(&per_cu, (const void*)mega, 512, LDS_BYTES) != hipSuccess || per_cu < 1) { fprintf(stderr, "kernel_launch: occupancy query gave %d\n", per_cu); per_cu = 1; }
        (void)hipGetLastError();
        grid_blocks = cus * 1;
    }
    if (grid_blocks < 0) return;
    (void)hipMemsetAsync((char*)d_ws + WS_BAR, 0, XCD_BAR_WORDS * 4, stream);
    Params p{};
    for (int i = 0; i < 21; ++i) p.in[i] = (const float*)d_in[i];
    p.out = (float*)d_out; p.ws = (unsigned char*)d_ws;
    void* args[] = {&p};
    hipError_t e = hipLaunchCooperativeKernel((const void*)mega, dim3(grid_blocks), dim3(512), args, LDS_BYTES, stream);
    if (e != hipSuccess) fprintf(stderr, "cooperative launch failed: %s (grid %d)\n", hipGetErrorString(e), grid_blocks);
}
```

```cpp
#include <hip/hip_runtime.h>
#include <hip/hip_cooperative_groups.h>
#include <cstdio>
namespace cg = cooperative_groups;

#define LAS __attribute__((address_space(3)))
typedef unsigned short bf16_t;
typedef short bf16x8 __attribute__((ext_vector_type(8)));
typedef float f32x4 __attribute__((ext_vector_type(4)));
typedef float f32x2 __attribute__((ext_vector_type(2)));
typedef unsigned u32x4 __attribute__((ext_vector_type(4)));
typedef unsigned u32x2 __attribute__((ext_vector_type(2)));

constexpr int MP = 16384, MS = 512, MT = MP + MS;
constexpr int DM = 2048, NMOD = 12288, NINP = 5376, DFF = 8192;
constexpr float EPSN = 1e-6f;
constexpr float QSCALE = 0.07216878364870322f * 1.4426950408889634f;
constexpr int NCHUNK_P = 2048, NCHUNK = 2304;

constexpr size_t O_Y = 0, O_CKV_P = 34603008, O_KPE_P = 42991616, O_ST_P = 44040192, O_CKV_S = 44302336, O_KPE_S = 44564480, O_ST_S = 44597248;
constexpr size_t OB_G = 0, OB_QH = 69206016, OB_VH = 103809024;
constexpr size_t WS_CTL = 0, WS_MOD = 4096, WS_ZERO_BYTES = 4096 + 34 * 12288 * 4;
constexpr size_t WS_ROPE = 1675264;
constexpr size_t WS_WIN = WS_ROPE + 2097152;
constexpr size_t WS_WUQ = WS_WIN + (size_t)NINP * 2048 * 2;
constexpr size_t WS_WUK = WS_WUQ + 1536 * 512 * 2;
constexpr size_t WS_WUV = WS_WUK + 1024 * 512 * 2;
constexpr size_t WS_WUKO = WS_WUV + 1024 * 512 * 2;
constexpr size_t WS_WOUT = WS_WUKO + 1024 * 512 * 2;
constexpr size_t WS_WFF1 = WS_WOUT + 2048 * 2048 * 2;
constexpr size_t WS_WFF2 = WS_WFF1 + (size_t)8192 * 2048 * 2;
constexpr size_t WS_H = WS_WFF2 + (size_t)8192 * 2048 * 2;
constexpr size_t WS_KN = WS_H, WS_VT = WS_H + (size_t)MP * 1024 * 2;
constexpr size_t WS_ARENA = WS_H + (size_t)MT * 2048 * 2;
constexpr size_t WS_GATE = WS_ARENA;
constexpr size_t WS_KPE = WS_GATE + (size_t)MT * 1024 * 2;
constexpr size_t WS_CQKV = WS_KPE + (size_t)MT * 64 * 2;
constexpr size_t WS_Q = WS_CQKV;
constexpr size_t WS_CQN = WS_CQKV + (size_t)MT * 1024 * 4;
constexpr size_t WS_QLAT = WS_WIN;
constexpr size_t WS_PO = WS_CQKV + (size_t)MT * 1536 * 2;
constexpr size_t WS_PML = WS_PO + (size_t)256 * 8 * 16 * 512 * 2;
constexpr size_t WS_CKV = WS_CQN + (size_t)MT * 512 * 2;
constexpr size_t WS_U = WS_CKV + (size_t)MT * 512 * 2;
constexpr size_t WS_MIX = WS_U;
constexpr size_t WS_DD = WS_U + (size_t)NCHUNK * 16384 * 2;
constexpr size_t WS_S = WS_DD + (size_t)NCHUNK * 128 * 4;
constexpr size_t WS_END = WS_S + (size_t)NCHUNK * 16384 * 2;
constexpr size_t WS_FFH = WS_ARENA;
constexpr size_t WS_BAR = WS_END, WS_TOTAL = WS_END + 16384;
static_assert(WS_ARENA + (size_t)MT * DFF * 2 <= WS_END, "ffh overlay");
static_assert(WS_PML + 256 * 8 * 16 * 2 * 4 <= WS_CKV, "sample partials");
static_assert((size_t)32 * 8 * 16 * 576 * 2 <= (size_t)NINP * 2048 * 2, "qlat");

#ifndef P5MASK2
#define P5MASK2 0x380
#endif
#ifndef P5REPS
#define P5REPS 1
#endif
#ifndef PHMASK
#define PHMASK 0xFFFF
#endif
constexpr int LDS_BYTES = 131072 + 256;
constexpr int LDS_Q = 131072;

typedef __bf16 bf16v2 __attribute__((ext_vector_type(2)));
__device__ __forceinline__ unsigned pk2(float lo, float hi) { const f32x2 v = (f32x2){lo, hi}; const bf16v2 b = __builtin_convertvector(v, bf16v2); return __builtin_bit_cast(unsigned, b); }
__device__ __forceinline__ float bf2f(bf16_t b) { return __uint_as_float(((unsigned)b) << 16); }
__device__ __forceinline__ float wave_sum(float v) {
#pragma unroll
    for (int o = 1; o < 64; o <<= 1) v += __shfl_xor(v, o);
    return v;
}
__device__ __forceinline__ int ltid() { int t = threadIdx.x; asm volatile("" : "+v"(t)); return t; }
__device__ __forceinline__ float silu_f(float v) { return v * __builtin_amdgcn_rcpf(1.0f + __expf(-v)); }
__device__ __forceinline__ int row_pos(int r) { return r < MP ? (r & 8191) : 2048 + ((r - MP) & 15); }
__device__ __forceinline__ int row_ci(int r) { return r < MP ? (r >> 13) : 2 + ((r - MP) >> 4); }

namespace pg8 {
constexpr int BM = 256, BK = 64, HALF = 128, HTB = HALF * BK * 2, STAGE_BYTES = 8 * HTB, NXCD = 8, WGM = 8;
__host__ __device__ __forceinline__ int lds_byte(int r, int c) { const int st = (r >> 4) * 2 + (c >> 5), rr = r & 15, cc = c & 31, ob = rr * 64 + cc * 2; return st * 1024 + (ob ^ (((ob >> 9) & 1) << 5)); }
__host__ __device__ __forceinline__ void stage_rc(int b, int& R, int& C) { const int st = b / 1024, sb = b % 1024, swz = sb ^ (((sb >> 9) & 1) << 5); R = (st >> 1) * 16 + swz / 64; C = (st & 1) * 32 + (swz % 64) / 2; }
struct Unit { int pm, pn, k0, nt, sl; };
struct Gemm { const bf16_t* A; const bf16_t* Bt; int M, N, K; };
struct StaticOrder {
    int nM, nN, nwg, G, c, ntK, ns, tail_pm0, ntail;
    __host__ __device__ void init(int M, int N, int K, int G_, int c_, int ns_ = 1, int tail_pm0_ = 0, int ntail_ = 0) { nM = M / BM; nN = N / BM; nwg = nM * nN; G = G_; c = c_; ntK = K / BK; ns = ns_; tail_pm0 = tail_pm0_; ntail = ntail_; }
    __host__ __device__ __forceinline__ void unit_of(int L, Unit& u) const {
        int wgid = L; { const int q = nwg / NXCD, r = nwg % NXCD, xcd = wgid % NXCD, off = wgid / NXCD; wgid = (xcd < r ? xcd * (q + 1) : r * (q + 1) + (xcd - r) * q) + off; }
        const int nig = WGM * nN, gid = wgid / nig, fm = gid * WGM, gsz = (nM - fm) < WGM ? (nM - fm) : WGM;
        u.pm = fm + ((wgid % nig) % gsz); u.pn = (wgid % nig) / gsz;
    }
    __host__ __device__ __forceinline__ bool next(int i, Unit& u) const {
        int L = i * G + c, k0 = 0, nt = ntK, sl = 0; bool ok = L < nwg;
        if (!ok) L = 0;
        unit_of(L, u);
        if (ns > 1) {
            const int rounds = nwg / G, idx = c / ns;
            const bool tail = (i == rounds) && (idx < ntail);
            if (tail) { nt = ntK / ns; k0 = (c % ns) * nt * BK; sl = 1; u.pm = tail_pm0 + idx / nN; u.pn = idx % nN; ok = true; }
        }
        u.k0 = k0; u.nt = nt; u.sl = sl; return ok;
    }
};
template <class Epi>
__device__ __forceinline__ void gemm_phase(LAS unsigned char* lds, const Gemm g, const StaticOrder& S, const Epi& E) {
    const int tid = ltid(), wid = __builtin_amdgcn_readfirstlane(tid >> 6), lane = tid & 63, wr = wid >> 2, wc = wid & 3, fr = lane & 15, fq = lane >> 4;
    const int K = g.K;
    unsigned voffA[2], voffB[2];
#pragma unroll
    for (int i = 0; i < 2; ++i) { int R, C; stage_rc(tid * 16 + i * 8192, R, C); voffA[i] = (unsigned)(R * K + C) * 2u; voffB[i] = (unsigned)(R * K + C) * 2u; }
    const size_t kstep = (size_t)(BK * 2);
    const size_t hstep = (size_t)HALF * K * 2;
    const size_t tstep = 2 * hstep;
    const unsigned ldsw = (unsigned)wid * 1024u;
    const int aoff = lds_byte(wr * 64 + fr, fq * 8), boff = lds_byte(wc * 32 + fr, fq * 8);
#define PG8_SA(b, h) (((b) * 2 + (h)) * HTB)
#define PG8_SB(b, h) ((4 + (b) * 2 + (h)) * HTB)
#define PG8_STAGE(bufoff, gbase, voff) do { _Pragma("unroll") for (int _i = 0; _i < 2; ++_i) \
        __builtin_amdgcn_global_load_lds((const unsigned*)((const char*)(gbase) + (voff)[_i]), (LAS unsigned*)(lds + (bufoff) + ldsw + _i * 8192), 16, 0, 0); } while (0)
#define PG8_LDA(dst, b, h) do { _Pragma("unroll") for (int m = 0; m < 4; ++m) _Pragma("unroll") for (int k = 0; k < 2; ++k) dst[m][k] = *(const LAS bf16x8*)(lds + PG8_SA(b, h) + aoff + m * 2048 + k * 1024); } while (0)
#define PG8_LDB(dst, b, h) do { _Pragma("unroll") for (int n = 0; n < 2; ++n) _Pragma("unroll") for (int k = 0; k < 2; ++k) dst[n][k] = *(const LAS bf16x8*)(lds + PG8_SB(b, h) + boff + n * 2048 + k * 1024); } while (0)
#define PG8_MMA(ai, bj, At, Bt) do { __builtin_amdgcn_s_setprio(1); _Pragma("unroll") for (int m = 0; m < 4; ++m) _Pragma("unroll") for (int n = 0; n < 2; ++n) _Pragma("unroll") for (int k = 0; k < 2; ++k) \
        acc[ai][bj][m][n] = __builtin_amdgcn_mfma_f32_16x16x32_bf16(Bt[n][k], At[m][k], acc[ai][bj][m][n], 0, 0, 0); __builtin_amdgcn_s_setprio(0); } while (0)
#define PG8_WAIT_V(n) asm volatile("s_waitcnt vmcnt(" #n ")" ::: "memory")
#define PG8_WAIT_L(n) asm volatile("s_waitcnt lgkmcnt(" #n ")" ::: "memory")
#define PG8_BAR __builtin_amdgcn_s_barrier()
#define PG8_SCHED __builtin_amdgcn_sched_barrier(0)
    Unit cur, nxt; int ui = 0;
    if (!S.next(0, cur)) return;
    f32x4 acc[2][2][4][2];
#pragma unroll
    for (int a = 0; a < 2; ++a)
#pragma unroll
        for (int b = 0; b < 2; ++b)
#pragma unroll
            for (int m = 0; m < 4; ++m)
#pragma unroll
                for (int n = 0; n < 2; ++n) acc[a][b][m][n] = (f32x4){0.f, 0.f, 0.f, 0.f};
    bf16x8 At[4][2], B0[2][2], B1[2][2];
    const char* cA = (const char*)g.A + (size_t)cur.pm * tstep + (size_t)cur.k0 * 2; const char* cB = (const char*)g.Bt + (size_t)cur.pn * tstep + (size_t)cur.k0 * 2;
    PG8_STAGE(PG8_SB(0, 0), cB, voffB); PG8_STAGE(PG8_SA(0, 0), cA, voffA); PG8_STAGE(PG8_SB(0, 1), cB + hstep, voffB); PG8_STAGE(PG8_SA(0, 1), cA + hstep, voffA);
    if (wr == 1) PG8_BAR;
    PG8_WAIT_V(4); PG8_BAR;
    PG8_STAGE(PG8_SB(1, 0), cB + kstep, voffB); PG8_STAGE(PG8_SA(1, 0), cA + kstep, voffA); PG8_STAGE(PG8_SB(1, 1), cB + hstep + kstep, voffB);
    PG8_WAIT_V(6); PG8_BAR;
    for (;;) {
        const bool has_next = S.next(ui + 1, nxt);
        const char* nA = has_next ? (const char*)g.A + (size_t)nxt.pm * tstep + (size_t)nxt.k0 * 2 : cA; const char* nB = has_next ? (const char*)g.Bt + (size_t)nxt.pn * tstep + (size_t)nxt.k0 * 2 : cB;
        const int nt = cur.nt;
        for (int t = 0; t < nt; t += 2) {
            const bool last = (t == nt - 2);
            const char* a1 = cA + (size_t)(t + 1) * kstep;
            const char* a2 = last ? nA : cA + (size_t)(t + 2) * kstep; const char* b2 = last ? nB : cB + (size_t)(t + 2) * kstep;
            const char* a3 = a2 + kstep; const char* b3 = b2 + kstep;
            PG8_LDB(B0, 0, 0); PG8_SCHED; PG8_LDA(At, 0, 0); PG8_STAGE(PG8_SA(1, 1), a1 + hstep, voffA);
            PG8_WAIT_L(8); PG8_BAR; PG8_WAIT_L(0); PG8_MMA(0, 0, At, B0); PG8_BAR; PG8_SCHED;
            PG8_LDB(B1, 0, 1); PG8_STAGE(PG8_SB(0, 0), b2, voffB);
            PG8_BAR; PG8_WAIT_L(0); PG8_MMA(0, 1, At, B1); PG8_BAR;
            PG8_LDA(At, 0, 1); PG8_STAGE(PG8_SA(0, 0), a2, voffA);
            PG8_BAR; PG8_WAIT_L(0); PG8_MMA(1, 0, At, B0); PG8_BAR; PG8_SCHED;
            PG8_STAGE(PG8_SB(0, 1), b2 + hstep, voffB);
            PG8_WAIT_V(6); PG8_BAR; PG8_MMA(1, 1, At, B1); PG8_BAR;
            PG8_LDB(B0, 1, 0); PG8_SCHED; PG8_LDA(At, 1, 0); PG8_STAGE(PG8_SA(0, 1), a2 + hstep, voffA);
            PG8_WAIT_L(8); PG8_BAR; PG8_WAIT_L(0); PG8_MMA(0, 0, At, B0); PG8_BAR; PG8_SCHED;
            PG8_LDB(B1, 1, 1); PG8_STAGE(PG8_SB(1, 0), b3, voffB);
            PG8_BAR; PG8_WAIT_L(0); PG8_MMA(0, 1, At, B1); PG8_BAR;
            PG8_LDA(At, 1, 1); PG8_STAGE(PG8_SA(1, 0), a3, voffA);
            PG8_BAR; PG8_WAIT_L(0); PG8_MMA(1, 0, At, B0); PG8_BAR; PG8_SCHED;
            PG8_STAGE(PG8_SB(1, 1), b3 + hstep, voffB);
            PG8_WAIT_V(6); PG8_BAR; PG8_MMA(1, 1, At, B1); PG8_BAR;
        }
        E(acc, cur, wr, wc, fr, fq);
        if (!has_next) break;
#pragma unroll
        for (int a = 0; a < 2; ++a)
#pragma unroll
            for (int b = 0; b < 2; ++b)
#pragma unroll
                for (int m = 0; m < 4; ++m)
#pragma unroll
                    for (int n = 0; n < 2; ++n) acc[a][b][m][n] = (f32x4){0.f, 0.f, 0.f, 0.f};
        cur = nxt; cA = nA; cB = nB; ++ui;
    }
    PG8_WAIT_V(0);
    if (wr == 0) PG8_BAR;
    PG8_BAR;
#undef PG8_SA
#undef PG8_SB
#undef PG8_STAGE
#undef PG8_LDA
#undef PG8_LDB
#undef PG8_MMA
#undef PG8_WAIT_V
#undef PG8_WAIT_L
#undef PG8_BAR
#undef PG8_SCHED
}
}

template <class F>
__device__ __forceinline__ void epi_walk(const f32x4 (&acc)[2][2][4][2], const pg8::Unit& u, int wr, int wc, int fr, int fq, const F& f) {
    const int row0 = u.pm * 256 + wr * 64 + fr;
#pragma unroll
    for (int ai = 0; ai < 2; ++ai)
#pragma unroll
        for (int m = 0; m < 4; ++m) {
            const int r = row0 + ai * 128 + m * 16;
#pragma unroll
            for (int bj = 0; bj < 2; ++bj)
#pragma unroll
                for (int n = 0; n < 2; ++n) f(r, bj * 128 + wc * 32 + n * 16 + 4 * fq, acc[ai][bj][m][n]);
        }
}

struct EpiIn {
    float* cqkv; bf16_t* qh; float* g; bf16_t* vh; bf16_t* gate; bf16_t* kpe; const f32x2* rope; float* okp; float* oks; const float* hglb;
    __device__ __forceinline__ void operator()(const f32x4 (&acc)[2][2][4][2], const pg8::Unit& u, int wr, int wc, int fr, int fq) const {
        const int pn = u.pn;
        epi_walk(acc, u, wr, wc, fr, fq, [&](int r, int cl, f32x4 v) {
            const int c = pn * 256 + cl;
            if (pn < 4) { *(f32x4*)(cqkv + (size_t)r * 1024 + c) = v; }
            else if (pn < 8) {
                const float sc = 0.08838834764831845f;
                u32x2 w; w.x = pk2(silu_f(v[0]) * sc, silu_f(v[1]) * sc); w.y = pk2(silu_f(v[2]) * sc, silu_f(v[3]) * sc);
                *(u32x2*)(qh + (size_t)r * 1024 + (c - 1024)) = w;
            } else if (pn < 12) {
                const int j = c - 2048;
                const f32x4 a0 = *(const f32x4*)(hglb + j), a1 = *(const f32x4*)(hglb + 1024 + j);
                f32x4 o;
#pragma unroll
                for (int e = 0; e < 4; ++e) { const float lb = __builtin_amdgcn_rcpf(1.0f + __expf(a1[e] - a0[e])); const float sg = __builtin_amdgcn_rcpf(1.0f + __expf(-v[e])); o[e] = __logf(lb + (1.0f - lb) * sg); }
                *(f32x4*)(g + (size_t)r * 1024 + j) = o;
            } else if (pn < 16) {
                u32x2 w; w.x = pk2(v[0], v[1]); w.y = pk2(v[2], v[3]);
                *(u32x2*)(vh + (size_t)r * 1024 + (c - 3072)) = w;
            } else if (pn < 20) {
                u32x2 w; w.x = pk2(silu_f(v[0]), silu_f(v[1])); w.y = pk2(silu_f(v[2]), silu_f(v[3]));
                *(u32x2*)(gate + (size_t)r * 1024 + (c - 4096)) = w;
            } else if (cl < 64) {
                const int i0 = cl >> 1, pos = row_pos(r);
                const f32x2 c0 = rope[pos * 32 + i0], c1 = rope[pos * 32 + i0 + 1];
                const float o1a = v[0] * c0.x - v[1] * c0.y, o2a = v[1] * c0.x + v[0] * c0.y;
                const float o1b = v[2] * c1.x - v[3] * c1.y, o2b = v[3] * c1.x + v[2] * c1.y;
                float* ob = r < MP ? okp + (size_t)r * 64 : oks + (size_t)(r - MP) * 64;
                *(f32x2*)(ob + i0) = (f32x2){o1a, o1b}; *(f32x2*)(ob + 32 + i0) = (f32x2){o2a, o2b};
                u32x2 w; w.x = pk2(o1a, o2a); w.y = pk2(o1b, o2b);
                *(u32x2*)(kpe + (size_t)r * 64 + cl) = w;
            }
        });
    }
};
struct EpiQ {
    bf16_t* q; const f32x2* rope;
    __device__ __forceinline__ void operator()(const f32x4 (&acc)[2][2][4][2], const pg8::Unit& u, int wr, int wc, int fr, int fq) const {
        const int pn = u.pn;
        epi_walk(acc, u, wr, wc, fr, fq, [&](int r, int cl, f32x4 v) {
            const int c = pn * 256 + cl, h = c / 192, j = c - h * 192;
            u32x2 w;
            if (j < 128) { w.x = pk2(v[0] * QSCALE, v[1] * QSCALE); w.y = pk2(v[2] * QSCALE, v[3] * QSCALE); }
            else {
                const int i0 = (j - 128) >> 1, pos = row_pos(r);
                const f32x2 c0 = rope[pos * 32 + i0], c1 = rope[pos * 32 + i0 + 1];
                const float o1a = v[0] * c0.x - v[1] * c0.y, o2a = v[1] * c0.x + v[0] * c0.y;
                const float o1b = v[2] * c1.x - v[3] * c1.y, o2b = v[3] * c1.x + v[2] * c1.y;
                w.x = pk2(o1a * QSCALE, o2a * QSCALE); w.y = pk2(o1b * QSCALE, o2b * QSCALE);
            }
            *(u32x2*)(q + (size_t)r * 1536 + c) = w;
        });
    }
};
struct EpiPlain {
    bf16_t* o; int ldc;
    __device__ __forceinline__ void operator()(const f32x4 (&acc)[2][2][4][2], const pg8::Unit& u, int wr, int wc, int fr, int fq) const {
        const int pn = u.pn;
        epi_walk(acc, u, wr, wc, fr, fq, [&](int r, int cl, f32x4 v) {
            u32x2 w; w.x = pk2(v[0], v[1]); w.y = pk2(v[2], v[3]);
            *(u32x2*)(o + (size_t)r * ldc + pn * 256 + cl) = w;
        });
    }
};
struct EpiRelu2 {
    bf16_t* o;
    __device__ __forceinline__ void operator()(const f32x4 (&acc)[2][2][4][2], const pg8::Unit& u, int wr, int wc, int fr, int fq) const {
        const int pn = u.pn;
        epi_walk(acc, u, wr, wc, fr, fq, [&](int r, int cl, f32x4 v) {
            f32x4 t;
#pragma unroll
            for (int e = 0; e < 4; ++e) { const float a = fmaxf(v[e], 0.f); t[e] = a * a; }
            u32x2 w; w.x = pk2(t[0], t[1]); w.y = pk2(t[2], t[3]);
            *(u32x2*)(o + (size_t)r * DFF + pn * 256 + cl) = w;
        });
    }
};
struct EpiRes {
    const float* xa; const float* xb; float* xo; const float* mod; const float* bada; int goff; float* part;
    __device__ __forceinline__ void operator()(const f32x4 (&acc)[2][2][4][2], const pg8::Unit& u, int wr, int wc, int fr, int fq) const {
        const int pn = u.pn, sl = u.sl, sidx = u.k0 / (u.nt * 64);
        epi_walk(acc, u, wr, wc, fr, fq, [&](int r, int cl, f32x4 v) {
            const int c = pn * 256 + cl;
            if (sl) { *(f32x4*)(part + ((size_t)sidx * MS + (r - MP)) * DM + c) = v; }
            else {
                const int ci = row_ci(r);
                const float* xi = r < MP ? xa + (size_t)r * DM : xb + (size_t)(r - MP) * DM;
                const f32x4 gt = *(const f32x4*)(mod + (size_t)ci * NMOD + goff + c) + *(const f32x4*)(bada + goff + c);
                const f32x4 x = *(const f32x4*)(xi + c);
                *(f32x4*)(xo + (size_t)r * DM + c) = x + gt * v;
            }
        });
    }
};

__device__ __forceinline__ int map_row(int mat, int n) {
    if (mat == 0) { if (n < 1024) return n; if (n < 1088) { const int i = n - 1024; return 5120 + (i < 32 ? 2 * i : 2 * (i - 32) + 1); } return n - 64; }
    if (mat == 1) { const int h = n / 192, j = n - h * 192; if (j < 128) return n; const int i = j - 128; return h * 192 + 128 + (i < 32 ? 2 * i : 2 * (i - 32) + 1); }
    return n;
}
struct TrItem { const float* W; bf16_t* WT; int K, N, mat, item; };
__device__ __forceinline__ void tr_load(const TrItem& t, int lane, float (&tv)[32]) {
    const int nblk = t.N / 32, kb = t.item / nblk, nb = t.item % nblk, k0 = 64 * kb, n0 = 32 * nb;
#pragma unroll
    for (int i = 0; i < 32; ++i) { const int kk = 2 * i + (lane >> 5); tv[i] = t.W[(size_t)(k0 + kk) * t.N + n0 + (lane & 31)]; }
}
__device__ __forceinline__ void tr_store(const TrItem& t, int lane, const float (&tv)[32], LAS float* scr) {
    const int nblk = t.N / 32, kb = t.item / nblk, nb = t.item % nblk, k0 = 64 * kb, n0 = 32 * nb;
#pragma unroll
    for (int i = 0; i < 32; ++i) { const int kk = 2 * i + (lane >> 5); scr[kk * 33 + (lane & 31)] = tv[i]; }
    asm volatile("s_waitcnt lgkmcnt(0)" ::: "memory");
    const int c = lane & 7;
#pragma unroll
    for (int j = 0; j < 4; ++j) { const int n = (lane >> 3) + 8 * j; const LAS float* sp = scr + (8 * c) * 33 + n;
        u32x4 o; o.x = pk2(sp[0 * 33], sp[1 * 33]); o.y = pk2(sp[2 * 33], sp[3 * 33]); o.z = pk2(sp[4 * 33], sp[5 * 33]); o.w = pk2(sp[6 * 33], sp[7 * 33]);
        *(u32x4*)(t.WT + (size_t)map_row(t.mat, n0 + n) * t.K + k0 + 8 * c) = o; }
    asm volatile("s_waitcnt lgkmcnt(0)" ::: "memory");
}
__device__ __forceinline__ TrItem tr_item(const float* const* in, unsigned char* ws, int it) {
    constexpr int I0 = 32 * 162, I1 = 8 * 48, I2 = 8 * 32, I3 = 8 * 32, I4 = 32 * 64, I5 = 32 * 256;
    int r = it;
    if (r < I0) return TrItem{in[9], (bf16_t*)(ws + WS_WIN), 2048, 5184, 0, r}; r -= I0;
    if (r < I1) return TrItem{in[10], (bf16_t*)(ws + WS_WUQ), 512, 1536, 1, r}; r -= I1;
    if (r < I2) return TrItem{in[13], (bf16_t*)(ws + WS_WUK), 512, 1024, 2, r}; r -= I2;
    if (r < I3) return TrItem{in[14], (bf16_t*)(ws + WS_WUV), 512, 1024, 2, r}; r -= I3;
    if (r < I4) return TrItem{in[17], (bf16_t*)(ws + WS_WOUT), 2048, 2048, 2, r}; r -= I4;
    if (r < I5) return TrItem{in[18], (bf16_t*)(ws + WS_WFF1), 2048, 8192, 2, r}; r -= I5;
    return TrItem{in[19], (bf16_t*)(ws + WS_WFF2), 8192, 2048, 2, r};
}
__device__ __forceinline__ void phase0(const float* const* in, unsigned char* ws, unsigned char* lds) {
    const int tid = ltid(), lane = tid & 63, wave = tid >> 6, G = gridDim.x, bx = blockIdx.x;
    {
        float* sl = (float*)lds;
        float* MOD = (float*)(ws + WS_MOD);
        const float* wada = in[7];
        if (bx == 0 && tid < 2) __hip_atomic_store((unsigned*)(ws + WS_CTL) + tid * 64, 0u, __ATOMIC_RELAXED, __HIP_MEMORY_SCOPE_AGENT);
        for (int it = bx; it < 192; it += G) {
            const int grp = tid >> 6, col = it * 64 + lane;
            float acc[34];
#pragma unroll
            for (int r = 0; r < 34; ++r) acc[r] = 0.f;
            for (int pass = 0; pass < 4; ++pass) {
                __syncthreads();
                for (int e = tid; e < 34 * 512; e += 512) { const int r = e >> 9, kl = e & 511, kg = (kl >> 6) * 256 + pass * 64 + (kl & 63);
                    const float cv = r < 2 ? in[2][r * DM + kg] : in[3][(r - 2) * DM + kg]; sl[e] = silu_f(cv); }
                __syncthreads();
                const int k0 = grp * 256 + pass * 64;
                for (int kk = 0; kk < 64; kk += 8) {
                    float w[8];
#pragma unroll
                    for (int j = 0; j < 8; ++j) w[j] = wada[(size_t)(k0 + kk + j) * NMOD + col];
#pragma unroll
                    for (int r = 0; r < 34; ++r) { const f32x4 sv = *(const f32x4*)(sl + r * 512 + grp * 64 + kk), sw = *(const f32x4*)(sl + r * 512 + grp * 64 + kk + 4);
                        acc[r] += (sv[0] * w[0] + sv[1] * w[1] + sv[2] * w[2] + sv[3] * w[3]) + (sw[0] * w[4] + sw[1] * w[5] + sw[2] * w[6] + sw[3] * w[7]); }
                }
            }
            __syncthreads();
            float* red = (float*)lds;
#pragma unroll
            for (int r = 0; r < 34; ++r) red[(grp * 34 + r) * 64 + lane] = acc[r];
            __syncthreads();
            for (int e = tid; e < 34 * 64; e += 512) { const int r = e >> 6, c = e & 63; float sum = 0.f;
#pragma unroll
                for (int g2 = 0; g2 < 8; ++g2) sum += red[(g2 * 34 + r) * 64 + c];
                MOD[(size_t)r * NMOD + it * 64 + c] = sum; }
            __syncthreads();
        }
    }
    {
        LAS float* scr = (LAS float*)lds + wave * (64 * 33);
        const int gw = bx * 8 + wave, NGW = G * 8;
        constexpr int NIT = 32 * 162 + 8 * 48 + 8 * 32 + 8 * 32 + 32 * 64 + 32 * 256 + 128 * 64;
        float ta[32], tb[32];
        int it = gw;
        if (it < NIT) tr_load(tr_item(in, ws, it), lane, ta);
        for (; it < NIT; it += 2 * NGW) {
            if (it + NGW < NIT) tr_load(tr_item(in, ws, it + NGW), lane, tb);
            tr_store(tr_item(in, ws, it), lane, ta, scr);
            if (it + NGW < NIT) {
                if (it + 2 * NGW < NIT) tr_load(tr_item(in, ws, it + 2 * NGW), lane, ta);
                tr_store(tr_item(in, ws, it + NGW), lane, tb, scr);
            }
        }
    }
    const int gt = bx * 512 + tid, NGT = G * 512;
    { u32x4* z = (u32x4*)(ws + WS_WIN + (size_t)5184 * 2048 * 2); for (int i = gt; i < 192 * 2048 * 2 / 16; i += NGT) z[i] = (u32x4){0u, 0u, 0u, 0u}; }
    { const f32x4* s = (const f32x4*)in[13]; u32x2* d = (u32x2*)(ws + WS_WUKO); for (int i = gt; i < 512 * 1024 / 4; i += NGT) { const f32x4 v = s[i]; u32x2 w; w.x = pk2(v[0], v[1]); w.y = pk2(v[2], v[3]); d[i] = w; } }
    { f32x2* rp = (f32x2*)(ws + WS_ROPE);
      for (int i = gt; i < 8192 * 32; i += NGT) { const int pos = i >> 5, k = i & 31;
          const double invf = exp(-9.210340371976184 * (double)k / 32.0); const double t = (double)pos * invf * 0.15915494309189535; const float fr = (float)(t - rint(t));
          rp[i] = (f32x2){__builtin_amdgcn_cosf(fr), __builtin_amdgcn_sinf(fr)}; } }
}

template <int NSL, int PARTS = 3>
__device__ __forceinline__ void adaln_rows(float* xch, const float* xa, const float* xb, const float* mod, const float* bada, int off_sh, int off_sc, bf16_t* H,
                                           const float* part = nullptr, int off_gt = 0, float* xout = nullptr, int wg0 = 0, int nwg = 0) {
    const int tid_ = ltid(), lane = tid_ & 63;
    const int nw_ = nwg ? nwg : (int)gridDim.x, gw = ((int)blockIdx.x - wg0) * 8 + (tid_ >> 6), NGW = nw_ * 8;
    if (PARTS & 1) {
        f32x4 v[8], nx[8];
#pragma unroll
        for (int j = 0; j < 8; ++j) v[j] = *(const f32x4*)(xa + (size_t)gw * DM + 4 * lane + 256 * j);
        for (int row = gw; row < MP; row += NGW) {
            const int nrow = row + NGW;
            if (nrow < MP) {
#pragma unroll
                for (int j = 0; j < 8; ++j) nx[j] = *(const f32x4*)(xa + (size_t)nrow * DM + 4 * lane + 256 * j); }
            const int ci = row >> 13;
            float ss = 0.f;
#pragma unroll
            for (int j = 0; j < 8; ++j) ss += (v[j][0] * v[j][0] + v[j][1] * v[j][1]) + (v[j][2] * v[j][2] + v[j][3] * v[j][3]);
            const float* mr = mod + (size_t)ci * NMOD;
            const float rstd = 1.0f / sqrtf(wave_sum(ss) * (1.0f / DM) + EPSN);
#pragma unroll
            for (int j = 0; j < 8; ++j) { const int c = 4 * lane + 256 * j;
                const f32x4 scj = *(const f32x4*)(mr + off_sc + c) + *(const f32x4*)(bada + off_sc + c) + 1.0f;
                const f32x4 shj = *(const f32x4*)(mr + off_sh + c) + *(const f32x4*)(bada + off_sh + c);
                const f32x4 h = v[j] * rstd * scj + shj;
                u32x2 w; w.x = pk2(h[0], h[1]); w.y = pk2(h[2], h[3]);
                *(u32x2*)(H + (size_t)row * DM + c) = w; v[j] = nx[j]; }
        }
    }
    __builtin_amdgcn_sched_barrier(0);
    if (PARTS & 2) {
        const int wave = tid_ >> 6, q4 = wave & 3;
        for (int rp = blockIdx.x; rp < MS / 2; rp += gridDim.x) {
            const int sr = 2 * rp + (wave >> 2), row = MP + sr; const float* xr = xb + (size_t)sr * DM; const float* mr = mod + (size_t)row_ci(row) * NMOD;
            f32x4 v[2]; float ss = 0.f;
#pragma unroll
            for (int j = 0; j < 2; ++j) { const int c = q4 * 512 + 4 * lane + 256 * j; v[j] = *(const f32x4*)(xr + c);
                if (NSL > 0) { f32x4 a = (f32x4){0.f, 0.f, 0.f, 0.f};
#pragma unroll
                    for (int s2 = 0; s2 < NSL; ++s2) a += *(const f32x4*)(part + ((size_t)s2 * MS + sr) * DM + c);
                    const f32x4 gt = *(const f32x4*)(mr + off_gt + c) + *(const f32x4*)(bada + off_gt + c);
                    v[j] += gt * a; *(f32x4*)(xout + (size_t)row * DM + c) = v[j]; }
                ss += (v[j][0] * v[j][0] + v[j][1] * v[j][1]) + (v[j][2] * v[j][2] + v[j][3] * v[j][3]); }
            ss = wave_sum(ss);
            __syncthreads();
            if (lane == 0) xch[wave] = ss;
            __syncthreads();
            const int w0 = wave & 4;
            const float rstd = 1.0f / sqrtf(((xch[w0] + xch[w0 + 1]) + (xch[w0 + 2] + xch[w0 + 3])) * (1.0f / DM) + EPSN);
#pragma unroll
            for (int j = 0; j < 2; ++j) { const int c = q4 * 512 + 4 * lane + 256 * j;
                const f32x4 sc = *(const f32x4*)(mr + off_sc + c) + *(const f32x4*)(bada + off_sc + c) + 1.0f;
                const f32x4 sh = *(const f32x4*)(mr + off_sh + c) + *(const f32x4*)(bada + off_sh + c);
                const f32x4 h = v[j] * rstd * sc + sh;
                u32x2 w; w.x = pk2(h[0], h[1]); w.y = pk2(h[2], h[3]);
                *(u32x2*)(H + (size_t)row * DM + c) = w; }
        }
    }
}
template <int NSL>
__device__ __forceinline__ void final_rows(float* xch, float* X, const float* gf, const float* part, const float* mod, const float* bada) {
    const int tid_ = ltid(), lane = tid_ & 63, gw = blockIdx.x * 8 + (tid_ >> 6), NGW = gridDim.x * 8;
    {
        f32x4 v[8], nx[8], gn[8];
#pragma unroll
        for (int j = 0; j < 8; ++j) { gn[j] = *(const f32x4*)(gf + 4 * lane + 256 * j); v[j] = *(const f32x4*)(X + (size_t)gw * DM + 4 * lane + 256 * j); }
        for (int row = gw; row < MP; row += NGW) {
            const int nrow = row + NGW;
            if (nrow < MP) {
#pragma unroll
                for (int j = 0; j < 8; ++j) nx[j] = *(const f32x4*)(X + (size_t)nrow * DM + 4 * lane + 256 * j); }
            float ss = 0.f;
#pragma unroll
            for (int j = 0; j < 8; ++j) ss += (v[j][0] * v[j][0] + v[j][1] * v[j][1]) + (v[j][2] * v[j][2] + v[j][3] * v[j][3]);
            const float rstd = 1.0f / sqrtf(wave_sum(ss) * (1.0f / DM) + EPSN);
#pragma unroll
            for (int j = 0; j < 8; ++j) { *(f32x4*)(X + (size_t)row * DM + 4 * lane + 256 * j) = v[j] * rstd * gn[j]; v[j] = nx[j]; }
        }
    }
    __builtin_amdgcn_sched_barrier(0);
    {
        const int wave = tid_ >> 6, q4 = wave & 3;
        for (int rp = blockIdx.x; rp < MS / 2; rp += gridDim.x) {
            const int sr = 2 * rp + (wave >> 2), row = MP + sr;
            f32x4 v[2]; float ss = 0.f;
#pragma unroll
            for (int j = 0; j < 2; ++j) { const int c = q4 * 512 + 4 * lane + 256 * j; v[j] = *(const f32x4*)(X + (size_t)row * DM + c);
                if (NSL > 0) { f32x4 a = (f32x4){0.f, 0.f, 0.f, 0.f};
#pragma unroll
                    for (int s2 = 0; s2 < NSL; ++s2) a += *(const f32x4*)(part + ((size_t)s2 * MS + sr) * DM + c);
                    const f32x4 gt = *(const f32x4*)(mod + (size_t)row_ci(row) * NMOD + 10240 + c) + *(const f32x4*)(bada + 10240 + c);
                    v[j] += gt * a; }
                ss += (v[j][0] * v[j][0] + v[j][1] * v[j][1]) + (v[j][2] * v[j][2] + v[j][3] * v[j][3]); }
            ss = wave_sum(ss);
            __syncthreads();
            if (lane == 0) xch[wave] = ss;
            __syncthreads();
            const int w0 = wave & 4;
            const float rstd = 1.0f / sqrtf(((xch[w0] + xch[w0 + 1]) + (xch[w0 + 2] + xch[w0 + 3])) * (1.0f / DM) + EPSN);
#pragma unroll
            for (int j = 0; j < 2; ++j) { const int c = q4 * 512 + 4 * lane + 256 * j; *(f32x4*)(X + (size_t)row * DM + c) = v[j] * rstd * *(const f32x4*)(gf + c); }
        }
    }
}
__device__ __forceinline__ void latent_rows(const float* cqkv, const float* gq, const float* gkv, bf16_t* cqn, bf16_t* ckv, float* ockp, float* ocks) {
    const int tid_ = ltid(), lane = tid_ & 63, gw = blockIdx.x * 8 + (tid_ >> 6), NGW = gridDim.x * 8;
    for (int row = gw; row < MT; row += NGW) {
        const float* sr = cqkv + (size_t)row * 1024;
        f32x4 a[2], b[2]; float sa = 0.f, sb = 0.f;
#pragma unroll
        for (int j = 0; j < 2; ++j) { a[j] = *(const f32x4*)(sr + 4 * lane + 256 * j); b[j] = *(const f32x4*)(sr + 512 + 4 * lane + 256 * j);
            sa += (a[j][0] * a[j][0] + a[j][1] * a[j][1]) + (a[j][2] * a[j][2] + a[j][3] * a[j][3]); sb += (b[j][0] * b[j][0] + b[j][1] * b[j][1]) + (b[j][2] * b[j][2] + b[j][3] * b[j][3]); }
        const float ra = 1.0f / sqrtf(wave_sum(sa) * (1.0f / 512) + EPSN), rb = 1.0f / sqrtf(wave_sum(sb) * (1.0f / 512) + EPSN);
        float* oc = row < MP ? ockp + (size_t)row * 512 : ocks + (size_t)(row - MP) * 512;
#pragma unroll
        for (int j = 0; j < 2; ++j) { const int c = 4 * lane + 256 * j;
            const f32x4 qa = a[j] * ra * *(const f32x4*)(gq + c), kb = b[j] * rb * *(const f32x4*)(gkv + c);
            u32x2 w; w.x = pk2(qa[0], qa[1]); w.y = pk2(qa[2], qa[3]); *(u32x2*)(cqn + (size_t)row * 512 + c) = w;
            *(f32x4*)(oc + c) = kb;
            w.x = pk2(kb[0], kb[1]); w.y = pk2(kb[2], kb[3]); *(u32x2*)(ckv + (size_t)row * 512 + c) = w; }
    }
}

template <int L>
__device__ __forceinline__ void hgrn_cumsum(const float* G, int row0, int h, int lreal, float* Bs, float* tot, float (&gv)[L / 4]) {
    constexpr int SEG = L / 4;
    const int tid = ltid(), k = tid & 127, seg = tid >> 7;
    float run = 0.f;
#pragma unroll
    for (int i = 0; i < SEG; ++i) { const int t = seg * SEG + i; gv[i] = t < lreal ? G[(size_t)(row0 + t) * 1024 + h * 128 + k] : 0.f; }
#pragma unroll
    for (int i = 0; i < SEG; ++i) { run += gv[i]; Bs[(seg * SEG + i) * 128 + k] = run; }
    tot[seg * 128 + k] = run;
    __syncthreads();
    float off = 0.f;
#pragma unroll
    for (int s2 = 0; s2 < 3; ++s2) if (s2 < seg) off += tot[s2 * 128 + k];
#pragma unroll
    for (int i = 0; i < SEG; ++i) Bs[(seg * SEG + i) * 128 + k] += off;
    __syncthreads();
}
template <int L>
__device__ __forceinline__ void hgrn_a(int it, int bh, int row0, int lreal, const float* G, const bf16_t* VH, bf16_t* U, float* DD, unsigned char* lds) {
    constexpr int SEG = L / 4, ST = L + 8;
    const int tid = ltid(), lane = tid & 63, wave = tid >> 6, k = tid & 127, seg = tid >> 7, h = bh & 7;
    float* Bs = (float*)lds; float* tot = (float*)(lds + 32768);
    bf16_t* KDT = (bf16_t*)(lds + 34816); bf16_t* VT = (bf16_t*)(lds + 34816 + 128 * ST * 2);
    float gv[SEG]; bf16_t vraw[SEG];
#pragma unroll
    for (int i = 0; i < SEG; ++i) { const int s = seg * SEG + i; vraw[i] = s < lreal ? VH[(size_t)(row0 + s) * 1024 + h * 128 + k] : (bf16_t)0; }
    hgrn_cumsum<L>(G, row0, h, lreal, Bs, tot, gv);
    const float blast = Bs[(L - 1) * 128 + k];
#pragma unroll
    for (int i = 0; i < SEG; ++i) { const int s = seg * SEG + i;
        const float kd = (1.0f - __expf(gv[i])) * __expf(blast - Bs[s * 128 + k]);
        KDT[k * ST + s] = (bf16_t)(pk2(kd, 0.f) & 0xffffu);
        VT[k * ST + s] = vraw[i]; }
    if (seg == 0) DD[(size_t)it * 128 + k] = __expf(blast);
    __syncthreads();
    const int r = lane & 15, g = lane >> 4;
#pragma unroll
    for (int vt = 0; vt < 8; ++vt) {
        f32x4 acc = (f32x4){0.f, 0.f, 0.f, 0.f};
#pragma unroll
        for (int ks = 0; ks < L / 32; ++ks) {
            const bf16x8 a = *(const bf16x8*)(KDT + (16 * wave + r) * ST + 32 * ks + 8 * g);
            const bf16x8 b = *(const bf16x8*)(VT + (16 * vt + r) * ST + 32 * ks + 8 * g);
            acc = __builtin_amdgcn_mfma_f32_16x16x32_bf16(a, b, acc, 0, 0, 0);
        }
        bf16_t* up = U + (size_t)it * 16384 + (16 * wave + 4 * g) * 128 + 16 * vt + r;
        const unsigned p01 = pk2(acc[0], acc[1]), p23 = pk2(acc[2], acc[3]);
        up[0] = (bf16_t)(p01 & 0xffffu); up[128] = (bf16_t)(p01 >> 16); up[256] = (bf16_t)(p23 & 0xffffu); up[384] = (bf16_t)(p23 >> 16);
    }
    __syncthreads();
}
__device__ __forceinline__ void hgrn_b(const bf16_t* U, const float* DD, bf16_t* Sn, const float* st0, float* ostp, float* osts) {
    const int gt = blockIdx.x * 512 + ltid(), NGT = gridDim.x * 512;
#ifdef HB_TEST
    for (int e = gt; e < 16 * 16384; e += NGT) { const int bh = e >> 14, kv = e & 16383; ostp[e] = bf2f(U[((size_t)bh * 128 + 127) * 16384 + kv]); }
    for (int e = gt; e < 256 * 16384; e += NGT) { const int bh = e >> 14, kv = e & 16383; osts[e] = bf2f(U[((size_t)2048 + bh) * 16384 + kv]) + DD[((size_t)2048 + bh) * 128 + (kv >> 7)]; }
    return;
#endif
    for (int e = gt; e < 8 * 16384; e += NGT) {
        const int e1 = e + 8 * 16384;
        const int bh0 = e >> 14, kv0 = e & 16383, bh1 = e1 >> 14, kv1 = e1 & 16383;
        float S0 = 0.f, S1 = 0.f;
        const bf16_t* up0 = U + (size_t)bh0 * 128 * 16384 + kv0; const float* dp0 = DD + (size_t)bh0 * 128 * 128 + (kv0 >> 7); bf16_t* sp0 = Sn + (size_t)bh0 * 128 * 16384 + kv0;
        const bf16_t* up1 = U + (size_t)bh1 * 128 * 16384 + kv1; const float* dp1 = DD + (size_t)bh1 * 128 * 128 + (kv1 >> 7); bf16_t* sp1 = Sn + (size_t)bh1 * 128 * 16384 + kv1;
        for (int n0 = 0; n0 < 128; n0 += 16) {
            bf16_t ur0[16], ur1[16]; float dr0[16], dr1[16];
#pragma unroll
            for (int j = 0; j < 16; ++j) { ur0[j] = up0[(size_t)(n0 + j) * 16384]; dr0[j] = dp0[(n0 + j) * 128]; ur1[j] = up1[(size_t)(n0 + j) * 16384]; dr1[j] = dp1[(n0 + j) * 128]; }
#pragma unroll
            for (int j = 0; j < 16; ++j) { sp0[(size_t)(n0 + j) * 16384] = (bf16_t)(pk2(S0, 0.f) & 0xffffu); S0 = dr0[j] * S0 + bf2f(ur0[j]);
                                           sp1[(size_t)(n0 + j) * 16384] = (bf16_t)(pk2(S1, 0.f) & 0xffffu); S1 = dr1[j] * S1 + bf2f(ur1[j]); }
        }
        ostp[e] = S0; ostp[e1] = S1;
    }
    for (int e = gt; e < 256 * 16384; e += 8 * NGT) {
        float s0[8], dd[8]; bf16_t uu[8];
#pragma unroll
        for (int j = 0; j < 8; ++j) { const int ej = e + j * NGT; const int bh = ej >> 14, kv = ej & 16383; const size_t it = 2048 + bh;
            const bool ok = ej < 256 * 16384;
            s0[j] = ok ? st0[ej] : 0.f; dd[j] = ok ? DD[it * 128 + (kv >> 7)] : 0.f; uu[j] = ok ? U[it * 16384 + kv] : (bf16_t)0; }
#pragma unroll
        for (int j = 0; j < 8; ++j) { const int ej = e + j * NGT; const int bh = ej >> 14, kv = ej & 16383; const size_t it = 2048 + bh;
            if (ej < 256 * 16384) { Sn[it * 16384 + kv] = (bf16_t)(pk2(s0[j], 0.f) & 0xffffu); osts[ej] = dd[j] * s0[j] + bf2f(uu[j]); } }
    }
}
template <int L>
__device__ __forceinline__ void hgrn_c(int it, int bh, int row0, int lreal, const float* G, const bf16_t* QH, const bf16_t* VH, const bf16_t* GATE, const bf16_t* Sn, const float* ghg, bf16_t* MIX, unsigned char* lds) {
    constexpr int SEG = L / 4, VS = L + 8;
    const int tid = ltid(), lane = tid & 63, wave = tid >> 6, k = tid & 127, seg = tid >> 7, h = bh & 7;
    float* Bs = (float*)lds; float* tot = (float*)(lds + 32768);
    bf16_t* QT = (bf16_t*)(lds + 34816); bf16_t* KT = (bf16_t*)(lds + 52224); bf16_t* VT = (bf16_t*)(lds + 69632); bf16_t* ST = (bf16_t*)(lds + 88064);
    float gv[SEG];
    bf16_t qraw[SEG], vraw[SEG]; u32x4 sraw[4];
#pragma unroll
    for (int i = 0; i < SEG; ++i) { const int s = seg * SEG + i;
        qraw[i] = s < lreal ? QH[(size_t)(row0 + s) * 1024 + h * 128 + k] : (bf16_t)0;
        vraw[i] = s < lreal ? VH[(size_t)(row0 + s) * 1024 + h * 128 + k] : (bf16_t)0; }
#pragma unroll
    for (int i = 0; i < 4; ++i) sraw[i] = *(const u32x4*)(Sn + (size_t)it * 16384 + (size_t)k * 128 + (seg + 4 * i) * 8);
    hgrn_cumsum<L>(G, row0, h, lreal, Bs, tot, gv);
#pragma unroll
    for (int i = 0; i < SEG; ++i) { const int s = seg * SEG + i; const float bs = Bs[s * 128 + k];
        QT[s * 136 + k] = (bf16_t)(pk2(bf2f(qraw[i]) * __expf(bs), 0.f) & 0xffffu);
        KT[s * 136 + k] = (bf16_t)(pk2((1.0f - __expf(gv[i])) * __expf(-bs), 0.f) & 0xffffu);
        VT[k * VS + s] = vraw[i]; }
#pragma unroll
    for (int i = 0; i < 4; ++i) { const int kk = k, v0 = (seg + 4 * i) * 8;
        const unsigned w4[4] = {sraw[i].x, sraw[i].y, sraw[i].z, sraw[i].w};
#pragma unroll
        for (int e = 0; e < 4; ++e) { ST[(v0 + 2 * e) * 136 + kk] = (bf16_t)(w4[e] & 0xffffu); ST[(v0 + 2 * e + 1) * 136 + kk] = (bf16_t)(w4[e] >> 16); } }
    __syncthreads();
    const int tt = wave;
    if (tt * 16 < lreal) {
        const int r = lane & 15, g = lane >> 4;
        bf16x8 qf[4];
#pragma unroll
        for (int ks = 0; ks < 4; ++ks) qf[ks] = *(const bf16x8*)(QT + (16 * tt + r) * 136 + 32 * ks + 8 * g);
        bf16x8 pf[L / 32];
#pragma unroll
        for (int p = 0; p < L / 32; ++p) {
            unsigned pw[4];
#pragma unroll
            for (int hs = 0; hs < 2; ++hs) { const int st = 2 * p + hs;
                f32x4 acc = (f32x4){0.f, 0.f, 0.f, 0.f};
                if (st <= tt) {
#pragma unroll
                    for (int ks = 0; ks < 4; ++ks) { const bf16x8 a = *(const bf16x8*)(KT + (16 * st + r) * 136 + 32 * ks + 8 * g); acc = __builtin_amdgcn_mfma_f32_16x16x32_bf16(a, qf[ks], acc, 0, 0, 0); }
#pragma unroll
                    for (int e = 0; e < 4; ++e) if (16 * st + 4 * g + e > 16 * tt + r) acc[e] = 0.f;
                }
                pw[2 * hs] = pk2(acc[0], acc[1]); pw[2 * hs + 1] = pk2(acc[2], acc[3]); }
            u32x4 t4 = (u32x4){pw[0], pw[1], pw[2], pw[3]};
            pf[p] = __builtin_bit_cast(bf16x8, t4);
        }
        f32x4 o[8]; float ss = 0.f;
#pragma unroll
        for (int vt = 0; vt < 8; ++vt) {
            f32x4 acc = (f32x4){0.f, 0.f, 0.f, 0.f};
#pragma unroll
            for (int p = 0; p < L / 32; ++p) if (2 * p <= tt) {
                const u32x2 lo = *(const u32x2*)(VT + (16 * vt + r) * VS + 32 * p + 4 * g), hi = *(const u32x2*)(VT + (16 * vt + r) * VS + 32 * p + 16 + 4 * g);
                u32x4 t4 = (u32x4){lo.x, lo.y, hi.x, hi.y};
                acc = __builtin_amdgcn_mfma_f32_16x16x32_bf16(__builtin_bit_cast(bf16x8, t4), pf[p], acc, 0, 0, 0); }
#pragma unroll
            for (int ks = 0; ks < 4; ++ks) { const bf16x8 a = *(const bf16x8*)(ST + (16 * vt + r) * 136 + 32 * ks + 8 * g); acc = __builtin_amdgcn_mfma_f32_16x16x32_bf16(a, qf[ks], acc, 0, 0, 0); }
            o[vt] = acc; ss += (acc[0] * acc[0] + acc[1] * acc[1]) + (acc[2] * acc[2] + acc[3] * acc[3]);
        }
        ss += __shfl_xor(ss, 16); ss += __shfl_xor(ss, 32);
        const float rstd = 1.0f / sqrtf(ss * (1.0f / 128) + EPSN);
        const int t = 16 * tt + r;
        if (t < lreal) {
            const size_t row = (size_t)(row0 + t);
#pragma unroll
            for (int vt = 0; vt < 8; ++vt) { const int v0 = 16 * vt + 4 * g;
                const u32x2 gw2 = *(const u32x2*)(GATE + row * 1024 + h * 128 + v0); const f32x4 gh = *(const f32x4*)(ghg + v0);
                const float g0 = __uint_as_float(gw2.x << 16), g1 = __uint_as_float(gw2.x & 0xffff0000u), g2 = __uint_as_float(gw2.y << 16), g3 = __uint_as_float(gw2.y & 0xffff0000u);
                u32x2 w; w.x = pk2(o[vt][0] * rstd * gh[0] * g0, o[vt][1] * rstd * gh[1] * g1); w.y = pk2(o[vt][2] * rstd * gh[2] * g2, o[vt][3] * rstd * gh[3] * g3);
                *(u32x2*)(MIX + row * 2048 + 1024 + h * 128 + v0) = w; }
        }
    }
    __syncthreads();
}

template <int NKS, int NDT, int KSTR, int VSTR, bool QG, int NQF>
__device__ __forceinline__ void attn_step(const bf16x8 (&qf)[NQF], const bf16_t* qg, f32x4 (&o)[NDT], float& m, float& l, const LAS unsigned char* kimg, const LAS unsigned char* vimg, int lane, bool half_valid) {
    const int r = lane & 15, g = lane >> 4;
    f32x4 s0 = (f32x4){0.f, 0.f, 0.f, 0.f}, s1 = (f32x4){0.f, 0.f, 0.f, 0.f};
    const LAS unsigned char* kp = kimg + r * (KSTR * 2) + g * 16;
    if constexpr (QG) {
#pragma unroll 1
        for (int ks3 = 0; ks3 < NKS; ks3 += 3) {
#pragma unroll
            for (int k2 = 0; k2 < 3; ++k2) { const int ks = ks3 + k2;
                const bf16x8 a0 = *(const LAS bf16x8*)(kp + ks * 64), a1 = *(const LAS bf16x8*)(kp + 16 * KSTR * 2 + ks * 64);
                const bf16x8 qv = *(const bf16x8*)(qg + 32 * ks);
                s0 = __builtin_amdgcn_mfma_f32_16x16x32_bf16(a0, qv, s0, 0, 0, 0);
                s1 = __builtin_amdgcn_mfma_f32_16x16x32_bf16(a1, qv, s1, 0, 0, 0); }
        }
    } else {
#pragma unroll
        for (int ks = 0; ks < NKS; ++ks) {
            const bf16x8 a0 = *(const LAS bf16x8*)(kp + ks * 64), a1 = *(const LAS bf16x8*)(kp + 16 * KSTR * 2 + ks * 64);
            s0 = __builtin_amdgcn_mfma_f32_16x16x32_bf16(a0, qf[ks], s0, 0, 0, 0);
            s1 = __builtin_amdgcn_mfma_f32_16x16x32_bf16(a1, qf[ks], s1, 0, 0, 0);
        }
    }
    if (half_valid) s1 = (f32x4){-INFINITY, -INFINITY, -INFINITY, -INFINITY};
    float mx = fmaxf(fmaxf(fmaxf(s0[0], s0[1]), fmaxf(s0[2], s0[3])), fmaxf(fmaxf(s1[0], s1[1]), fmaxf(s1[2], s1[3])));
    mx = fmaxf(mx, __shfl_xor(mx, 16)); mx = fmaxf(mx, __shfl_xor(mx, 32));
    const float mn = fmaxf(m, mx), alpha = exp2f(m - mn);
    f32x4 p0, p1;
#pragma unroll
    for (int e = 0; e < 4; ++e) { p0[e] = exp2f(s0[e] - mn); p1[e] = exp2f(s1[e] - mn); }
    float ls = (p0[0] + p0[1]) + (p0[2] + p0[3]) + (p1[0] + p1[1]) + (p1[2] + p1[3]);
    ls += __shfl_xor(ls, 16); ls += __shfl_xor(ls, 32);
    l = l * alpha + ls; m = mn;
    u32x4 pw = (u32x4){pk2(p0[0], p0[1]), pk2(p0[2], p0[3]), pk2(p1[0], p1[1]), pk2(p1[2], p1[3])};
    const bf16x8 pf = __builtin_bit_cast(bf16x8, pw);
    const LAS unsigned char* vp = vimg + r * (VSTR * 2) + g * 8;
#pragma unroll
    for (int dt = 0; dt < NDT; ++dt) {
        const u32x2 lo = *(const LAS u32x2*)(vp + dt * 16 * VSTR * 2), hi = *(const LAS u32x2*)(vp + dt * 16 * VSTR * 2 + 32);
        u32x4 t4 = (u32x4){lo.x, lo.y, hi.x, hi.y};
        o[dt] = __builtin_amdgcn_mfma_f32_16x16x32_bf16(__builtin_bit_cast(bf16x8, t4), pf, o[dt] * alpha, 0, 0, 0);
        if ((dt & 3) == 3) __builtin_amdgcn_sched_barrier(0);
    }
}

typedef float f32x16 __attribute__((ext_vector_type(16)));
__device__ __forceinline__ void attn_prompt_item(int b, int h, int qb, const bf16_t* Q, const bf16_t* KN, const bf16_t* KPE, const bf16_t* VT, bf16_t* MIX, LAS unsigned char* lds) {
    constexpr int KSTR = 200, VSTR = 72, KIMG = 64 * KSTR * 2, BUFB = KIMG + 128 * VSTR * 2;
    const int tid = ltid(), lane = tid & 63, wave = tid >> 6, r = lane & 31, hh = lane >> 5;
    const int nkt = 4 * qb + 4, nkw = 4 * qb + (wave >> 1) + 1;
    const size_t qrow = (size_t)b * 8192 + 256 * qb + 32 * wave + r;
    bf16x8 qf[12];
#pragma unroll
    for (int ks = 0; ks < 12; ++ks) qf[ks] = *(const bf16x8*)(Q + qrow * 1536 + h * 192 + 16 * ks + 8 * hh);
    f32x16 o[4];
#pragma unroll
    for (int dt = 0; dt < 4; ++dt)
#pragma unroll
        for (int i = 0; i < 16; ++i) o[dt][i] = 0.f;
    float m = -INFINITY, l = 0.f;
    const bf16_t* kn_src = KN + ((size_t)b * 8192 + (tid >> 4)) * 1024 + h * 128 + 8 * (tid & 15);
    const bf16_t* kp_src = KPE + ((size_t)b * 8192 + (tid >> 3)) * 64 + 8 * (tid & 7);
    const bf16_t* vt_src = VT + ((size_t)h * 128 + (tid >> 3)) * 16384 + (size_t)b * 8192 + 8 * (tid & 7);
    const int wk = (tid >> 4) * (KSTR * 2) + (tid & 15) * 16, wp = (tid >> 3) * (KSTR * 2) + 256 + (tid & 7) * 16, wv = KIMG + (tid >> 3) * (VSTR * 2) + ((tid & 7) >> 1) * 32 + ((tid & 7) & 1) * 8;
    u32x4 ak0, ak1, ap, av0, av1;
#define AT_LOAD(S_, t) do { S_##k0 = *(const u32x4*)(kn_src + (size_t)(t) * 64 * 1024); S_##k1 = *(const u32x4*)(kn_src + ((size_t)(t) * 64 + 32) * 1024); S_##p = *(const u32x4*)(kp_src + (size_t)(t) * 64 * 64); \
        S_##v0 = *(const u32x4*)(vt_src + (t) * 64); S_##v1 = *(const u32x4*)(vt_src + (size_t)64 * 16384 + (t) * 64); } while (0)
#define AT_STORE(S_, t) do { const int bo_ = ((t) & 1) * BUFB; *(LAS u32x4*)(lds + bo_ + wk) = S_##k0; *(LAS u32x4*)(lds + bo_ + wk + 32 * KSTR * 2) = S_##k1; *(LAS u32x4*)(lds + bo_ + wp) = S_##p; \
        *(LAS u32x2*)(lds + bo_ + wv) = (u32x2){S_##v0.x, S_##v0.y}; *(LAS u32x2*)(lds + bo_ + wv + 16) = (u32x2){S_##v0.z, S_##v0.w}; \
        *(LAS u32x2*)(lds + bo_ + wv + 64 * VSTR * 2) = (u32x2){S_##v1.x, S_##v1.y}; *(LAS u32x2*)(lds + bo_ + wv + 64 * VSTR * 2 + 16) = (u32x2){S_##v1.z, S_##v1.w}; } while (0)
#define AT_SUB(kt, u) do { \
            const LAS unsigned char* kimg = lds + ((kt) & 1) * BUFB + (u) * 32 * KSTR * 2; const LAS unsigned char* vimg = lds + ((kt) & 1) * BUFB + KIMG + (u) * 64; \
            f32x16 sc; \
            _Pragma("unroll") for (int i = 0; i < 16; ++i) sc[i] = 0.f; \
            const LAS unsigned char* kp = kimg + r * (KSTR * 2) + hh * 16; \
            _Pragma("unroll") for (int ks = 0; ks < 12; ++ks) { const bf16x8 a = *(const LAS bf16x8*)(kp + ks * 32); sc = __builtin_amdgcn_mfma_f32_32x32x16_bf16(a, qf[ks], sc, 0, 0, 0); } \
            float mx = sc[0]; \
            _Pragma("unroll") for (int i = 1; i < 16; ++i) mx = fmaxf(mx, sc[i]); \
            mx = fmaxf(mx, __shfl_xor(mx, 32)); \
            const float mn = fmaxf(m, mx), alpha = __builtin_amdgcn_exp2f(m - mn); \
            float ls = 0.f; \
            _Pragma("unroll") for (int i = 0; i < 16; ++i) { sc[i] = __builtin_amdgcn_exp2f(sc[i] - mn); ls += sc[i]; } \
            ls += __shfl_xor(ls, 32); \
            l = l * alpha + ls; m = mn; \
            bf16x8 pf[2]; \
            _Pragma("unroll") for (int s2 = 0; s2 < 2; ++s2) { u32x4 pw = (u32x4){pk2(sc[8 * s2], sc[8 * s2 + 1]), pk2(sc[8 * s2 + 2], sc[8 * s2 + 3]), pk2(sc[8 * s2 + 4], sc[8 * s2 + 5]), pk2(sc[8 * s2 + 6], sc[8 * s2 + 7])}; pf[s2] = __builtin_bit_cast(bf16x8, pw); } \
            const LAS unsigned char* vp = vimg + r * (VSTR * 2) + hh * 16; \
            _Pragma("unroll") for (int dt = 0; dt < 4; ++dt) { \
                f32x16 acc = o[dt] * alpha; \
                _Pragma("unroll") for (int s2 = 0; s2 < 2; ++s2) { \
                    const bf16x8 va = *(const LAS bf16x8*)(vp + dt * 32 * VSTR * 2 + s2 * 32); \
                    acc = __builtin_amdgcn_mfma_f32_32x32x16_bf16(va, pf[s2], acc, 0, 0, 0); } \
                o[dt] = acc; } } while (0)
#define AT_COMPUTE(kt) do { if ((kt) < nkw) { AT_SUB(kt, 0); AT_SUB(kt, 1); } } while (0)
    AT_LOAD(a, 0); AT_STORE(a, 0); AT_LOAD(a, 1);
    __syncthreads();
    for (int kt = 0; kt < nkt; ++kt) {
        AT_COMPUTE(kt);
        if (kt + 1 < nkt) AT_STORE(a, kt + 1);
        if (kt + 2 < nkt) AT_LOAD(a, kt + 2);
        __syncthreads();
    }
#undef AT_LOAD
#undef AT_STORE
#undef AT_SUB
#undef AT_COMPUTE
    const float inv = 1.0f / l;
#pragma unroll
    for (int dt = 0; dt < 4; ++dt)
#pragma unroll
        for (int ig = 0; ig < 4; ++ig) { u32x2 w; w.x = pk2(o[dt][4 * ig] * inv, o[dt][4 * ig + 1] * inv); w.y = pk2(o[dt][4 * ig + 2] * inv, o[dt][4 * ig + 3] * inv);
            *(u32x2*)(MIX + qrow * 2048 + h * 128 + 32 * dt + 8 * ig + 4 * hh) = w; }
}

constexpr int NSPL = 8;
__device__ __forceinline__ void attn_sample_item(int b, int sp, const bf16_t* Q, const bf16_t* WUKO, const float* cckv, const float* ckpe, const bf16_t* CKV, const bf16_t* KPE, bf16_t* QLAT, bf16_t* PO, float* PML, LAS unsigned char* lds) {
    constexpr int KSTR = 584, VSTR = 36;
    const int tid = ltid(), lane = tid & 63, h = tid >> 6, r = lane & 15, g = lane >> 4;
    LAS unsigned char* kimg = lds; LAS unsigned char* vimg = lds + 32 * KSTR * 2;
    const size_t qrow0 = (size_t)MP + (size_t)b * 16;
    bf16_t* ql = QLAT + ((size_t)b * 8 + h) * 16 * 576;
    {
        bf16x8 aq[4];
#pragma unroll
        for (int ks = 0; ks < 4; ++ks) aq[ks] = *(const bf16x8*)(Q + (qrow0 + r) * 1536 + h * 192 + 32 * ks + 8 * g);
#pragma unroll 8
        for (int ct = 0; ct < 32; ++ct) {
            f32x4 acc = (f32x4){0.f, 0.f, 0.f, 0.f};
#pragma unroll
            for (int ks = 0; ks < 4; ++ks) { const bf16x8 bw = *(const bf16x8*)(WUKO + (size_t)(16 * ct + r) * 1024 + h * 128 + 32 * ks + 8 * g); acc = __builtin_amdgcn_mfma_f32_16x16x32_bf16(bw, aq[ks], acc, 0, 0, 0); }
            u32x2 w; w.x = pk2(acc[0], acc[1]); w.y = pk2(acc[2], acc[3]);
            *(u32x2*)(ql + r * 576 + 16 * ct + 4 * g) = w;
        }
#pragma unroll
        for (int i = 0; i < 2; ++i) { const int pc = lane + 64 * i, qq = pc >> 3, cc = pc & 7;
            *(u32x4*)(ql + qq * 576 + 512 + 8 * cc) = *(const u32x4*)(Q + (qrow0 + qq) * 1536 + h * 192 + 128 + 8 * cc); }
    }
    __threadfence(); __syncthreads();
    const bf16_t* qg = ql + r * 576 + 8 * g;
    f32x4 o[32];
#pragma unroll
    for (int dt = 0; dt < 32; ++dt) o[dt] = (f32x4){0.f, 0.f, 0.f, 0.f};
    float m = -INFINITY, l = 0.f;
    const float* cb = cckv + (size_t)b * 2048 * 512; const float* pb = ckpe + (size_t)b * 2048 * 64;
    const int kt0 = sp * 8, kt1 = (sp == NSPL - 1) ? 65 : kt0 + 8;
    for (int kt = kt0; kt < kt1; ++kt) {
        __syncthreads();
        if (kt < 64) {
            const int c = tid;
            float v[32];
#pragma unroll
            for (int kk = 0; kk < 32; ++kk) v[kk] = cb[(size_t)(32 * kt + kk) * 512 + c];
            const int key = tid >> 4, i4 = (tid & 15) * 4; const f32x4 pv = *(const f32x4*)(pb + (size_t)(32 * kt + key) * 64 + i4);
#pragma unroll
            for (int kk = 0; kk < 32; kk += 2) {
                const unsigned pw = pk2(v[kk], v[kk + 1]);
                *(LAS bf16_t*)(kimg + kk * (KSTR * 2) + c * 2) = (bf16_t)(pw & 0xffffu);
                *(LAS bf16_t*)(kimg + (kk + 1) * (KSTR * 2) + c * 2) = (bf16_t)(pw >> 16);
                *(LAS unsigned*)(vimg + c * (VSTR * 2) + kk * 2) = pw;
            }
#pragma unroll
            for (int e = 0; e < 4; ++e) { const int i = i4 + e, pi = i < 32 ? 2 * i : 2 * (i - 32) + 1;
                *(LAS bf16_t*)(kimg + key * (KSTR * 2) + (512 + pi) * 2) = (bf16_t)(pk2(pv[e], 0.f) & 0xffffu); }
        } else {
            const int c = tid;
#pragma unroll 4
            for (int kk = 0; kk < 32; kk += 2) {
                unsigned pw = 0u;
                if (kk < 16) { const unsigned a = CKV[(qrow0 + kk) * 512 + c], bb = CKV[(qrow0 + kk + 1) * 512 + c]; pw = a | (bb << 16); }
                *(LAS bf16_t*)(kimg + kk * (KSTR * 2) + c * 2) = (bf16_t)(pw & 0xffffu);
                *(LAS bf16_t*)(kimg + (kk + 1) * (KSTR * 2) + c * 2) = (bf16_t)(pw >> 16);
                *(LAS unsigned*)(vimg + c * (VSTR * 2) + kk * 2) = pw;
            }
            { const int key = tid >> 4, i4 = (tid & 15) * 4;
              u32x2 w = (u32x2){0u, 0u}; if (key < 16) w = *(const u32x2*)(KPE + (qrow0 + key) * 64 + i4);
              *(LAS u32x2*)(kimg + key * (KSTR * 2) + (512 + i4) * 2) = w; }
        }
        bf16x8 qv[18];
#pragma unroll
        for (int ks = 0; ks < 18; ++ks) qv[ks] = *(const bf16x8*)(qg + 32 * ks);
        __syncthreads();
        attn_step<18, 32, KSTR, VSTR, false, 18>(qv, nullptr, o, m, l, kimg, vimg, lane, kt == 64);
    }
    const float inv = 1.0f / l;
    const size_t pi = (((size_t)b * NSPL + sp) * 8 + h) * 16 + r;
    bf16_t* po = PO + pi * 512 + 4 * g;
#pragma unroll
    for (int dt = 0; dt < 32; ++dt) { u32x2 w; w.x = pk2(o[dt][0] * inv, o[dt][1] * inv); w.y = pk2(o[dt][2] * inv, o[dt][3] * inv); *(u32x2*)(po + 16 * dt) = w; }
    if (g == 0) *(f32x2*)(PML + pi * 2) = (f32x2){m, l};
    __syncthreads();
}
__device__ __forceinline__ void attn_sample_combine(int b, int h, const bf16_t* PO, const float* PML, const bf16_t* WUVT, bf16_t* MIX, LAS unsigned char* lds) {
    const int tid = ltid(), lane = tid & 63, wave = tid >> 6, r = lane & 15, g = lane >> 4;
    float ms[NSPL], cs[NSPL], M = -INFINITY, L = 0.f;
#pragma unroll
    for (int sp = 0; sp < NSPL; ++sp) { const f32x2 ml = *(const f32x2*)(PML + ((((size_t)b * NSPL + sp) * 8 + h) * 16 + r) * 2); ms[sp] = ml.x; cs[sp] = ml.y; M = fmaxf(M, ml.x); }
#pragma unroll
    for (int sp = 0; sp < NSPL; ++sp) { cs[sp] *= __builtin_amdgcn_exp2f(ms[sp] - M); L += cs[sp]; }
    const float invL = 1.0f / L;
#pragma unroll
    for (int sp = 0; sp < NSPL; ++sp) cs[sp] *= invL;
#pragma unroll
    for (int s2 = 0; s2 < 2; ++s2) { const int s = 2 * wave + s2;
        f32x4 a0 = (f32x4){0.f, 0.f, 0.f, 0.f}, a1 = (f32x4){0.f, 0.f, 0.f, 0.f};
#pragma unroll
        for (int sp = 0; sp < NSPL; ++sp) {
            const bf16_t* po = PO + ((((size_t)b * NSPL + sp) * 8 + h) * 16 + r) * 512 + 32 * s + 4 * g;
            const u32x2 w0 = *(const u32x2*)po, w1 = *(const u32x2*)(po + 16);
            a0 += cs[sp] * (f32x4){__uint_as_float(w0.x << 16), __uint_as_float(w0.x & 0xffff0000u), __uint_as_float(w0.y << 16), __uint_as_float(w0.y & 0xffff0000u)};
            a1 += cs[sp] * (f32x4){__uint_as_float(w1.x << 16), __uint_as_float(w1.x & 0xffff0000u), __uint_as_float(w1.y << 16), __uint_as_float(w1.y & 0xffff0000u)};
        }
        *(LAS u32x4*)(lds + (s * 64 + lane) * 16) = (u32x4){pk2(a0[0], a0[1]), pk2(a0[2], a0[3]), pk2(a1[0], a1[1]), pk2(a1[2], a1[3])};
    }
    __syncthreads();
    const size_t qrow0 = (size_t)MP + (size_t)b * 16;
    const int dt = wave;
    f32x4 acc = (f32x4){0.f, 0.f, 0.f, 0.f};
    const bf16_t* wp = WUVT + (size_t)(h * 128 + 16 * dt + r) * 512 + 4 * g;
#pragma unroll
    for (int s = 0; s < 16; ++s) {
        const u32x2 lo = *(const u32x2*)(wp + 32 * s), hi = *(const u32x2*)(wp + 32 * s + 16);
        u32x4 t4 = (u32x4){lo.x, lo.y, hi.x, hi.y};
        const bf16x8 pf = *(const LAS bf16x8*)(lds + (s * 64 + lane) * 16);
        acc = __builtin_amdgcn_mfma_f32_16x16x32_bf16(__builtin_bit_cast(bf16x8, t4), pf, acc, 0, 0, 0);
    }
    u32x2 w; w.x = pk2(acc[0], acc[1]); w.y = pk2(acc[2], acc[3]);
    *(u32x2*)(MIX + (qrow0 + r) * 2048 + h * 128 + 16 * dt + 4 * g) = w;
    __syncthreads();
}

#define XB_TMO      128
#define XB_XCNT(j)  (256  + 64 * (j))
#define XB_XSUB(j)  (1280 + 64 * (j))
#define XB_XGEN(j)  (2304 + 64 * (j))
#define XB_TOP      3328
#define XB_TOPGEN   3392
#define XCD_BAR_WORDS 3456
#define XB_SPIN_CAP (1u << 18)
__device__ __forceinline__ unsigned xb_ld(unsigned* p)              { return __hip_atomic_load(p, __ATOMIC_RELAXED, __HIP_MEMORY_SCOPE_AGENT); }
__device__ __forceinline__ unsigned xb_add(unsigned* p, unsigned v) { return __hip_atomic_fetch_add(p, v, __ATOMIC_RELAXED, __HIP_MEMORY_SCOPE_AGENT); }
__device__ __forceinline__ unsigned xb_xcc_id() { return (unsigned)__builtin_amdgcn_s_getreg((3 << 11) | 20) & 0xFu; }
#define XB_SPIN(cond, bar) do { unsigned _sp = 0; while (cond) { __builtin_amdgcn_s_sleep(1); \
    if ((++_sp & 255u) == 0u) { if (xb_ld(&(bar)[XB_TMO])) break; if (_sp > XB_SPIN_CAP) { atomicAdd(&(bar)[XB_TMO], 1u); break; } } } } while (0)
struct XcdBarrier { unsigned* bar; unsigned x; volatile LAS unsigned* st; };
__device__ __forceinline__ XcdBarrier xcd_barrier_post(unsigned* bar, volatile LAS unsigned* st) {
    XcdBarrier b; b.bar = bar; b.x = xb_xcc_id(); b.st = st;
    if (threadIdx.x == 0) (void)xb_add(&bar[XB_XCNT(b.x)], 1u);
    return b;
}
__device__ __forceinline__ void xcd_barrier_complete(unsigned* bar, unsigned x, unsigned& nloc, unsigned& nx) {
    const unsigned G = gridDim.x * gridDim.y * gridDim.z;
    unsigned sum, cnt, mine, sp = 0u;
    for (;;) {
        sum = 0u; cnt = 0u; mine = 0u;
#pragma unroll
        for (unsigned j = 0; j < 16; ++j) { const unsigned c = xb_ld(&bar[XB_XCNT(j)]); sum += c; cnt += (c > 0u) ? 1u : 0u; mine = (j == x) ? c : mine; }
        if (sum == G) break;
        __builtin_amdgcn_s_sleep(1);
        if ((++sp & 255u) == 0u) { if (xb_ld(&bar[XB_TMO])) break; if (sp > XB_SPIN_CAP) { atomicAdd(&bar[XB_TMO], 1u); break; } }
    }
    nloc = mine > 0u ? mine : 1u; nx = cnt > 0u ? cnt : 1u;
}
__device__ __forceinline__ void xcd_barrier(const XcdBarrier& b) {
    asm volatile("s_waitcnt vmcnt(0)" ::: "memory");
    __syncthreads();
    if (threadIdx.x == 0) {
        unsigned* bar = b.bar;
        __builtin_amdgcn_s_waitcnt(0);
        unsigned nloc = b.st[0], nx = b.st[1];
        if (nloc == 0u) { xcd_barrier_complete(bar, b.x, nloc, nx); b.st[0] = nloc; b.st[1] = nx; }
        const unsigned old = xb_add(&bar[XB_XSUB(b.x)], 1u);
        const unsigned gen = old / nloc;
        if (old + 1u == (gen + 1u) * nloc) {
            __builtin_amdgcn_fence(__ATOMIC_RELEASE, "agent");
            asm volatile("s_waitcnt vmcnt(0)" ::: "memory");
            const unsigned og = xb_add(&bar[XB_TOP], 1u);
            const unsigned tg = og / nx;
            if (og + 1u == (tg + 1u) * nx) xb_add(&bar[XB_TOPGEN], 1u);
            else XB_SPIN(xb_ld(&bar[XB_TOPGEN]) == tg, bar);
            __builtin_amdgcn_fence(__ATOMIC_ACQUIRE, "agent");
            xb_add(&bar[XB_XGEN(b.x)], 1u);
            asm volatile("s_waitcnt vmcnt(0)" ::: "memory");
        } else {
            XB_SPIN(xb_ld(&bar[XB_XGEN(b.x)]) == gen, bar);
            __builtin_amdgcn_fence(__ATOMIC_ACQUIRE, "agent");
            asm volatile("s_waitcnt vmcnt(0)" ::: "memory");
        }
    }
    __syncthreads();
}

__device__ __forceinline__ void gsync(cg::grid_group& grid) {
    asm volatile("s_waitcnt vmcnt(0) lgkmcnt(0)" ::: "memory");
    grid.sync();
    __builtin_amdgcn_fence(__ATOMIC_ACQUIRE, "agent");
    asm volatile("s_waitcnt vmcnt(0)" ::: "memory");
}
struct Params { const float* in[21]; float* out; unsigned char* ws; };

__global__ void __launch_bounds__(512) mega(Params p) {
    extern __shared__ __attribute__((aligned(16))) unsigned char lds[];
    cg::grid_group grid = cg::this_grid();
    LAS unsigned char* ldsl = (LAS unsigned char*)lds;
    unsigned char* ws = p.ws; float* out = p.out; unsigned char* outb = (unsigned char*)p.out;
    const int G = gridDim.x, bx = blockIdx.x, tid = threadIdx.x;
    float* MOD = (float*)(ws + WS_MOD); const float* bada = p.in[8];
    const f32x2* ROPE = (const f32x2*)(ws + WS_ROPE);
    bf16_t* H = (bf16_t*)(ws + WS_H);
    float* Gb = (float*)(outb + OB_G); bf16_t* QH = (bf16_t*)(outb + OB_QH); bf16_t* VH = (bf16_t*)(outb + OB_VH);
    bf16_t* GATE = (bf16_t*)(ws + WS_GATE); bf16_t* KPE = (bf16_t*)(ws + WS_KPE); float* CQKV = (float*)(ws + WS_CQKV);
    bf16_t* Qb = (bf16_t*)(ws + WS_Q); bf16_t* CQN = (bf16_t*)(ws + WS_CQN); bf16_t* QLAT = (bf16_t*)(ws + WS_QLAT); bf16_t* CKV = (bf16_t*)(ws + WS_CKV);
    bf16_t* U = (bf16_t*)(ws + WS_U); bf16_t* MIX = (bf16_t*)(ws + WS_MIX); float* DD = (float*)(ws + WS_DD); bf16_t* Sn = (bf16_t*)(ws + WS_S);
    bf16_t* KN = (bf16_t*)(ws + WS_KN); bf16_t* VT = (bf16_t*)(ws + WS_VT); bf16_t* FFH = (bf16_t*)(ws + WS_FFH);
    float* X = out + O_Y;
    pg8::StaticOrder S;
    volatile LAS unsigned* xst = (volatile LAS unsigned*)(ldsl + LDS_Q + 16);
    if (tid == 0) { xst[0] = 0u; xst[1] = 0u; }
    __syncthreads();
    const XcdBarrier xbar = xcd_barrier_post((unsigned*)(ws + WS_BAR), xst);

#ifdef FILLTEST
    for (size_t i = (size_t)bx * 512 + tid; i < 48791552; i += (size_t)G * 512) out[i] = 0.5f;
#endif
    if (PHMASK & 1) phase0(p.in, ws, lds);
#ifdef PROBE_P0
    gsync(grid);
    phase0(p.in, ws, lds);
#endif
    xcd_barrier(xbar);
#ifdef PROBE_SYNC
    for (int z = 0; z < 10; ++z) xcd_barrier(xbar);
#endif
    if (PHMASK & 2) adaln_rows<0>((float*)lds, p.in[0], p.in[1], MOD, bada, 0, 2048, H);
    xcd_barrier(xbar);
    if (PHMASK & 4) { EpiIn E{CQKV, QH, Gb, VH, GATE, KPE, ROPE, out + O_KPE_P, out + O_KPE_S, p.in[15]};
      S.init(MT, NINP, 2048, G, bx); pg8::gemm_phase(ldsl, pg8::Gemm{H, (const bf16_t*)(ws + WS_WIN), MT, NINP, 2048}, S, E); }
    xcd_barrier(xbar);
    if (PHMASK & 8) latent_rows(CQKV, p.in[11], p.in[12], CQN, CKV, out + O_CKV_P, out + O_CKV_S);
    if (PHMASK & 16) for (int it = bx; it < NCHUNK; it += G) {
        if (it < NCHUNK_P) hgrn_a<64>(it, it >> 7, (it >> 10) * 8192 + (it & 127) * 64, 64, Gb, VH, U, DD, lds);
        else hgrn_a<32>(it, it - NCHUNK_P, MP + ((it - NCHUNK_P) >> 3) * 16, 16, Gb, VH, U, DD, lds);
    }
#ifdef PROBE_MISC
    xcd_barrier(xbar);
    latent_rows(CQKV, p.in[11], p.in[12], CQN, CKV, out + O_CKV_P, out + O_CKV_S);
    for (int it = bx; it < NCHUNK; it += G) {
        if (it < NCHUNK_P) hgrn_a<64>(it, it >> 7, (it >> 10) * 8192 + (it & 127) * 64, 64, Gb, VH, U, DD, lds);
        else hgrn_a<32>(it, it - NCHUNK_P, MP + ((it - NCHUNK_P) >> 3) * 16, 16, Gb, VH, U, DD, lds);
    }
#endif
    xcd_barrier(xbar);
    if (PHMASK & 32) { EpiQ E{Qb, ROPE}; S.init(MT, 1536, 512, G, bx); pg8::gemm_phase(ldsl, pg8::Gemm{CQN, (const bf16_t*)(ws + WS_WUQ), MT, 1536, 512}, S, E); }
    if (PHMASK & 32) { EpiPlain E{KN, 1024}; S.init(MP, 1024, 512, G, bx); pg8::gemm_phase(ldsl, pg8::Gemm{CKV, (const bf16_t*)(ws + WS_WUK), MP, 1024, 512}, S, E); }
    if (PHMASK & 32) { EpiPlain E{VT, 16384}; S.init(1024, MP, 512, G, bx); pg8::gemm_phase(ldsl, pg8::Gemm{(const bf16_t*)(ws + WS_WUV), CKV, 1024, MP, 512}, S, E); }
    if (PHMASK & 64) hgrn_b(U, DD, Sn, p.in[6], out + O_ST_P, out + O_ST_S);
#ifdef PROBE_MISC
    xcd_barrier(xbar);
    hgrn_b(U, DD, Sn, p.in[6], out + O_ST_P, out + O_ST_S);
#endif
    xcd_barrier(xbar);
    for (int p5rep = 0; p5rep < P5REPS; ++p5rep) {
    if (p5rep) xcd_barrier(xbar);
    if (PHMASK & 0x380) {
        unsigned* ctr = (unsigned*)(ws + WS_CTL) + p5rep * 64;
        volatile int* qslot = (volatile int*)(lds + LDS_Q);
        for (;;) {
            __syncthreads();
            if (tid == 0) *qslot = (int)__hip_atomic_fetch_add(ctr, 1u, __ATOMIC_RELAXED, __HIP_MEMORY_SCOPE_AGENT);
            __syncthreads();
            const int it = *qslot;
            if (it >= 256 + 512 + NCHUNK) break;
            const int pm_ = p5rep ? (P5MASK2) : 0x380;
            if (it < 256) { if (pm_ & 128) attn_sample_item(it >> 3, it & 7, Qb, (const bf16_t*)(ws + WS_WUKO), p.in[4], p.in[5], CKV, KPE, QLAT, (bf16_t*)(ws + WS_PO), (float*)(ws + WS_PML), ldsl); }
            else if (it < 256 + 512) { if (pm_ & 256) { const int j = it - 256, qb = 31 - (j >> 4), bh = j & 15; attn_prompt_item(bh >> 3, bh & 7, qb, Qb, KN, KPE, VT, MIX, ldsl); } }
            else if (pm_ & 512) { const int c = it - 768;
                if (c < NCHUNK_P) hgrn_c<64>(c, c >> 7, (c >> 10) * 8192 + (c & 127) * 64, 64, Gb, QH, VH, GATE, Sn, p.in[16], MIX, lds);
                else hgrn_c<32>(c, c - NCHUNK_P, MP + ((c - NCHUNK_P) >> 3) * 16, 16, Gb, QH, VH, GATE, Sn, p.in[16], MIX, lds); }
        }
    }
    }
    xcd_barrier(xbar);
    for (int ci = bx; ci < 256; ci += G) attn_sample_combine(ci >> 3, ci & 7, (const bf16_t*)(ws + WS_PO), (const float*)(ws + WS_PML), (const bf16_t*)(ws + WS_WUV), MIX, ldsl);
    xcd_barrier(xbar);
    if (PHMASK & 1024) { EpiRes E{p.in[0], p.in[1], X, MOD, bada, 4096, (float*)(ws + WS_CQKV)}; if (G == 256) S.init(MP, 2048, 2048, G, bx, 8, 64, 16); else S.init(MT, 2048, 2048, G, bx); pg8::gemm_phase(ldsl, pg8::Gemm{MIX, (const bf16_t*)(ws + WS_WOUT), MT, 2048, 2048}, S, E); }
    xcd_barrier(xbar);
    if (G == 256) {
        adaln_rows<8, 2>((float*)lds, X, p.in[1], MOD, bada, 6144, 8192, H, (const float*)(ws + WS_CQKV), 4096, X);
        xcd_barrier(xbar);
        if (bx < 64) { EpiRelu2 E{FFH + (size_t)MP * DFF}; S.init(MS, DFF, 2048, 64, bx); pg8::gemm_phase(ldsl, pg8::Gemm{H + (size_t)MP * DM, (const bf16_t*)(ws + WS_WFF1), MS, DFF, 2048}, S, E); }
        else adaln_rows<0, 1>((float*)lds, X, p.in[1], MOD, bada, 6144, 8192, H, nullptr, 0, nullptr, 64, 192);
        xcd_barrier(xbar);
        { EpiRelu2 E{FFH}; S.init(MP, DFF, 2048, G, bx); pg8::gemm_phase(ldsl, pg8::Gemm{H, (const bf16_t*)(ws + WS_WFF1), MP, DFF, 2048}, S, E); }
    } else {
        adaln_rows<0>((float*)lds, X, X + (size_t)MP * DM, MOD, bada, 6144, 8192, H);
        xcd_barrier(xbar);
        { EpiRelu2 E{FFH}; S.init(MT, DFF, 2048, G, bx); pg8::gemm_phase(ldsl, pg8::Gemm{H, (const bf16_t*)(ws + WS_WFF1), MT, DFF, 2048}, S, E); }
    }
    xcd_barrier(xbar);
    if (PHMASK & 8192) { EpiRes E{X, X + (size_t)MP * DM, X, MOD, bada, 10240, (float*)(ws + WS_H)}; if (G == 256) S.init(MP, 2048, DFF, G, bx, 16, 64, 16); else S.init(MT, 2048, DFF, G, bx); pg8::gemm_phase(ldsl, pg8::Gemm{FFH, (const bf16_t*)(ws + WS_WFF2), MT, 2048, DFF}, S, E); }
    xcd_barrier(xbar);
    if (PHMASK & 16384) { if (G == 256) final_rows<16>((float*)lds, X, p.in[20], (const float*)(ws + WS_H), MOD, bada); else final_rows<0>((float*)lds, X, p.in[20], nullptr, MOD, bada); }
}

extern "C" void kernel_launch(void* const* d_in, const int* in_sizes, int n_in, void* d_out, int out_size, void* d_ws, size_t ws_size, hipStream_t stream) {
    static int grid_blocks = 0;
    if (grid_blocks == 0) {
        if (n_in != 21 || ws_size < WS_TOTAL) { fprintf(stderr, "kernel_launch: unexpected n_in %d or workspace %zu < %zu\n", n_in, ws_size, (size_t)WS_END); grid_blocks = -1; return; }
        int dev = 0, cus = 0, per_cu = 0;
        hipGetDevice(&dev);
        hipDeviceGetAttribute(&cus, hipDeviceAttributeMultiprocessorCount, dev);
        if (hipFuncSetAttribute((const void*)mega, hipFuncAttributeMaxDynamicSharedMemorySize, LDS_BYTES) != hipSuccess) { fprintf(stderr, "kernel_launch: hipFuncSetAttribute failed\n"); }
        if (hipOccupancyMaxActiveBlocksPerMultiprocessor(&per_cu, (const void*)mega, 512, LDS_BYTES) != hipSuccess || per_cu < 1) { fprintf(stderr, "kernel_launch: occupancy query gave %d\n", per_cu); per_cu = 1; }
        (void)hipGetLastError();
        grid_blocks = cus * 1;
    }
    if (grid_blocks < 0) return;
    (void)hipMemsetAsync((char*)d_ws + WS_BAR, 0, XCD_BAR_WORDS * 4, stream);
    Params p{};
    for (int i = 0; i < 21; ++i) p.in[i] = (const float*)d_in[i];
    p.out = (float*)d_out; p.ws = (unsigned char*)d_ws;
    void* args[] = {&p};
    hipError_t e = hipLaunchCooperativeKernel((const void*)mega, dim3(grid_blocks), dim3(512), args, LDS_BYTES, stream);
    if (e != hipSuccess) fprintf(stderr, "cooperative launch failed: %s (grid %d)\n", hipGetErrorString(e), grid_blocks);
}
```

```cpp
#include <hip/hip_runtime.h>
#include <hip/hip_cooperative_groups.h>
#include <cstdio>
namespace cg = cooperative_groups;

#define LAS __attribute__((address_space(3)))
typedef unsigned short bf16_t;
typedef short bf16x8 __attribute__((ext_vector_type(8)));
typedef float f32x4 __attribute__((ext_vector_type(4)));
typedef float f32x2 __attribute__((ext_vector_type(2)));
typedef unsigned u32x4 __attribute__((ext_vector_type(4)));
typedef unsigned u32x2 __attribute__((ext_vector_type(2)));

constexpr int MP = 16384, MS = 512, MT = MP + MS;
constexpr int DM = 2048, NMOD = 12288, NINP = 5376, DFF = 8192;
constexpr float EPSN = 1e-6f;
constexpr float QSCALE = 0.07216878364870322f * 1.4426950408889634f;
constexpr int NCHUNK_P = 2048, NCHUNK = 2304;

constexpr size_t O_Y = 0, O_CKV_P = 34603008, O_KPE_P = 42991616, O_ST_P = 44040192, O_CKV_S = 44302336, O_KPE_S = 44564480, O_ST_S = 44597248;
constexpr size_t OB_G = 0, OB_QH = 69206016, OB_VH = 103809024;
constexpr size_t WS_CTL = 0, WS_MOD = 4096, WS_ZERO_BYTES = 4096 + 34 * 12288 * 4;
constexpr size_t WS_ROPE = 1675264;
constexpr size_t WS_WIN = WS_ROPE + 2097152;
constexpr size_t WS_WUQ = WS_WIN + (size_t)NINP * 2048 * 2;
constexpr size_t WS_WUK = WS_WUQ + 1536 * 512 * 2;
constexpr size_t WS_WUV = WS_WUK + 1024 * 512 * 2;
constexpr size_t WS_WUKO = WS_WUV + 1024 * 512 * 2;
constexpr size_t WS_WOUT = WS_WUKO + 1024 * 512 * 2;
constexpr size_t WS_WFF1 = WS_WOUT + 2048 * 2048 * 2;
constexpr size_t WS_WFF2 = WS_WFF1 + (size_t)8192 * 2048 * 2;
constexpr size_t WS_H = WS_WFF2 + (size_t)8192 * 2048 * 2;
constexpr size_t WS_KN = WS_H, WS_VT = WS_H + (size_t)MP * 1024 * 2;
constexpr size_t WS_ARENA = WS_H + (size_t)MT * 2048 * 2;
constexpr size_t WS_GATE = WS_ARENA;
constexpr size_t WS_KPE = WS_GATE + (size_t)MT * 1024 * 2;
constexpr size_t WS_CQKV = WS_KPE + (size_t)MT * 64 * 2;
constexpr size_t WS_Q = WS_CQKV;
constexpr size_t WS_CQN = WS_CQKV + (size_t)MT * 1024 * 4;
constexpr size_t WS_QLAT = WS_WIN;
constexpr size_t WS_PO = WS_CQKV + (size_t)MT * 1536 * 2;
constexpr size_t WS_PML = WS_PO + (size_t)256 * 8 * 16 * 512 * 2;
constexpr size_t WS_CKV = WS_CQN + (size_t)MT * 512 * 2;
constexpr size_t WS_U = WS_CKV + (size_t)MT * 512 * 2;
constexpr size_t WS_MIX = WS_U;
constexpr size_t WS_DD = WS_U + (size_t)NCHUNK * 16384 * 2;
constexpr size_t WS_S = WS_DD + (size_t)NCHUNK * 128 * 4;
constexpr size_t WS_END = WS_S + (size_t)NCHUNK * 16384 * 2;
constexpr size_t WS_FFH = WS_ARENA;
constexpr size_t WS_BAR = WS_END, WS_TOTAL = WS_END + 16384;
static_assert(WS_ARENA + (size_t)MT * DFF * 2 <= WS_END, "ffh overlay");
static_assert(WS_PML + 256 * 8 * 16 * 2 * 4 <= WS_CKV, "sample partials");
static_assert((size_t)32 * 8 * 16 * 576 * 2 <= (size_t)NINP * 2048 * 2, "qlat");

#ifndef P5MASK2
#define P5MASK2 0x380
#endif
#ifndef P5REPS
#define P5REPS 1
#endif
#ifndef PHMASK
#define PHMASK 0xFFFF
#endif
constexpr int LDS_BYTES = 131072 + 256;
constexpr int LDS_Q = 131072;

typedef __bf16 bf16v2 __attribute__((ext_vector_type(2)));
__device__ __forceinline__ unsigned pk2(float lo, float hi) { const f32x2 v = (f32x2){lo, hi}; const bf16v2 b = __builtin_convertvector(v, bf16v2); return __builtin_bit_cast(unsigned, b); }
__device__ __forceinline__ float bf2f(bf16_t b) { return __uint_as_float(((unsigned)b) << 16); }
__device__ __forceinline__ float wave_sum(float v) {
#pragma unroll
    for (int o = 1; o < 64; o <<= 1) v += __shfl_xor(v, o);
    return v;
}
__device__ __forceinline__ int ltid() { int t = threadIdx.x; asm volatile("" : "+v"(t)); return t; }
__device__ __forceinline__ float silu_f(float v) { return v * __builtin_amdgcn_rcpf(1.0f + __expf(-v)); }
__device__ __forceinline__ int row_pos(int r) { return r < MP ? (r & 8191) : 2048 + ((r - MP) & 15); }
__device__ __forceinline__ int row_ci(int r) { return r < MP ? (r >> 13) : 2 + ((r - MP) >> 4); }

namespace pg8 {
constexpr int BM = 256, BK = 64, HALF = 128, HTB = HALF * BK * 2, STAGE_BYTES = 8 * HTB, NXCD = 8, WGM = 8;
__host__ __device__ __forceinline__ int lds_byte(int r, int c) { const int st = (r >> 4) * 2 + (c >> 5), rr = r & 15, cc = c & 31, ob = rr * 64 + cc * 2; return st * 1024 + (ob ^ (((ob >> 9) & 1) << 5)); }
__host__ __device__ __forceinline__ void stage_rc(int b, int& R, int& C) { const int st = b / 1024, sb = b % 1024, swz = sb ^ (((sb >> 9) & 1) << 5); R = (st >> 1) * 16 + swz / 64; C = (st & 1) * 32 + (swz % 64) / 2; }
struct Unit { int pm, pn, k0, nt, sl; };
struct Gemm { const bf16_t* A; const bf16_t* Bt; int M, N, K; };
struct StaticOrder {
    int nM, nN, nwg, G, c, ntK, ns, tail_pm0, ntail;
    __host__ __device__ void init(int M, int N, int K, int G_, int c_, int ns_ = 1, int tail_pm0_ = 0, int ntail_ = 0) { nM = M / BM; nN = N / BM; nwg = nM * nN; G = G_; c = c_; ntK = K / BK; ns = ns_; tail_pm0 = tail_pm0_; ntail = ntail_; }
    __host__ __device__ __forceinline__ void unit_of(int L, Unit& u) const {
        int wgid = L; { const int q = nwg / NXCD, r = nwg % NXCD, xcd = wgid % NXCD, off = wgid / NXCD; wgid = (xcd < r ? xcd * (q + 1) : r * (q + 1) + (xcd - r) * q) + off; }
        const int nig = WGM * nN, gid = wgid / nig, fm = gid * WGM, gsz = (nM - fm) < WGM ? (nM - fm) : WGM;
        u.pm = fm + ((wgid % nig) % gsz); u.pn = (wgid % nig) / gsz;
    }
    __host__ __device__ __forceinline__ bool next(int i, Unit& u) const {
        int L = i * G + c, k0 = 0, nt = ntK, sl = 0; bool ok = L < nwg;
        if (!ok) L = 0;
        unit_of(L, u);
        if (ns > 1) {
            const int rounds = nwg / G, idx = c / ns;
            const bool tail = (i == rounds) && (idx < ntail);
            if (tail) { nt = ntK / ns; k0 = (c % ns) * nt * BK; sl = 1; u.pm = tail_pm0 + idx / nN; u.pn = idx % nN; ok = true; }
        }
        u.k0 = k0; u.nt = nt; u.sl = sl; return ok;
    }
};
template <class Epi>
__device__ __forceinline__ void gemm_phase(LAS unsigned char* lds, const Gemm g, const StaticOrder& S, const Epi& E) {
    const int tid = ltid(), wid = __builtin_amdgcn_readfirstlane(tid >> 6), lane = tid & 63, wr = wid >> 2, wc = wid & 3, fr = lane & 15, fq = lane >> 4;
    const int K = g.K;
    unsigned voffA[2], voffB[2];
#pragma unroll
    for (int i = 0; i < 2; ++i) { int R, C; stage_rc(tid * 16 + i * 8192, R, C); voffA[i] = (unsigned)(R * K + C) * 2u; voffB[i] = (unsigned)(R * K + C) * 2u; }
    const size_t kstep = (size_t)(BK * 2);
    const size_t hstep = (size_t)HALF * K * 2;
    const size_t tstep = 2 * hstep;
    const unsigned ldsw = (unsigned)wid * 1024u;
    const int aoff = lds_byte(wr * 64 + fr, fq * 8), boff = lds_byte(wc * 32 + fr, fq * 8);
#define PG8_SA(b, h) (((b) * 2 + (h)) * HTB)
#define PG8_SB(b, h) ((4 + (b) * 2 + (h)) * HTB)
#define PG8_STAGE(bufoff, gbase, voff) do { _Pragma("unroll") for (int _i = 0; _i < 2; ++_i) \
        __builtin_amdgcn_global_load_lds((const unsigned*)((const char*)(gbase) + (voff)[_i]), (LAS unsigned*)(lds + (bufoff) + ldsw + _i * 8192), 16, 0, 0); } while (0)
#define PG8_LDA(dst, b, h) do { _Pragma("unroll") for (int m = 0; m < 4; ++m) _Pragma("unroll") for (int k = 0; k < 2; ++k) dst[m][k] = *(const LAS bf16x8*)(lds + PG8_SA(b, h) + aoff + m * 2048 + k * 1024); } while (0)
#define PG8_LDB(dst, b, h) do { _Pragma("unroll") for (int n = 0; n < 2; ++n) _Pragma("unroll") for (int k = 0; k < 2; ++k) dst[n][k] = *(const LAS bf16x8*)(lds + PG8_SB(b, h) + boff + n * 2048 + k * 1024); } while (0)
#define PG8_MMA(ai, bj, At, Bt) do { __builtin_amdgcn_s_setprio(1); _Pragma("unroll") for (int m = 0; m < 4; ++m) _Pragma("unroll") for (int n = 0; n < 2; ++n) _Pragma("unroll") for (int k = 0; k < 2; ++k) \
        acc[ai][bj][m][n] = __builtin_amdgcn_mfma_f32_16x16x32_bf16(Bt[n][k], At[m][k], acc[ai][bj][m][n], 0, 0, 0); __builtin_amdgcn_s_setprio(0); } while (0)
#define PG8_WAIT_V(n) asm volatile("s_waitcnt vmcnt(" #n ")" ::: "memory")
#define PG8_WAIT_L(n) asm volatile("s_waitcnt lgkmcnt(" #n ")" ::: "memory")
#define PG8_BAR __builtin_amdgcn_s_barrier()
#define PG8_SCHED __builtin_amdgcn_sched_barrier(0)
    Unit cur, nxt; int ui = 0;
    if (!S.next(0, cur)) return;
    f32x4 acc[2][2][4][2];
#pragma unroll
    for (int a = 0; a < 2; ++a)
#pragma unroll
        for (int b = 0; b < 2; ++b)
#pragma unroll
            for (int m = 0; m < 4; ++m)
#pragma unroll
                for (int n = 0; n < 2; ++n) acc[a][b][m][n] = (f32x4){0.f, 0.f, 0.f, 0.f};
    bf16x8 At[4][2], B0[2][2], B1[2][2];
    const char* cA = (const char*)g.A + (size_t)cur.pm * tstep + (size_t)cur.k0 * 2; const char* cB = (const char*)g.Bt + (size_t)cur.pn * tstep + (size_t)cur.k0 * 2;
    PG8_STAGE(PG8_SB(0, 0), cB, voffB); PG8_STAGE(PG8_SA(0, 0), cA, voffA); PG8_STAGE(PG8_SB(0, 1), cB + hstep, voffB); PG8_STAGE(PG8_SA(0, 1), cA + hstep, voffA);
    if (wr == 1) PG8_BAR;
    PG8_WAIT_V(4); PG8_BAR;
    PG8_STAGE(PG8_SB(1, 0), cB + kstep, voffB); PG8_STAGE(PG8_SA(1, 0), cA + kstep, voffA); PG8_STAGE(PG8_SB(1, 1), cB + hstep + kstep, voffB);
    PG8_WAIT_V(6); PG8_BAR;
    for (;;) {
        const bool has_next = S.next(ui + 1, nxt);
        const char* nA = has_next ? (const char*)g.A + (size_t)nxt.pm * tstep + (size_t)nxt.k0 * 2 : cA; const char* nB = has_next ? (const char*)g.Bt + (size_t)nxt.pn * tstep + (size_t)nxt.k0 * 2 : cB;
        const int nt = cur.nt;
        for (int t = 0; t < nt; t += 2) {
            const bool last = (t == nt - 2);
            const char* a1 = cA + (size_t)(t + 1) * kstep;
            const char* a2 = last ? nA : cA + (size_t)(t + 2) * kstep; const char* b2 = last ? nB : cB + (size_t)(t + 2) * kstep;
            const char* a3 = a2 + kstep; const char* b3 = b2 + kstep;
            PG8_LDB(B0, 0, 0); PG8_SCHED; PG8_LDA(At, 0, 0); PG8_STAGE(PG8_SA(1, 1), a1 + hstep, voffA);
            PG8_WAIT_L(8); PG8_BAR; PG8_WAIT_L(0); PG8_MMA(0, 0, At, B0); PG8_BAR; PG8_SCHED;
            PG8_LDB(B1, 0, 1); PG8_STAGE(PG8_SB(0, 0), b2, voffB);
            PG8_BAR; PG8_WAIT_L(0); PG8_MMA(0, 1, At, B1); PG8_BAR;
            PG8_LDA(At, 0, 1); PG8_STAGE(PG8_SA(0, 0), a2, voffA);
            PG8_BAR; PG8_WAIT_L(0); PG8_MMA(1, 0, At, B0); PG8_BAR; PG8_SCHED;
            PG8_STAGE(PG8_SB(0, 1), b2 + hstep, voffB);
            PG8_WAIT_V(6); PG8_BAR; PG8_MMA(1, 1, At, B1); PG8_BAR;
            PG8_LDB(B0, 1, 0); PG8_SCHED; PG8_LDA(At, 1, 0); PG8_STAGE(PG8_SA(0, 1), a2 + hstep, voffA);
            PG8_WAIT_L(8); PG8_BAR; PG8_WAIT_L(0); PG8_MMA(0, 0, At, B0); PG8_BAR; PG8_SCHED;
            PG8_LDB(B1, 1, 1); PG8_STAGE(PG8_SB(1, 0), b3, voffB);
            PG8_BAR; PG8_WAIT_L(0); PG8_MMA(0, 1, At, B1); PG8_BAR;
            PG8_LDA(At, 1, 1); PG8_STAGE(PG8_SA(1, 0), a3, voffA);
            PG8_BAR; PG8_WAIT_L(0); PG8_MMA(1, 0, At, B0); PG8_BAR; PG8_SCHED;
            PG8_STAGE(PG8_SB(1, 1), b3 + hstep, voffB);
            PG8_WAIT_V(6); PG8_BAR; PG8_MMA(1, 1, At, B1); PG8_BAR;
        }
        E(acc, cur, wr, wc, fr, fq);
        if (!has_next) break;
#pragma unroll
        for (int a = 0; a < 2; ++a)
#pragma unroll
            for (int b = 0; b < 2; ++b)
#pragma unroll
                for (int m = 0; m < 4; ++m)
#pragma unroll
                    for (int n = 0; n < 2; ++n) acc[a][b][m][n] = (f32x4){0.f, 0.f, 0.f, 0.f};
        cur = nxt; cA = nA; cB = nB; ++ui;
    }
    PG8_WAIT_V(0);
    if (wr == 0) PG8_BAR;
    PG8_BAR;
#undef PG8_SA
#undef PG8_SB
#undef PG8_STAGE
#undef PG8_LDA
#undef PG8_LDB
#undef PG8_MMA
#undef PG8_WAIT_V
#undef PG8_WAIT_L
#undef PG8_BAR
#undef PG8_SCHED
}
}

template <class F>
__device__ __forceinline__ void epi_walk(const f32x4 (&acc)[2][2][4][2], const pg8::Unit& u, int wr, int wc, int fr, int fq, const F& f) {
    const int row0 = u.pm * 256 + wr * 64 + fr;
#pragma unroll
    for (int ai = 0; ai < 2; ++ai)
#pragma unroll
        for (int m = 0; m < 4; ++m) {
            const int r = row0 + ai * 128 + m * 16;
#pragma unroll
            for (int bj = 0; bj < 2; ++bj)
#pragma unroll
                for (int n = 0; n < 2; ++n) f(r, bj * 128 + wc * 32 + n * 16 + 4 * fq, acc[ai][bj][m][n]);
        }
}

struct EpiIn {
    float* cqkv; bf16_t* qh; float* g; bf16_t* vh; bf16_t* gate; bf16_t* kpe; const f32x2* rope; float* okp; float* oks; const float* hglb;
    __device__ __forceinline__ void operator()(const f32x4 (&acc)[2][2][4][2], const pg8::Unit& u, int wr, int wc, int fr, int fq) const {
        const int pn = u.pn;
        epi_walk(acc, u, wr, wc, fr, fq, [&](int r, int cl, f32x4 v) {
            const int c = pn * 256 + cl;
            if (pn < 4) { *(f32x4*)(cqkv + (size_t)r * 1024 + c) = v; }
            else if (pn < 8) {
                const float sc = 0.08838834764831845f;
                u32x2 w; w.x = pk2(silu_f(v[0]) * sc, silu_f(v[1]) * sc); w.y = pk2(silu_f(v[2]) * sc, silu_f(v[3]) * sc);
                *(u32x2*)(qh + (size_t)r * 1024 + (c - 1024)) = w;
            } else if (pn < 12) {
                const int j = c - 2048;
                const f32x4 a0 = *(const f32x4*)(hglb + j), a1 = *(const f32x4*)(hglb + 1024 + j);
                f32x4 o;
#pragma unroll
                for (int e = 0; e < 4; ++e) { const float lb = __builtin_amdgcn_rcpf(1.0f + __expf(a1[e] - a0[e])); const float sg = __builtin_amdgcn_rcpf(1.0f + __expf(-v[e])); o[e] = __logf(lb + (1.0f - lb) * sg); }
                *(f32x4*)(g + (size_t)r * 1024 + j) = o;
            } else if (pn < 16) {
                u32x2 w; w.x = pk2(v[0], v[1]); w.y = pk2(v[2], v[3]);
                *(u32x2*)(vh + (size_t)r * 1024 + (c - 3072)) = w;
            } else if (pn < 20) {
                u32x2 w; w.x = pk2(silu_f(v[0]), silu_f(v[1])); w.y = pk2(silu_f(v[2]), silu_f(v[3]));
                *(u32x2*)(gate + (size_t)r * 1024 + (c - 4096)) = w;
            } else if (cl < 64) {
                const int i0 = cl >> 1, pos = row_pos(r);
                const f32x2 c0 = rope[pos * 32 + i0], c1 = rope[pos * 32 + i0 + 1];
                const float o1a = v[0] * c0.x - v[1] * c0.y, o2a = v[1] * c0.x + v[0] * c0.y;
                const float o1b = v[2] * c1.x - v[3] * c1.y, o2b = v[3] * c1.x + v[2] * c1.y;
                float* ob = r < MP ? okp + (size_t)r * 64 : oks + (size_t)(r - MP) * 64;
                *(f32x2*)(ob + i0) = (f32x2){o1a, o1b}; *(f32x2*)(ob + 32 + i0) = (f32x2){o2a, o2b};
                u32x2 w; w.x = pk2(o1a, o2a); w.y = pk2(o1b, o2b);
                *(u32x2*)(kpe + (size_t)r * 64 + cl) = w;
            }
        });
    }
};
struct EpiQ {
    bf16_t* q; const f32x2* rope;
    __device__ __forceinline__ void operator()(const f32x4 (&acc)[2][2][4][2], const pg8::Unit& u, int wr, int wc, int fr, int fq) const {
        const int pn = u.pn;
        epi_walk(acc, u, wr, wc, fr, fq, [&](int r, int cl, f32x4 v) {
            const int c = pn * 256 + cl, h = c / 192, j = c - h * 192;
            u32x2 w;
            if (j < 128) { w.x = pk2(v[0] * QSCALE, v[1] * QSCALE); w.y = pk2(v[2] * QSCALE, v[3] * QSCALE); }
            else {
                const int i0 = (j - 128) >> 1, pos = row_pos(r);
                const f32x2 c0 = rope[pos * 32 + i0], c1 = rope[pos * 32 + i0 + 1];
                const float o1a = v[0] * c0.x - v[1] * c0.y, o2a = v[1] * c0.x + v[0] * c0.y;
                const float o1b = v[2] * c1.x - v[3] * c1.y, o2b = v[3] * c1.x + v[2] * c1.y;
                w.x = pk2(o1a * QSCALE, o2a * QSCALE); w.y = pk2(o1b * QSCALE, o2b * QSCALE);
            }
            *(u32x2*)(q + (size_t)r * 1536 + c) = w;
        });
    }
};
struct EpiPlain {
    bf16_t* o; int ldc;
    __device__ __forceinline__ void operator()(const f32x4 (&acc)[2][2][4][2], const pg8::Unit& u, int wr, int wc, int fr, int fq) const {
        const int pn = u.pn;
        epi_walk(acc, u, wr, wc, fr, fq, [&](int r, int cl, f32x4 v) {
            u32x2 w; w.x = pk2(v[0], v[1]); w.y = pk2(v[2], v[3]);
            *(u32x2*)(o + (size_t)r * ldc + pn * 256 + cl) = w;
        });
    }
};
struct EpiRelu2 {
    bf16_t* o;
    __device__ __forceinline__ void operator()(const f32x4 (&acc)[2][2][4][2], const pg8::Unit& u, int wr, int wc, int fr, int fq) const {
        const int pn = u.pn;
        epi_walk(acc, u, wr, wc, fr, fq, [&](int r, int cl, f32x4 v) {
            f32x4 t;
#pragma unroll
            for (int e = 0; e < 4; ++e) { const float a = fmaxf(v[e], 0.f); t[e] = a * a; }
            u32x2 w; w.x = pk2(t[0], t[1]); w.y = pk2(t[2], t[3]);
            *(u32x2*)(o + (size_t)r * DFF + pn * 256 + cl) = w;
        });
    }
};
struct EpiRes {
    const float* xa; const float* xb; float* xo; const float* mod; const float* bada; int goff; float* part;
    __device__ __forceinline__ void operator()(const f32x4 (&acc)[2][2][4][2], const pg8::Unit& u, int wr, int wc, int fr, int fq) const {
        const int pn = u.pn, sl = u.sl, sidx = u.k0 / (u.nt * 64);
        epi_walk(acc, u, wr, wc, fr, fq, [&](int r, int cl, f32x4 v) {
            const int c = pn * 256 + cl;
            if (sl) { *(f32x4*)(part + ((size_t)sidx * MS + (r - MP)) * DM + c) = v; }
            else {
                const int ci = row_ci(r);
                const float* xi = r < MP ? xa + (size_t)r * DM : xb + (size_t)(r - MP) * DM;
                const f32x4 gt = *(const f32x4*)(mod + (size_t)ci * NMOD + goff + c) + *(const f32x4*)(bada + goff + c);
                const f32x4 x = *(const f32x4*)(xi + c);
                *(f32x4*)(xo + (size_t)r * DM + c) = x + gt * v;
            }
        });
    }
};

__device__ __forceinline__ int map_row(int mat, int n) {
    if (mat == 0) { if (n < 1024) return n; if (n < 1088) { const int i = n - 1024; return 5120 + (i < 32 ? 2 * i : 2 * (i - 32) + 1); } return n - 64; }
    if (mat == 1) { const int h = n / 192, j = n - h * 192; if (j < 128) return n; const int i = j - 128; return h * 192 + 128 + (i < 32 ? 2 * i : 2 * (i - 32) + 1); }
    return n;
}
struct TrItem { const float* W; bf16_t* WT; int K, N, mat, item; };
__device__ __forceinline__ void tr_load(const TrItem& t, int lane, float (&tv)[32]) {
    const int nblk = t.N / 32, kb = t.item / nblk, nb = t.item % nblk, k0 = 64 * kb, n0 = 32 * nb;
#pragma unroll
    for (int i = 0; i < 32; ++i) { const int kk = 2 * i + (lane >> 5); tv[i] = t.W[(size_t)(k0 + kk) * t.N + n0 + (lane & 31)]; }
}
__device__ __forceinline__ void tr_store(const TrItem& t, int lane, const float (&tv)[32], LAS float* scr) {
    const int nblk = t.N / 32, kb = t.item / nblk, nb = t.item % nblk, k0 = 64 * kb, n0 = 32 * nb;
#pragma unroll
    for (int i = 0; i < 32; ++i) { const int kk = 2 * i + (lane >> 5); scr[kk * 33 + (lane & 31)] = tv[i]; }
    asm volatile("s_waitcnt lgkmcnt(0)" ::: "memory");
    const int c = lane & 7;
#pragma unroll
    for (int j = 0; j < 4; ++j) { const int n = (lane >> 3) + 8 * j; const LAS float* sp = scr + (8 * c) * 33 + n;
        u32x4 o; o.x = pk2(sp[0 * 33], sp[1 * 33]); o.y = pk2(sp[2 * 33], sp[3 * 33]); o.z = pk2(sp[4 * 33], sp[5 * 33]); o.w = pk2(sp[6 * 33], sp[7 * 33]);
        *(u32x4*)(t.WT + (size_t)map_row(t.mat, n0 + n) * t.K + k0 + 8 * c) = o; }
    asm volatile("s_waitcnt lgkmcnt(0)" ::: "memory");
}
__device__ __forceinline__ TrItem tr_item(const float* const* in, unsigned char* ws, int it) {
    constexpr int I0 = 32 * 162, I1 = 8 * 48, I2 = 8 * 32, I3 = 8 * 32, I4 = 32 * 64, I5 = 32 * 256;
    int r = it;
    if (r < I0) return TrItem{in[9], (bf16_t*)(ws + WS_WIN), 2048, 5184, 0, r}; r -= I0;
    if (r < I1) return TrItem{in[10], (bf16_t*)(ws + WS_WUQ), 512, 1536, 1, r}; r -= I1;
    if (r < I2) return TrItem{in[13], (bf16_t*)(ws + WS_WUK), 512, 1024, 2, r}; r -= I2;
    if (r < I3) return TrItem{in[14], (bf16_t*)(ws + WS_WUV), 512, 1024, 2, r}; r -= I3;
    if (r < I4) return TrItem{in[17], (bf16_t*)(ws + WS_WOUT), 2048, 2048, 2, r}; r -= I4;
    if (r < I5) return TrItem{in[18], (bf16_t*)(ws + WS_WFF1), 2048, 8192, 2, r}; r -= I5;
    return TrItem{in[19], (bf16_t*)(ws + WS_WFF2), 8192, 2048, 2, r};
}
constexpr int TR_NIT = 32 * 162 + 8 * 48 + 8 * 32 + 8 * 32 + 32 * 64 + 32 * 256 + 128 * 64;
__device__ __forceinline__ void transposes_range(const float* const* in, unsigned char* ws, unsigned char* lds, int i0, int i1, int gw, int NGW) {
    const int tid = ltid(), lane = tid & 63, wave = tid >> 6;
    LAS float* scr = (LAS float*)lds + wave * (64 * 33);
    float ta[32], tb[32];
    int it = i0 + gw;
    if (it < i1) tr_load(tr_item(in, ws, it), lane, ta);
    for (; it < i1; it += 2 * NGW) {
        if (it + NGW < i1) tr_load(tr_item(in, ws, it + NGW), lane, tb);
        tr_store(tr_item(in, ws, it), lane, ta, scr);
        if (it + NGW < i1) {
            if (it + 2 * NGW < i1) tr_load(tr_item(in, ws, it + 2 * NGW), lane, ta);
            tr_store(tr_item(in, ws, it + NGW), lane, tb, scr);
        }
    }
}
__device__ __forceinline__ void phase0(const float* const* in, unsigned char* ws, unsigned char* lds) {
    const int tid = ltid(), lane = tid & 63, wave = tid >> 6, G = gridDim.x, bx = blockIdx.x;
    {
        float* sl = (float*)lds;
        float* MOD = (float*)(ws + WS_MOD);
        const float* wada = in[7];
        if (bx == 0 && tid < 2) __hip_atomic_store((unsigned*)(ws + WS_CTL) + tid * 64, 0u, __ATOMIC_RELAXED, __HIP_MEMORY_SCOPE_AGENT);
        for (int it = bx; it < 192; it += G) {
            const int grp = tid >> 6, col = it * 64 + lane;
            float acc[34];
#pragma unroll
            for (int r = 0; r < 34; ++r) acc[r] = 0.f;
            for (int pass = 0; pass < 4; ++pass) {
                __syncthreads();
                for (int e = tid; e < 34 * 512; e += 512) { const int r = e >> 9, kl = e & 511, kg = (kl >> 6) * 256 + pass * 64 + (kl & 63);
                    const float cv = r < 2 ? in[2][r * DM + kg] : in[3][(r - 2) * DM + kg]; sl[e] = silu_f(cv); }
                __syncthreads();
                const int k0 = grp * 256 + pass * 64;
                for (int kk = 0; kk < 64; kk += 8) {
                    float w[8];
#pragma unroll
                    for (int j = 0; j < 8; ++j) w[j] = wada[(size_t)(k0 + kk + j) * NMOD + col];
#pragma unroll
                    for (int r = 0; r < 34; ++r) { const f32x4 sv = *(const f32x4*)(sl + r * 512 + grp * 64 + kk), sw = *(const f32x4*)(sl + r * 512 + grp * 64 + kk + 4);
                        acc[r] += (sv[0] * w[0] + sv[1] * w[1] + sv[2] * w[2] + sv[3] * w[3]) + (sw[0] * w[4] + sw[1] * w[5] + sw[2] * w[6] + sw[3] * w[7]); }
                }
            }
            __syncthreads();
            float* red = (float*)lds;
#pragma unroll
            for (int r = 0; r < 34; ++r) red[(grp * 34 + r) * 64 + lane] = acc[r];
            __syncthreads();
            for (int e = tid; e < 34 * 64; e += 512) { const int r = e >> 6, c = e & 63; float sum = 0.f;
#pragma unroll
                for (int g2 = 0; g2 < 8; ++g2) sum += red[(g2 * 34 + r) * 64 + c];
                MOD[(size_t)r * NMOD + it * 64 + c] = sum; }
            __syncthreads();
        }
    }
    transposes_range(in, ws, lds, 0, (G == 256) ? TR_NIT - 128 * 64 : TR_NIT, bx * 8 + wave, G * 8);
    const int gt = bx * 512 + tid, NGT = G * 512;
    { u32x4* z = (u32x4*)(ws + WS_WIN + (size_t)5184 * 2048 * 2); for (int i = gt; i < 192 * 2048 * 2 / 16; i += NGT) z[i] = (u32x4){0u, 0u, 0u, 0u}; }
    { const f32x4* s = (const f32x4*)in[13]; u32x2* d = (u32x2*)(ws + WS_WUKO); for (int i = gt; i < 512 * 1024 / 4; i += NGT) { const f32x4 v = s[i]; u32x2 w; w.x = pk2(v[0], v[1]); w.y = pk2(v[2], v[3]); d[i] = w; } }
    { f32x2* rp = (f32x2*)(ws + WS_ROPE);
      for (int i = gt; i < 8192 * 32; i += NGT) { const int pos = i >> 5, k = i & 31;
          const double invf = exp(-9.210340371976184 * (double)k / 32.0); const double t = (double)pos * invf * 0.15915494309189535; const float fr = (float)(t - rint(t));
          rp[i] = (f32x2){__builtin_amdgcn_cosf(fr), __builtin_amdgcn_sinf(fr)}; } }
}

template <int NSL, int PARTS = 3>
__device__ __forceinline__ void adaln_rows(float* xch, const float* xa, const float* xb, const float* mod, const float* bada, int off_sh, int off_sc, bf16_t* H,
                                           const float* part = nullptr, int off_gt = 0, float* xout = nullptr, int wg0 = 0, int nwg = 0) {
    const int tid_ = ltid(), lane = tid_ & 63;
    const int nw_ = nwg ? nwg : (int)gridDim.x, gw = ((int)blockIdx.x - wg0) * 8 + (tid_ >> 6), NGW = nw_ * 8;
    if (PARTS & 1) {
        f32x4 v[8], nx[8];
#pragma unroll
        for (int j = 0; j < 8; ++j) v[j] = *(const f32x4*)(xa + (size_t)gw * DM + 4 * lane + 256 * j);
        for (int row = gw; row < MP; row += NGW) {
            const int nrow = row + NGW;
            if (nrow < MP) {
#pragma unroll
                for (int j = 0; j < 8; ++j) nx[j] = *(const f32x4*)(xa + (size_t)nrow * DM + 4 * lane + 256 * j); }
            const int ci = row >> 13;
            float ss = 0.f;
#pragma unroll
            for (int j = 0; j < 8; ++j) ss += (v[j][0] * v[j][0] + v[j][1] * v[j][1]) + (v[j][2] * v[j][2] + v[j][3] * v[j][3]);
            const float* mr = mod + (size_t)ci * NMOD;
            const float rstd = 1.0f / sqrtf(wave_sum(ss) * (1.0f / DM) + EPSN);
#pragma unroll
            for (int j = 0; j < 8; ++j) { const int c = 4 * lane + 256 * j;
                const f32x4 scj = *(const f32x4*)(mr + off_sc + c) + *(const f32x4*)(bada + off_sc + c) + 1.0f;
                const f32x4 shj = *(const f32x4*)(mr + off_sh + c) + *(const f32x4*)(bada + off_sh + c);
                const f32x4 h = v[j] * rstd * scj + shj;
                u32x2 w; w.x = pk2(h[0], h[1]); w.y = pk2(h[2], h[3]);
                *(u32x2*)(H + (size_t)row * DM + c) = w; v[j] = nx[j]; }
        }
    }
    __builtin_amdgcn_sched_barrier(0);
    if (PARTS & 2) {
        const int wave = tid_ >> 6, q4 = wave & 3;
        for (int rp = blockIdx.x; rp < MS / 2; rp += gridDim.x) {
            const int sr = 2 * rp + (wave >> 2), row = MP + sr; const float* xr = xb + (size_t)sr * DM; const float* mr = mod + (size_t)row_ci(row) * NMOD;
            f32x4 v[2]; float ss = 0.f;
#pragma unroll
            for (int j = 0; j < 2; ++j) { const int c = q4 * 512 + 4 * lane + 256 * j; v[j] = *(const f32x4*)(xr + c);
                if (NSL > 0) { f32x4 a = (f32x4){0.f, 0.f, 0.f, 0.f};
#pragma unroll
                    for (int s2 = 0; s2 < NSL; ++s2) a += *(const f32x4*)(part + ((size_t)s2 * MS + sr) * DM + c);
                    const f32x4 gt = *(const f32x4*)(mr + off_gt + c) + *(const f32x4*)(bada + off_gt + c);
                    v[j] += gt * a; *(f32x4*)(xout + (size_t)row * DM + c) = v[j]; }
                ss += (v[j][0] * v[j][0] + v[j][1] * v[j][1]) + (v[j][2] * v[j][2] + v[j][3] * v[j][3]); }
            ss = wave_sum(ss);
            __syncthreads();
            if (lane == 0) xch[wave] = ss;
            __syncthreads();
            const int w0 = wave & 4;
            const float rstd = 1.0f / sqrtf(((xch[w0] + xch[w0 + 1]) + (xch[w0 + 2] + xch[w0 + 3])) * (1.0f / DM) + EPSN);
#pragma unroll
            for (int j = 0; j < 2; ++j) { const int c = q4 * 512 + 4 * lane + 256 * j;
                const f32x4 sc = *(const f32x4*)(mr + off_sc + c) + *(const f32x4*)(bada + off_sc + c) + 1.0f;
                const f32x4 sh = *(const f32x4*)(mr + off_sh + c) + *(const f32x4*)(bada + off_sh + c);
                const f32x4 h = v[j] * rstd * sc + sh;
                u32x2 w; w.x = pk2(h[0], h[1]); w.y = pk2(h[2], h[3]);
                *(u32x2*)(H + (size_t)row * DM + c) = w; }
        }
    }
}
template <int NSL>
__device__ __forceinline__ void final_rows(float* xch, float* X, const float* gf, const float* part, const float* mod, const float* bada) {
    const int tid_ = ltid(), lane = tid_ & 63, gw = blockIdx.x * 8 + (tid_ >> 6), NGW = gridDim.x * 8;
    {
        f32x4 v[8], nx[8], gn[8];
#pragma unroll
        for (int j = 0; j < 8; ++j) { gn[j] = *(const f32x4*)(gf + 4 * lane + 256 * j); v[j] = *(const f32x4*)(X + (size_t)gw * DM + 4 * lane + 256 * j); }
        for (int row = gw; row < MP; row += NGW) {
            const int nrow = row + NGW;
            if (nrow < MP) {
#pragma unroll
                for (int j = 0; j < 8; ++j) nx[j] = *(const f32x4*)(X + (size_t)nrow * DM + 4 * lane + 256 * j); }
            float ss = 0.f;
#pragma unroll
            for (int j = 0; j < 8; ++j) ss += (v[j][0] * v[j][0] + v[j][1] * v[j][1]) + (v[j][2] * v[j][2] + v[j][3] * v[j][3]);
            const float rstd = 1.0f / sqrtf(wave_sum(ss) * (1.0f / DM) + EPSN);
#pragma unroll
            for (int j = 0; j < 8; ++j) { *(f32x4*)(X + (size_t)row * DM + 4 * lane + 256 * j) = v[j] * rstd * gn[j]; v[j] = nx[j]; }
        }
    }
    __builtin_amdgcn_sched_barrier(0);
    {
        const int wave = tid_ >> 6, q4 = wave & 3;
        for (int rp = blockIdx.x; rp < MS / 2; rp += gridDim.x) {
            const int sr = 2 * rp + (wave >> 2), row = MP + sr;
            f32x4 v[2]; float ss = 0.f;
#pragma unroll
            for (int j = 0; j < 2; ++j) { const int c = q4 * 512 + 4 * lane + 256 * j; v[j] = *(const f32x4*)(X + (size_t)row * DM + c);
                if (NSL > 0) { f32x4 a = (f32x4){0.f, 0.f, 0.f, 0.f};
#pragma unroll
                    for (int s2 = 0; s2 < NSL; ++s2) a += *(const f32x4*)(part + ((size_t)s2 * MS + sr) * DM + c);
                    const f32x4 gt = *(const f32x4*)(mod + (size_t)row_ci(row) * NMOD + 10240 + c) + *(const f32x4*)(bada + 10240 + c);
                    v[j] += gt * a; }
                ss += (v[j][0] * v[j][0] + v[j][1] * v[j][1]) + (v[j][2] * v[j][2] + v[j][3] * v[j][3]); }
            ss = wave_sum(ss);
            __syncthreads();
            if (lane == 0) xch[wave] = ss;
            __syncthreads();
            const int w0 = wave & 4;
            const float rstd = 1.0f / sqrtf(((xch[w0] + xch[w0 + 1]) + (xch[w0 + 2] + xch[w0 + 3])) * (1.0f / DM) + EPSN);
#pragma unroll
            for (int j = 0; j < 2; ++j) { const int c = q4 * 512 + 4 * lane + 256 * j; *(f32x4*)(X + (size_t)row * DM + c) = v[j] * rstd * *(const f32x4*)(gf + c); }
        }
    }
}
__device__ __forceinline__ void latent_rows(const float* cqkv, const float* gq, const float* gkv, bf16_t* cqn, bf16_t* ckv, float* ockp, float* ocks) {
    const int tid_ = ltid(), lane = tid_ & 63, gw = blockIdx.x * 8 + (tid_ >> 6), NGW = gridDim.x * 8;
    for (int row = gw; row < MT; row += NGW) {
        const float* sr = cqkv + (size_t)row * 1024;
        f32x4 a[2], b[2]; float sa = 0.f, sb = 0.f;
#pragma unroll
        for (int j = 0; j < 2; ++j) { a[j] = *(const f32x4*)(sr + 4 * lane + 256 * j); b[j] = *(const f32x4*)(sr + 512 + 4 * lane + 256 * j);
            sa += (a[j][0] * a[j][0] + a[j][1] * a[j][1]) + (a[j][2] * a[j][2] + a[j][3] * a[j][3]); sb += (b[j][0] * b[j][0] + b[j][1] * b[j][1]) + (b[j][2] * b[j][2] + b[j][3] * b[j][3]); }
        const float ra = 1.0f / sqrtf(wave_sum(sa) * (1.0f / 512) + EPSN), rb = 1.0f / sqrtf(wave_sum(sb) * (1.0f / 512) + EPSN);
        float* oc = row < MP ? ockp + (size_t)row * 512 : ocks + (size_t)(row - MP) * 512;
#pragma unroll
        for (int j = 0; j < 2; ++j) { const int c = 4 * lane + 256 * j;
            const f32x4 qa = a[j] * ra * *(const f32x4*)(gq + c), kb = b[j] * rb * *(const f32x4*)(gkv + c);
            u32x2 w; w.x = pk2(qa[0], qa[1]); w.y = pk2(qa[2], qa[3]); *(u32x2*)(cqn + (size_t)row * 512 + c) = w;
            *(f32x4*)(oc + c) = kb;
            w.x = pk2(kb[0], kb[1]); w.y = pk2(kb[2], kb[3]); *(u32x2*)(ckv + (size_t)row * 512 + c) = w; }
    }
}

template <int L>
__device__ __forceinline__ void hgrn_cumsum(const float* G, int row0, int h, int lreal, float* Bs, float* tot, float (&gv)[L / 4]) {
    constexpr int SEG = L / 4;
    const int tid = ltid(), k = tid & 127, seg = tid >> 7;
    float run = 0.f;
#pragma unroll
    for (int i = 0; i < SEG; ++i) { const int t = seg * SEG + i; gv[i] = t < lreal ? G[(size_t)(row0 + t) * 1024 + h * 128 + k] : 0.f; }
#pragma unroll
    for (int i = 0; i < SEG; ++i) { run += gv[i]; Bs[(seg * SEG + i) * 128 + k] = run; }
    tot[seg * 128 + k] = run;
    __syncthreads();
    float off = 0.f;
#pragma unroll
    for (int s2 = 0; s2 < 3; ++s2) if (s2 < seg) off += tot[s2 * 128 + k];
#pragma unroll
    for (int i = 0; i < SEG; ++i) Bs[(seg * SEG + i) * 128 + k] += off;
    __syncthreads();
}
template <int L>
__device__ __forceinline__ void hgrn_a(int it, int bh, int row0, int lreal, const float* G, const bf16_t* VH, bf16_t* U, float* DD, unsigned char* lds) {
    constexpr int SEG = L / 4, ST = L + 8;
    const int tid = ltid(), lane = tid & 63, wave = tid >> 6, k = tid & 127, seg = tid >> 7, h = bh & 7;
    float* Bs = (float*)lds; float* tot = (float*)(lds + 32768);
    bf16_t* KDT = (bf16_t*)(lds + 34816); bf16_t* VT = (bf16_t*)(lds + 34816 + 128 * ST * 2);
    float gv[SEG]; bf16_t vraw[SEG];
#pragma unroll
    for (int i = 0; i < SEG; ++i) { const int s = seg * SEG + i; vraw[i] = s < lreal ? VH[(size_t)(row0 + s) * 1024 + h * 128 + k] : (bf16_t)0; }
    hgrn_cumsum<L>(G, row0, h, lreal, Bs, tot, gv);
    const float blast = Bs[(L - 1) * 128 + k];
#pragma unroll
    for (int i = 0; i < SEG; ++i) { const int s = seg * SEG + i;
        const float kd = (1.0f - __expf(gv[i])) * __expf(blast - Bs[s * 128 + k]);
        KDT[k * ST + s] = (bf16_t)(pk2(kd, 0.f) & 0xffffu);
        VT[k * ST + s] = vraw[i]; }
    if (seg == 0) DD[(size_t)it * 128 + k] = __expf(blast);
    __syncthreads();
    const int r = lane & 15, g = lane >> 4;
#pragma unroll
    for (int vt = 0; vt < 8; ++vt) {
        f32x4 acc = (f32x4){0.f, 0.f, 0.f, 0.f};
#pragma unroll
        for (int ks = 0; ks < L / 32; ++ks) {
            const bf16x8 a = *(const bf16x8*)(KDT + (16 * wave + r) * ST + 32 * ks + 8 * g);
            const bf16x8 b = *(const bf16x8*)(VT + (16 * vt + r) * ST + 32 * ks + 8 * g);
            acc = __builtin_amdgcn_mfma_f32_16x16x32_bf16(a, b, acc, 0, 0, 0);
        }
        bf16_t* up = U + (size_t)it * 16384 + (16 * wave + 4 * g) * 128 + 16 * vt + r;
        const unsigned p01 = pk2(acc[0], acc[1]), p23 = pk2(acc[2], acc[3]);
        up[0] = (bf16_t)(p01 & 0xffffu); up[128] = (bf16_t)(p01 >> 16); up[256] = (bf16_t)(p23 & 0xffffu); up[384] = (bf16_t)(p23 >> 16);
    }
    __syncthreads();
}
__device__ __forceinline__ void hgrn_b(const bf16_t* U, const float* DD, bf16_t* Sn, const float* st0, float* ostp, float* osts) {
    const int gt = blockIdx.x * 512 + ltid(), NGT = gridDim.x * 512;
#ifdef HB_TEST
    for (int e = gt; e < 16 * 16384; e += NGT) { const int bh = e >> 14, kv = e & 16383; ostp[e] = bf2f(U[((size_t)bh * 128 + 127) * 16384 + kv]); }
    for (int e = gt; e < 256 * 16384; e += NGT) { const int bh = e >> 14, kv = e & 16383; osts[e] = bf2f(U[((size_t)2048 + bh) * 16384 + kv]) + DD[((size_t)2048 + bh) * 128 + (kv >> 7)]; }
    return;
#endif
    for (int e = gt; e < 8 * 16384; e += NGT) {
        const int e1 = e + 8 * 16384;
        const int bh0 = e >> 14, kv0 = e & 16383, bh1 = e1 >> 14, kv1 = e1 & 16383;
        float S0 = 0.f, S1 = 0.f;
        const bf16_t* up0 = U + (size_t)bh0 * 128 * 16384 + kv0; const float* dp0 = DD + (size_t)bh0 * 128 * 128 + (kv0 >> 7); bf16_t* sp0 = Sn + (size_t)bh0 * 128 * 16384 + kv0;
        const bf16_t* up1 = U + (size_t)bh1 * 128 * 16384 + kv1; const float* dp1 = DD + (size_t)bh1 * 128 * 128 + (kv1 >> 7); bf16_t* sp1 = Sn + (size_t)bh1 * 128 * 16384 + kv1;
        for (int n0 = 0; n0 < 128; n0 += 16) {
            bf16_t ur0[16], ur1[16]; float dr0[16], dr1[16];
#pragma unroll
            for (int j = 0; j < 16; ++j) { ur0[j] = up0[(size_t)(n0 + j) * 16384]; dr0[j] = dp0[(n0 + j) * 128]; ur1[j] = up1[(size_t)(n0 + j) * 16384]; dr1[j] = dp1[(n0 + j) * 128]; }
#pragma unroll
            for (int j = 0; j < 16; ++j) { sp0[(size_t)(n0 + j) * 16384] = (bf16_t)(pk2(S0, 0.f) & 0xffffu); S0 = dr0[j] * S0 + bf2f(ur0[j]);
                                           sp1[(size_t)(n0 + j) * 16384] = (bf16_t)(pk2(S1, 0.f) & 0xffffu); S1 = dr1[j] * S1 + bf2f(ur1[j]); }
        }
        ostp[e] = S0; ostp[e1] = S1;
    }
    for (int e = gt; e < 256 * 16384; e += 8 * NGT) {
        float s0[8], dd[8]; bf16_t uu[8];
#pragma unroll
        for (int j = 0; j < 8; ++j) { const int ej = e + j * NGT; const int bh = ej >> 14, kv = ej & 16383; const size_t it = 2048 + bh;
            const bool ok = ej < 256 * 16384;
            s0[j] = ok ? st0[ej] : 0.f; dd[j] = ok ? DD[it * 128 + (kv >> 7)] : 0.f; uu[j] = ok ? U[it * 16384 + kv] : (bf16_t)0; }
#pragma unroll
        for (int j = 0; j < 8; ++j) { const int ej = e + j * NGT; const int bh = ej >> 14, kv = ej & 16383; const size_t it = 2048 + bh;
            if (ej < 256 * 16384) { Sn[it * 16384 + kv] = (bf16_t)(pk2(s0[j], 0.f) & 0xffffu); osts[ej] = dd[j] * s0[j] + bf2f(uu[j]); } }
    }
}
template <int L>
__device__ __forceinline__ void hgrn_c(int it, int bh, int row0, int lreal, const float* G, const bf16_t* QH, const bf16_t* VH, const bf16_t* GATE, const bf16_t* Sn, const float* ghg, bf16_t* MIX, unsigned char* lds) {
    constexpr int SEG = L / 4, VS = L + 8;
    const int tid = ltid(), lane = tid & 63, wave = tid >> 6, k = tid & 127, seg = tid >> 7, h = bh & 7;
    float* Bs = (float*)lds; float* tot = (float*)(lds + 32768);
    bf16_t* QT = (bf16_t*)(lds + 34816); bf16_t* KT = (bf16_t*)(lds + 52224); bf16_t* VT = (bf16_t*)(lds + 69632); bf16_t* ST = (bf16_t*)(lds + 88064);
    float gv[SEG];
    bf16_t qraw[SEG], vraw[SEG]; u32x4 sraw[4];
#pragma unroll
    for (int i = 0; i < SEG; ++i) { const int s = seg * SEG + i;
        qraw[i] = s < lreal ? QH[(size_t)(row0 + s) * 1024 + h * 128 + k] : (bf16_t)0;
        vraw[i] = s < lreal ? VH[(size_t)(row0 + s) * 1024 + h * 128 + k] : (bf16_t)0; }
#pragma unroll
    for (int i = 0; i < 4; ++i) sraw[i] = *(const u32x4*)(Sn + (size_t)it * 16384 + (size_t)k * 128 + (seg + 4 * i) * 8);
    hgrn_cumsum<L>(G, row0, h, lreal, Bs, tot, gv);
#pragma unroll
    for (int i = 0; i < SEG; ++i) { const int s = seg * SEG + i; const float bs = Bs[s * 128 + k];
        QT[s * 136 + k] = (bf16_t)(pk2(bf2f(qraw[i]) * __expf(bs), 0.f) & 0xffffu);
        KT[s * 136 + k] = (bf16_t)(pk2((1.0f - __expf(gv[i])) * __expf(-bs), 0.f) & 0xffffu);
        VT[k * VS + s] = vraw[i]; }
#pragma unroll
    for (int i = 0; i < 4; ++i) { const int kk = k, v0 = (seg + 4 * i) * 8;
        const unsigned w4[4] = {sraw[i].x, sraw[i].y, sraw[i].z, sraw[i].w};
#pragma unroll
        for (int e = 0; e < 4; ++e) { ST[(v0 + 2 * e) * 136 + kk] = (bf16_t)(w4[e] & 0xffffu); ST[(v0 + 2 * e + 1) * 136 + kk] = (bf16_t)(w4[e] >> 16); } }
    __syncthreads();
    const int tt = wave;
    if (tt * 16 < lreal) {
        const int r = lane & 15, g = lane >> 4;
        bf16x8 qf[4];
#pragma unroll
        for (int ks = 0; ks < 4; ++ks) qf[ks] = *(const bf16x8*)(QT + (16 * tt + r) * 136 + 32 * ks + 8 * g);
        bf16x8 pf[L / 32];
#pragma unroll
        for (int p = 0; p < L / 32; ++p) {
            unsigned pw[4];
#pragma unroll
            for (int hs = 0; hs < 2; ++hs) { const int st = 2 * p + hs;
                f32x4 acc = (f32x4){0.f, 0.f, 0.f, 0.f};
                if (st <= tt) {
#pragma unroll
                    for (int ks = 0; ks < 4; ++ks) { const bf16x8 a = *(const bf16x8*)(KT + (16 * st + r) * 136 + 32 * ks + 8 * g); acc = __builtin_amdgcn_mfma_f32_16x16x32_bf16(a, qf[ks], acc, 0, 0, 0); }
#pragma unroll
                    for (int e = 0; e < 4; ++e) if (16 * st + 4 * g + e > 16 * tt + r) acc[e] = 0.f;
                }
                pw[2 * hs] = pk2(acc[0], acc[1]); pw[2 * hs + 1] = pk2(acc[2], acc[3]); }
            u32x4 t4 = (u32x4){pw[0], pw[1], pw[2], pw[3]};
            pf[p] = __builtin_bit_cast(bf16x8, t4);
        }
        f32x4 o[8]; float ss = 0.f;
#pragma unroll
        for (int vt = 0; vt < 8; ++vt) {
            f32x4 acc = (f32x4){0.f, 0.f, 0.f, 0.f};
#pragma unroll
            for (int p = 0; p < L / 32; ++p) if (2 * p <= tt) {
                const u32x2 lo = *(const u32x2*)(VT + (16 * vt + r) * VS + 32 * p + 4 * g), hi = *(const u32x2*)(VT + (16 * vt + r) * VS + 32 * p + 16 + 4 * g);
                u32x4 t4 = (u32x4){lo.x, lo.y, hi.x, hi.y};
                acc = __builtin_amdgcn_mfma_f32_16x16x32_bf16(__builtin_bit_cast(bf16x8, t4), pf[p], acc, 0, 0, 0); }
#pragma unroll
            for (int ks = 0; ks < 4; ++ks) { const bf16x8 a = *(const bf16x8*)(ST + (16 * vt + r) * 136 + 32 * ks + 8 * g); acc = __builtin_amdgcn_mfma_f32_16x16x32_bf16(a, qf[ks], acc, 0, 0, 0); }
            o[vt] = acc; ss += (acc[0] * acc[0] + acc[1] * acc[1]) + (acc[2] * acc[2] + acc[3] * acc[3]);
        }
        ss += __shfl_xor(ss, 16); ss += __shfl_xor(ss, 32);
        const float rstd = 1.0f / sqrtf(ss * (1.0f / 128) + EPSN);
        const int t = 16 * tt + r;
        if (t < lreal) {
            const size_t row = (size_t)(row0 + t);
#pragma unroll
            for (int vt = 0; vt < 8; ++vt) { const int v0 = 16 * vt + 4 * g;
                const u32x2 gw2 = *(const u32x2*)(GATE + row * 1024 + h * 128 + v0); const f32x4 gh = *(const f32x4*)(ghg + v0);
                const float g0 = __uint_as_float(gw2.x << 16), g1 = __uint_as_float(gw2.x & 0xffff0000u), g2 = __uint_as_float(gw2.y << 16), g3 = __uint_as_float(gw2.y & 0xffff0000u);
                u32x2 w; w.x = pk2(o[vt][0] * rstd * gh[0] * g0, o[vt][1] * rstd * gh[1] * g1); w.y = pk2(o[vt][2] * rstd * gh[2] * g2, o[vt][3] * rstd * gh[3] * g3);
                *(u32x2*)(MIX + row * 2048 + 1024 + h * 128 + v0) = w; }
        }
    }
    __syncthreads();
}

template <int NKS, int NDT, int KSTR, int VSTR, bool QG, int NQF>
__device__ __forceinline__ void attn_step(const bf16x8 (&qf)[NQF], const bf16_t* qg, f32x4 (&o)[NDT], float& m, float& l, const LAS unsigned char* kimg, const LAS unsigned char* vimg, int lane, bool half_valid) {
    const int r = lane & 15, g = lane >> 4;
    f32x4 s0 = (f32x4){0.f, 0.f, 0.f, 0.f}, s1 = (f32x4){0.f, 0.f, 0.f, 0.f};
    const LAS unsigned char* kp = kimg + r * (KSTR * 2) + g * 16;
    if constexpr (QG) {
#pragma unroll 1
        for (int ks3 = 0; ks3 < NKS; ks3 += 3) {
#pragma unroll
            for (int k2 = 0; k2 < 3; ++k2) { const int ks = ks3 + k2;
                const bf16x8 a0 = *(const LAS bf16x8*)(kp + ks * 64), a1 = *(const LAS bf16x8*)(kp + 16 * KSTR * 2 + ks * 64);
                const bf16x8 qv = *(const bf16x8*)(qg + 32 * ks);
                s0 = __builtin_amdgcn_mfma_f32_16x16x32_bf16(a0, qv, s0, 0, 0, 0);
                s1 = __builtin_amdgcn_mfma_f32_16x16x32_bf16(a1, qv, s1, 0, 0, 0); }
        }
    } else {
#pragma unroll
        for (int ks = 0; ks < NKS; ++ks) {
            const bf16x8 a0 = *(const LAS bf16x8*)(kp + ks * 64), a1 = *(const LAS bf16x8*)(kp + 16 * KSTR * 2 + ks * 64);
            s0 = __builtin_amdgcn_mfma_f32_16x16x32_bf16(a0, qf[ks], s0, 0, 0, 0);
            s1 = __builtin_amdgcn_mfma_f32_16x16x32_bf16(a1, qf[ks], s1, 0, 0, 0);
        }
    }
    if (half_valid) s1 = (f32x4){-INFINITY, -INFINITY, -INFINITY, -INFINITY};
    float mx = fmaxf(fmaxf(fmaxf(s0[0], s0[1]), fmaxf(s0[2], s0[3])), fmaxf(fmaxf(s1[0], s1[1]), fmaxf(s1[2], s1[3])));
    mx = fmaxf(mx, __shfl_xor(mx, 16)); mx = fmaxf(mx, __shfl_xor(mx, 32));
    const float mn = fmaxf(m, mx), alpha = exp2f(m - mn);
    f32x4 p0, p1;
#pragma unroll
    for (int e = 0; e < 4; ++e) { p0[e] = exp2f(s0[e] - mn); p1[e] = exp2f(s1[e] - mn); }
    float ls = (p0[0] + p0[1]) + (p0[2] + p0[3]) + (p1[0] + p1[1]) + (p1[2] + p1[3]);
    ls += __shfl_xor(ls, 16); ls += __shfl_xor(ls, 32);
    l = l * alpha + ls; m = mn;
    u32x4 pw = (u32x4){pk2(p0[0], p0[1]), pk2(p0[2], p0[3]), pk2(p1[0], p1[1]), pk2(p1[2], p1[3])};
    const bf16x8 pf = __builtin_bit_cast(bf16x8, pw);
    const LAS unsigned char* vp = vimg + r * (VSTR * 2) + g * 8;
#pragma unroll
    for (int dt = 0; dt < NDT; ++dt) {
        const u32x2 lo = *(const LAS u32x2*)(vp + dt * 16 * VSTR * 2), hi = *(const LAS u32x2*)(vp + dt * 16 * VSTR * 2 + 32);
        u32x4 t4 = (u32x4){lo.x, lo.y, hi.x, hi.y};
        o[dt] = __builtin_amdgcn_mfma_f32_16x16x32_bf16(__builtin_bit_cast(bf16x8, t4), pf, o[dt] * alpha, 0, 0, 0);
        if ((dt & 3) == 3) __builtin_amdgcn_sched_barrier(0);
    }
}

typedef float f32x16 __attribute__((ext_vector_type(16)));
__device__ __forceinline__ void attn_prompt_item(int b, int h, int qb, const bf16_t* Q, const bf16_t* KN, const bf16_t* KPE, const bf16_t* VT, bf16_t* MIX, LAS unsigned char* lds) {
    constexpr int KSTR = 200, VSTR = 72, KIMG = 64 * KSTR * 2, BUFB = KIMG + 128 * VSTR * 2;
    const int tid = ltid(), lane = tid & 63, wave = tid >> 6, r = lane & 31, hh = lane >> 5;
    const int nkt = 4 * qb + 4, nkw = 4 * qb + (wave >> 1) + 1;
    const size_t qrow = (size_t)b * 8192 + 256 * qb + 32 * wave + r;
    bf16x8 qf[12];
#pragma unroll
    for (int ks = 0; ks < 12; ++ks) qf[ks] = *(const bf16x8*)(Q + qrow * 1536 + h * 192 + 16 * ks + 8 * hh);
    f32x16 o[4];
#pragma unroll
    for (int dt = 0; dt < 4; ++dt)
#pragma unroll
        for (int i = 0; i < 16; ++i) o[dt][i] = 0.f;
    float m = -INFINITY, l = 0.f;
    const bf16_t* kn_src = KN + ((size_t)b * 8192 + (tid >> 4)) * 1024 + h * 128 + 8 * (tid & 15);
    const bf16_t* kp_src = KPE + ((size_t)b * 8192 + (tid >> 3)) * 64 + 8 * (tid & 7);
    const bf16_t* vt_src = VT + ((size_t)h * 128 + (tid >> 3)) * 16384 + (size_t)b * 8192 + 8 * (tid & 7);
    const int wk = (tid >> 4) * (KSTR * 2) + (tid & 15) * 16, wp = (tid >> 3) * (KSTR * 2) + 256 + (tid & 7) * 16, wv = KIMG + (tid >> 3) * (VSTR * 2) + ((tid & 7) >> 1) * 32 + ((tid & 7) & 1) * 8;
    u32x4 ak0, ak1, ap, av0, av1;
#define AT_LOAD(S_, t) do { S_##k0 = *(const u32x4*)(kn_src + (size_t)(t) * 64 * 1024); S_##k1 = *(const u32x4*)(kn_src + ((size_t)(t) * 64 + 32) * 1024); S_##p = *(const u32x4*)(kp_src + (size_t)(t) * 64 * 64); \
        S_##v0 = *(const u32x4*)(vt_src + (t) * 64); S_##v1 = *(const u32x4*)(vt_src + (size_t)64 * 16384 + (t) * 64); } while (0)
#define AT_STORE(S_, t) do { const int bo_ = ((t) & 1) * BUFB; *(LAS u32x4*)(lds + bo_ + wk) = S_##k0; *(LAS u32x4*)(lds + bo_ + wk + 32 * KSTR * 2) = S_##k1; *(LAS u32x4*)(lds + bo_ + wp) = S_##p; \
        *(LAS u32x2*)(lds + bo_ + wv) = (u32x2){S_##v0.x, S_##v0.y}; *(LAS u32x2*)(lds + bo_ + wv + 16) = (u32x2){S_##v0.z, S_##v0.w}; \
        *(LAS u32x2*)(lds + bo_ + wv + 64 * VSTR * 2) = (u32x2){S_##v1.x, S_##v1.y}; *(LAS u32x2*)(lds + bo_ + wv + 64 * VSTR * 2 + 16) = (u32x2){S_##v1.z, S_##v1.w}; } while (0)
#define AT_SUB(kt, u) do { \
            const LAS unsigned char* kimg = lds + ((kt) & 1) * BUFB + (u) * 32 * KSTR * 2; const LAS unsigned char* vimg = lds + ((kt) & 1) * BUFB + KIMG + (u) * 64; \
            f32x16 sc; \
            _Pragma("unroll") for (int i = 0; i < 16; ++i) sc[i] = 0.f; \
            const LAS unsigned char* kp = kimg + r * (KSTR * 2) + hh * 16; \
            _Pragma("unroll") for (int ks = 0; ks < 12; ++ks) { const bf16x8 a = *(const LAS bf16x8*)(kp + ks * 32); sc = __builtin_amdgcn_mfma_f32_32x32x16_bf16(a, qf[ks], sc, 0, 0, 0); } \
            float mx = sc[0]; \
            _Pragma("unroll") for (int i = 1; i < 16; ++i) mx = fmaxf(mx, sc[i]); \
            mx = fmaxf(mx, __shfl_xor(mx, 32)); \
            const float mn = fmaxf(m, mx), alpha = __builtin_amdgcn_exp2f(m - mn); \
            float ls = 0.f; \
            _Pragma("unroll") for (int i = 0; i < 16; ++i) { sc[i] = __builtin_amdgcn_exp2f(sc[i] - mn); ls += sc[i]; } \
            ls += __shfl_xor(ls, 32); \
            l = l * alpha + ls; m = mn; \
            bf16x8 pf[2]; \
            _Pragma("unroll") for (int s2 = 0; s2 < 2; ++s2) { u32x4 pw = (u32x4){pk2(sc[8 * s2], sc[8 * s2 + 1]), pk2(sc[8 * s2 + 2], sc[8 * s2 + 3]), pk2(sc[8 * s2 + 4], sc[8 * s2 + 5]), pk2(sc[8 * s2 + 6], sc[8 * s2 + 7])}; pf[s2] = __builtin_bit_cast(bf16x8, pw); } \
            const LAS unsigned char* vp = vimg + r * (VSTR * 2) + hh * 16; \
            _Pragma("unroll") for (int dt = 0; dt < 4; ++dt) { \
                f32x16 acc = o[dt] * alpha; \
                _Pragma("unroll") for (int s2 = 0; s2 < 2; ++s2) { \
                    const bf16x8 va = *(const LAS bf16x8*)(vp + dt * 32 * VSTR * 2 + s2 * 32); \
                    acc = __builtin_amdgcn_mfma_f32_32x32x16_bf16(va, pf[s2], acc, 0, 0, 0); } \
                o[dt] = acc; } } while (0)
#define AT_COMPUTE(kt) do { if ((kt) < nkw) { AT_SUB(kt, 0); AT_SUB(kt, 1); } } while (0)
    AT_LOAD(a, 0); AT_STORE(a, 0); AT_LOAD(a, 1);
    __syncthreads();
    for (int kt = 0; kt < nkt; ++kt) {
        AT_COMPUTE(kt);
        if (kt + 1 < nkt) AT_STORE(a, kt + 1);
        if (kt + 2 < nkt) AT_LOAD(a, kt + 2);
        __syncthreads();
    }
#undef AT_LOAD
#undef AT_STORE
#undef AT_SUB
#undef AT_COMPUTE
    const float inv = 1.0f / l;
#pragma unroll
    for (int dt = 0; dt < 4; ++dt)
#pragma unroll
        for (int ig = 0; ig < 4; ++ig) { u32x2 w; w.x = pk2(o[dt][4 * ig] * inv, o[dt][4 * ig + 1] * inv); w.y = pk2(o[dt][4 * ig + 2] * inv, o[dt][4 * ig + 3] * inv);
            *(u32x2*)(MIX + qrow * 2048 + h * 128 + 32 * dt + 8 * ig + 4 * hh) = w; }
}

constexpr int NSPL = 8;
__device__ __forceinline__ void attn_sample_item(int b, int sp, const bf16_t* Q, const bf16_t* WUKO, const float* cckv, const float* ckpe, const bf16_t* CKV, const bf16_t* KPE, bf16_t* QLAT, bf16_t* PO, float* PML, LAS unsigned char* lds) {
    constexpr int KSTR = 584, VSTR = 36;
    const int tid = ltid(), lane = tid & 63, h = tid >> 6, r = lane & 15, g = lane >> 4;
    LAS unsigned char* kimg = lds; LAS unsigned char* vimg = lds + 32 * KSTR * 2;
    const size_t qrow0 = (size_t)MP + (size_t)b * 16;
    bf16_t* ql = QLAT + ((size_t)b * 8 + h) * 16 * 576;
    {
        bf16x8 aq[4];
#pragma unroll
        for (int ks = 0; ks < 4; ++ks) aq[ks] = *(const bf16x8*)(Q + (qrow0 + r) * 1536 + h * 192 + 32 * ks + 8 * g);
#pragma unroll 8
        for (int ct = 0; ct < 32; ++ct) {
            f32x4 acc = (f32x4){0.f, 0.f, 0.f, 0.f};
#pragma unroll
            for (int ks = 0; ks < 4; ++ks) { const bf16x8 bw = *(const bf16x8*)(WUKO + (size_t)(16 * ct + r) * 1024 + h * 128 + 32 * ks + 8 * g); acc = __builtin_amdgcn_mfma_f32_16x16x32_bf16(bw, aq[ks], acc, 0, 0, 0); }
            u32x2 w; w.x = pk2(acc[0], acc[1]); w.y = pk2(acc[2], acc[3]);
            *(u32x2*)(ql + r * 576 + 16 * ct + 4 * g) = w;
        }
#pragma unroll
        for (int i = 0; i < 2; ++i) { const int pc = lane + 64 * i, qq = pc >> 3, cc = pc & 7;
            *(u32x4*)(ql + qq * 576 + 512 + 8 * cc) = *(const u32x4*)(Q + (qrow0 + qq) * 1536 + h * 192 + 128 + 8 * cc); }
    }
    __threadfence(); __syncthreads();
    const bf16_t* qg = ql + r * 576 + 8 * g;
    f32x4 o[32];
#pragma unroll
    for (int dt = 0; dt < 32; ++dt) o[dt] = (f32x4){0.f, 0.f, 0.f, 0.f};
    float m = -INFINITY, l = 0.f;
    const float* cb = cckv + (size_t)b * 2048 * 512; const float* pb = ckpe + (size_t)b * 2048 * 64;
    const int kt0 = sp * 8, kt1 = (sp == NSPL - 1) ? 65 : kt0 + 8;
    for (int kt = kt0; kt < kt1; ++kt) {
        __syncthreads();
        if (kt < 64) {
            const int c = tid;
            float v[32];
#pragma unroll
            for (int kk = 0; kk < 32; ++kk) v[kk] = cb[(size_t)(32 * kt + kk) * 512 + c];
            const int key = tid >> 4, i4 = (tid & 15) * 4; const f32x4 pv = *(const f32x4*)(pb + (size_t)(32 * kt + key) * 64 + i4);
#pragma unroll
            for (int kk = 0; kk < 32; kk += 2) {
                const unsigned pw = pk2(v[kk], v[kk + 1]);
                *(LAS bf16_t*)(kimg + kk * (KSTR * 2) + c * 2) = (bf16_t)(pw & 0xffffu);
                *(LAS bf16_t*)(kimg + (kk + 1) * (KSTR * 2) + c * 2) = (bf16_t)(pw >> 16);
                *(LAS unsigned*)(vimg + c * (VSTR * 2) + kk * 2) = pw;
            }
#pragma unroll
            for (int e = 0; e < 4; ++e) { const int i = i4 + e, pi = i < 32 ? 2 * i : 2 * (i - 32) + 1;
                *(LAS bf16_t*)(kimg + key * (KSTR * 2) + (512 + pi) * 2) = (bf16_t)(pk2(pv[e], 0.f) & 0xffffu); }
        } else {
            const int c = tid;
#pragma unroll 4
            for (int kk = 0; kk < 32; kk += 2) {
                unsigned pw = 0u;
                if (kk < 16) { const unsigned a = CKV[(qrow0 + kk) * 512 + c], bb = CKV[(qrow0 + kk + 1) * 512 + c]; pw = a | (bb << 16); }
                *(LAS bf16_t*)(kimg + kk * (KSTR * 2) + c * 2) = (bf16_t)(pw & 0xffffu);
                *(LAS bf16_t*)(kimg + (kk + 1) * (KSTR * 2) + c * 2) = (bf16_t)(pw >> 16);
                *(LAS unsigned*)(vimg + c * (VSTR * 2) + kk * 2) = pw;
            }
            { const int key = tid >> 4, i4 = (tid & 15) * 4;
              u32x2 w = (u32x2){0u, 0u}; if (key < 16) w = *(const u32x2*)(KPE + (qrow0 + key) * 64 + i4);
              *(LAS u32x2*)(kimg + key * (KSTR * 2) + (512 + i4) * 2) = w; }
        }
        bf16x8 qv[18];
#pragma unroll
        for (int ks = 0; ks < 18; ++ks) qv[ks] = *(const bf16x8*)(qg + 32 * ks);
        __syncthreads();
        attn_step<18, 32, KSTR, VSTR, false, 18>(qv, nullptr, o, m, l, kimg, vimg, lane, kt == 64);
    }
    const float inv = 1.0f / l;
    const size_t pi = (((size_t)b * NSPL + sp) * 8 + h) * 16 + r;
    bf16_t* po = PO + pi * 512 + 4 * g;
#pragma unroll
    for (int dt = 0; dt < 32; ++dt) { u32x2 w; w.x = pk2(o[dt][0] * inv, o[dt][1] * inv); w.y = pk2(o[dt][2] * inv, o[dt][3] * inv); *(u32x2*)(po + 16 * dt) = w; }
    if (g == 0) *(f32x2*)(PML + pi * 2) = (f32x2){m, l};
    __syncthreads();
}
__device__ __forceinline__ void attn_sample_combine(int b, int h, const bf16_t* PO, const float* PML, const bf16_t* WUVT, bf16_t* MIX, LAS unsigned char* lds) {
    const int tid = ltid(), lane = tid & 63, wave = tid >> 6, r = lane & 15, g = lane >> 4;
    float ms[NSPL], cs[NSPL], M = -INFINITY, L = 0.f;
#pragma unroll
    for (int sp = 0; sp < NSPL; ++sp) { const f32x2 ml = *(const f32x2*)(PML + ((((size_t)b * NSPL + sp) * 8 + h) * 16 + r) * 2); ms[sp] = ml.x; cs[sp] = ml.y; M = fmaxf(M, ml.x); }
#pragma unroll
    for (int sp = 0; sp < NSPL; ++sp) { cs[sp] *= __builtin_amdgcn_exp2f(ms[sp] - M); L += cs[sp]; }
    const float invL = 1.0f / L;
#pragma unroll
    for (int sp = 0; sp < NSPL; ++sp) cs[sp] *= invL;
#pragma unroll
    for (int s2 = 0; s2 < 2; ++s2) { const int s = 2 * wave + s2;
        f32x4 a0 = (f32x4){0.f, 0.f, 0.f, 0.f}, a1 = (f32x4){0.f, 0.f, 0.f, 0.f};
#pragma unroll
        for (int sp = 0; sp < NSPL; ++sp) {
            const bf16_t* po = PO + ((((size_t)b * NSPL + sp) * 8 + h) * 16 + r) * 512 + 32 * s + 4 * g;
            const u32x2 w0 = *(const u32x2*)po, w1 = *(const u32x2*)(po + 16);
            a0 += cs[sp] * (f32x4){__uint_as_float(w0.x << 16), __uint_as_float(w0.x & 0xffff0000u), __uint_as_float(w0.y << 16), __uint_as_float(w0.y & 0xffff0000u)};
            a1 += cs[sp] * (f32x4){__uint_as_float(w1.x << 16), __uint_as_float(w1.x & 0xffff0000u), __uint_as_float(w1.y << 16), __uint_as_float(w1.y & 0xffff0000u)};
        }
        *(LAS u32x4*)(lds + (s * 64 + lane) * 16) = (u32x4){pk2(a0[0], a0[1]), pk2(a0[2], a0[3]), pk2(a1[0], a1[1]), pk2(a1[2], a1[3])};
    }
    __syncthreads();
    const size_t qrow0 = (size_t)MP + (size_t)b * 16;
    const int dt = wave;
    f32x4 acc = (f32x4){0.f, 0.f, 0.f, 0.f};
    const bf16_t* wp = WUVT + (size_t)(h * 128 + 16 * dt + r) * 512 + 4 * g;
#pragma unroll
    for (int s = 0; s < 16; ++s) {
        const u32x2 lo = *(const u32x2*)(wp + 32 * s), hi = *(const u32x2*)(wp + 32 * s + 16);
        u32x4 t4 = (u32x4){lo.x, lo.y, hi.x, hi.y};
        const bf16x8 pf = *(const LAS bf16x8*)(lds + (s * 64 + lane) * 16);
        acc = __builtin_amdgcn_mfma_f32_16x16x32_bf16(__builtin_bit_cast(bf16x8, t4), pf, acc, 0, 0, 0);
    }
    u32x2 w; w.x = pk2(acc[0], acc[1]); w.y = pk2(acc[2], acc[3]);
    *(u32x2*)(MIX + (qrow0 + r) * 2048 + h * 128 + 16 * dt + 4 * g) = w;
    __syncthreads();
}

#define XB_TMO      128
#define XB_XCNT(j)  (256  + 64 * (j))
#define XB_XSUB(j)  (1280 + 64 * (j))
#define XB_XGEN(j)  (2304 + 64 * (j))
#define XB_TOP      3328
#define XB_TOPGEN   3392
#define XCD_BAR_WORDS 3456
#define XB_SPIN_CAP (1u << 18)
__device__ __forceinline__ unsigned xb_ld(unsigned* p)              { return __hip_atomic_load(p, __ATOMIC_RELAXED, __HIP_MEMORY_SCOPE_AGENT); }
__device__ __forceinline__ unsigned xb_add(unsigned* p, unsigned v) { return __hip_atomic_fetch_add(p, v, __ATOMIC_RELAXED, __HIP_MEMORY_SCOPE_AGENT); }
__device__ __forceinline__ unsigned xb_xcc_id() { return (unsigned)__builtin_amdgcn_s_getreg((3 << 11) | 20) & 0xFu; }
#define XB_SPIN(cond, bar) do { unsigned _sp = 0; while (cond) { __builtin_amdgcn_s_sleep(1); \
    if ((++_sp & 255u) == 0u) { if (xb_ld(&(bar)[XB_TMO])) break; if (_sp > XB_SPIN_CAP) { atomicAdd(&(bar)[XB_TMO], 1u); break; } } } } while (0)
struct XcdBarrier { unsigned* bar; unsigned x; volatile LAS unsigned* st; };
__device__ __forceinline__ XcdBarrier xcd_barrier_post(unsigned* bar, volatile LAS unsigned* st) {
    XcdBarrier b; b.bar = bar; b.x = xb_xcc_id(); b.st = st;
    if (threadIdx.x == 0) (void)xb_add(&bar[XB_XCNT(b.x)], 1u);
    return b;
}
__device__ __forceinline__ void xcd_barrier_complete(unsigned* bar, unsigned x, unsigned& nloc, unsigned& nx) {
    const unsigned G = gridDim.x * gridDim.y * gridDim.z;
    unsigned sum, cnt, mine, sp = 0u;
    for (;;) {
        sum = 0u; cnt = 0u; mine = 0u;
#pragma unroll
        for (unsigned j = 0; j < 16; ++j) { const unsigned c = xb_ld(&bar[XB_XCNT(j)]); sum += c; cnt += (c > 0u) ? 1u : 0u; mine = (j == x) ? c : mine; }
        if (sum == G) break;
        __builtin_amdgcn_s_sleep(1);
        if ((++sp & 255u) == 0u) { if (xb_ld(&bar[XB_TMO])) break; if (sp > XB_SPIN_CAP) { atomicAdd(&bar[XB_TMO], 1u); break; } }
    }
    nloc = mine > 0u ? mine : 1u; nx = cnt > 0u ? cnt : 1u;
}
__device__ __forceinline__ void xcd_barrier(const XcdBarrier& b) {
    asm volatile("s_waitcnt vmcnt(0)" ::: "memory");
    __syncthreads();
    if (threadIdx.x == 0) {
        unsigned* bar = b.bar;
        __builtin_amdgcn_s_waitcnt(0);
        unsigned nloc = b.st[0], nx = b.st[1];
        if (nloc == 0u) { xcd_barrier_complete(bar, b.x, nloc, nx); b.st[0] = nloc; b.st[1] = nx; }
        const unsigned old = xb_add(&bar[XB_XSUB(b.x)], 1u);
        const unsigned gen = old / nloc;
        if (old + 1u == (gen + 1u) * nloc) {
            __builtin_amdgcn_fence(__ATOMIC_RELEASE, "agent");
            asm volatile("s_waitcnt vmcnt(0)" ::: "memory");
            const unsigned og = xb_add(&bar[XB_TOP], 1u);
            const unsigned tg = og / nx;
            if (og + 1u == (tg + 1u) * nx) xb_add(&bar[XB_TOPGEN], 1u);
            else XB_SPIN(xb_ld(&bar[XB_TOPGEN]) == tg, bar);
            __builtin_amdgcn_fence(__ATOMIC_ACQUIRE, "agent");
            xb_add(&bar[XB_XGEN(b.x)], 1u);
            asm volatile("s_waitcnt vmcnt(0)" ::: "memory");
        } else {
            XB_SPIN(xb_ld(&bar[XB_XGEN(b.x)]) == gen, bar);
            __builtin_amdgcn_fence(__ATOMIC_ACQUIRE, "agent");
            asm volatile("s_waitcnt vmcnt(0)" ::: "memory");
        }
    }
    __syncthreads();
}

__device__ __forceinline__ void gsync(cg::grid_group& grid) {
    asm volatile("s_waitcnt vmcnt(0) lgkmcnt(0)" ::: "memory");
    grid.sync();
    __builtin_amdgcn_fence(__ATOMIC_ACQUIRE, "agent");
    asm volatile("s_waitcnt vmcnt(0)" ::: "memory");
}
struct Params { const float* in[21]; float* out; unsigned char* ws; };

__global__ void __launch_bounds__(512) mega(Params p) {
    extern __shared__ __attribute__((aligned(16))) unsigned char lds[];
    cg::grid_group grid = cg::this_grid();
    LAS unsigned char* ldsl = (LAS unsigned char*)lds;
    unsigned char* ws = p.ws; float* out = p.out; unsigned char* outb = (unsigned char*)p.out;
    const int G = gridDim.x, bx = blockIdx.x, tid = threadIdx.x;
    float* MOD = (float*)(ws + WS_MOD); const float* bada = p.in[8];
    const f32x2* ROPE = (const f32x2*)(ws + WS_ROPE);
    bf16_t* H = (bf16_t*)(ws + WS_H);
    float* Gb = (float*)(outb + OB_G); bf16_t* QH = (bf16_t*)(outb + OB_QH); bf16_t* VH = (bf16_t*)(outb + OB_VH);
    bf16_t* GATE = (bf16_t*)(ws + WS_GATE); bf16_t* KPE = (bf16_t*)(ws + WS_KPE); float* CQKV = (float*)(ws + WS_CQKV);
    bf16_t* Qb = (bf16_t*)(ws + WS_Q); bf16_t* CQN = (bf16_t*)(ws + WS_CQN); bf16_t* QLAT = (bf16_t*)(ws + WS_QLAT); bf16_t* CKV = (bf16_t*)(ws + WS_CKV);
    bf16_t* U = (bf16_t*)(ws + WS_U); bf16_t* MIX = (bf16_t*)(ws + WS_MIX); float* DD = (float*)(ws + WS_DD); bf16_t* Sn = (bf16_t*)(ws + WS_S);
    bf16_t* KN = (bf16_t*)(ws + WS_KN); bf16_t* VT = (bf16_t*)(ws + WS_VT); bf16_t* FFH = (bf16_t*)(ws + WS_FFH);
    float* X = out + O_Y;
    pg8::StaticOrder S;
    volatile LAS unsigned* xst = (volatile LAS unsigned*)(ldsl + LDS_Q + 16);
    if (tid == 0) { xst[0] = 0u; xst[1] = 0u; }
    __syncthreads();
    const XcdBarrier xbar = xcd_barrier_post((unsigned*)(ws + WS_BAR), xst);

#ifdef FILLTEST
    for (size_t i = (size_t)bx * 512 + tid; i < 48791552; i += (size_t)G * 512) out[i] = 0.5f;
#endif
    if (PHMASK & 1) phase0(p.in, ws, lds);
#ifdef PROBE_P0
    gsync(grid);
    phase0(p.in, ws, lds);
#endif
    xcd_barrier(xbar);
#ifdef PROBE_SYNC
    for (int z = 0; z < 10; ++z) xcd_barrier(xbar);
#endif
    if (PHMASK & 2) adaln_rows<0>((float*)lds, p.in[0], p.in[1], MOD, bada, 0, 2048, H);
    xcd_barrier(xbar);
    if (PHMASK & 4) { EpiIn E{CQKV, QH, Gb, VH, GATE, KPE, ROPE, out + O_KPE_P, out + O_KPE_S, p.in[15]};
      S.init(MT, NINP, 2048, G, bx); pg8::gemm_phase(ldsl, pg8::Gemm{H, (const bf16_t*)(ws + WS_WIN), MT, NINP, 2048}, S, E); }
    if (G == 256 && bx >= (MT / 256) * (NINP / 256) - 5 * 256) {
        __syncthreads();
        transposes_range(p.in, ws, lds, TR_NIT - 128 * 64, TR_NIT, (bx - 106) * 8 + (tid >> 6), 150 * 8);
    }
    xcd_barrier(xbar);
    if (PHMASK & 8) latent_rows(CQKV, p.in[11], p.in[12], CQN, CKV, out + O_CKV_P, out + O_CKV_S);
    if (PHMASK & 16) for (int it = bx; it < NCHUNK; it += G) {
        if (it < NCHUNK_P) hgrn_a<64>(it, it >> 7, (it >> 10) * 8192 + (it & 127) * 64, 64, Gb, VH, U, DD, lds);
        else hgrn_a<32>(it, it - NCHUNK_P, MP + ((it - NCHUNK_P) >> 3) * 16, 16, Gb, VH, U, DD, lds);
    }
#ifdef PROBE_MISC
    xcd_barrier(xbar);
    latent_rows(CQKV, p.in[11], p.in[12], CQN, CKV, out + O_CKV_P, out + O_CKV_S);
    for (int it = bx; it < NCHUNK; it += G) {
        if (it < NCHUNK_P) hgrn_a<64>(it, it >> 7, (it >> 10) * 8192 + (it & 127) * 64, 64, Gb, VH, U, DD, lds);
        else hgrn_a<32>(it, it - NCHUNK_P, MP + ((it - NCHUNK_P) >> 3) * 16, 16, Gb, VH, U, DD, lds);
    }
#endif
    xcd_barrier(xbar);
    if (PHMASK & 32) { EpiQ E{Qb, ROPE}; S.init(MT, 1536, 512, G, bx); pg8::gemm_phase(ldsl, pg8::Gemm{CQN, (const bf16_t*)(ws + WS_WUQ), MT, 1536, 512}, S, E); }
    if (PHMASK & 32) { EpiPlain E{KN, 1024}; S.init(MP, 1024, 512, G, bx); pg8::gemm_phase(ldsl, pg8::Gemm{CKV, (const bf16_t*)(ws + WS_WUK), MP, 1024, 512}, S, E); }
    if (PHMASK & 32) { EpiPlain E{VT, 16384}; S.init(1024, MP, 512, G, bx); pg8::gemm_phase(ldsl, pg8::Gemm{(const bf16_t*)(ws + WS_WUV), CKV, 1024, MP, 512}, S, E); }
    if (PHMASK & 64) hgrn_b(U, DD, Sn, p.in[6], out + O_ST_P, out + O_ST_S);
#ifdef PROBE_MISC
    xcd_barrier(xbar);
    hgrn_b(U, DD, Sn, p.in[6], out + O_ST_P, out + O_ST_S);
#endif
    xcd_barrier(xbar);
    for (int p5rep = 0; p5rep < P5REPS; ++p5rep) {
    if (p5rep) xcd_barrier(xbar);
    if (PHMASK & 0x380) {
        unsigned* ctr = (unsigned*)(ws + WS_CTL) + p5rep * 64;
        volatile int* qslot = (volatile int*)(lds + LDS_Q);
        for (;;) {
            __syncthreads();
            if (tid == 0) *qslot = (int)__hip_atomic_fetch_add(ctr, 1u, __ATOMIC_RELAXED, __HIP_MEMORY_SCOPE_AGENT);
            __syncthreads();
            const int it = *qslot;
            if (it >= 256 + 512 + NCHUNK) break;
            const int pm_ = p5rep ? (P5MASK2) : 0x380;
            if (it < 256) { if (pm_ & 128) attn_sample_item(it >> 3, it & 7, Qb, (const bf16_t*)(ws + WS_WUKO), p.in[4], p.in[5], CKV, KPE, QLAT, (bf16_t*)(ws + WS_PO), (float*)(ws + WS_PML), ldsl); }
            else if (it < 256 + 512) { if (pm_ & 256) { const int j = it - 256, qb = 31 - (j >> 4), bh = j & 15; attn_prompt_item(bh >> 3, bh & 7, qb, Qb, KN, KPE, VT, MIX, ldsl); } }
            else if (pm_ & 512) { const int c = it - 768;
                if (c < NCHUNK_P) hgrn_c<64>(c, c >> 7, (c >> 10) * 8192 + (c & 127) * 64, 64, Gb, QH, VH, GATE, Sn, p.in[16], MIX, lds);
                else hgrn_c<32>(c, c - NCHUNK_P, MP + ((c - NCHUNK_P) >> 3) * 16, 16, Gb, QH, VH, GATE, Sn, p.in[16], MIX, lds); }
        }
    }
    }
    xcd_barrier(xbar);
    for (int ci = bx; ci < 256; ci += G) attn_sample_combine(ci >> 3, ci & 7, (const bf16_t*)(ws + WS_PO), (const float*)(ws + WS_PML), (const bf16_t*)(ws + WS_WUV), MIX, ldsl);
    xcd_barrier(xbar);
    if (PHMASK & 1024) { EpiRes E{p.in[0], p.in[1], X, MOD, bada, 4096, (float*)(ws + WS_CQKV)}; if (G == 256) S.init(MP, 2048, 2048, G, bx, 8, 64, 16); else S.init(MT, 2048, 2048, G, bx); pg8::gemm_phase(ldsl, pg8::Gemm{MIX, (const bf16_t*)(ws + WS_WOUT), MT, 2048, 2048}, S, E); }
    xcd_barrier(xbar);
    if (G == 256) {
        adaln_rows<8, 2>((float*)lds, X, p.in[1], MOD, bada, 6144, 8192, H, (const float*)(ws + WS_CQKV), 4096, X);
        xcd_barrier(xbar);
        if (bx < 64) { EpiRelu2 E{FFH + (size_t)MP * DFF}; S.init(MS, DFF, 2048, 64, bx); pg8::gemm_phase(ldsl, pg8::Gemm{H + (size_t)MP * DM, (const bf16_t*)(ws + WS_WFF1), MS, DFF, 2048}, S, E); }
        else adaln_rows<0, 1>((float*)lds, X, p.in[1], MOD, bada, 6144, 8192, H, nullptr, 0, nullptr, 64, 192);
        xcd_barrier(xbar);
        { EpiRelu2 E{FFH}; S.init(MP, DFF, 2048, G, bx); pg8::gemm_phase(ldsl, pg8::Gemm{H, (const bf16_t*)(ws + WS_WFF1), MP, DFF, 2048}, S, E); }
    } else {
        adaln_rows<0>((float*)lds, X, X + (size_t)MP * DM, MOD, bada, 6144, 8192, H);
        xcd_barrier(xbar);
        { EpiRelu2 E{FFH}; S.init(MT, DFF, 2048, G, bx); pg8::gemm_phase(ldsl, pg8::Gemm{H, (const bf16_t*)(ws + WS_WFF1), MT, DFF, 2048}, S, E); }
    }
    xcd_barrier(xbar);
    if (PHMASK & 8192) { EpiRes E{X, X + (size_t)MP * DM, X, MOD, bada, 10240, (float*)(ws + WS_H)}; if (G == 256) S.init(MP, 2048, DFF, G, bx, 16, 64, 16); else S.init(MT, 2048, DFF, G, bx); pg8::gemm_phase(ldsl, pg8::Gemm{FFH, (const bf16_t*)(ws + WS_WFF2), MT, 2048, DFF}, S, E); }
    xcd_barrier(xbar);
    if (PHMASK & 16384) { if (G == 256) final_rows<16>((float*)lds, X, p.in[20], (const float*)(ws + WS_H), MOD, bada); else final_rows<0>((float*)lds, X, p.in[20], nullptr, MOD, bada); }
}

extern "C" void kernel_launch(void* const* d_in, const int* in_sizes, int n_in, void* d_out, int out_size, void* d_ws, size_t ws_size, hipStream_t stream) {
    static int grid_blocks = 0;
    if (grid_blocks == 0) {
        if (n_in != 21 || ws_size < WS_TOTAL) { fprintf(stderr, "kernel_launch: unexpected n_in %d or workspace %zu < %zu\n", n_in, ws_size, (size_t)WS_END); grid_blocks = -1; return; }
        int dev = 0, cus = 0, per_cu = 0;
        hipGetDevice(&dev);
        hipDeviceGetAttribute(&cus, hipDeviceAttributeMultiprocessorCount, dev);
        if (hipFuncSetAttribute((const void*)mega, hipFuncAttributeMaxDynamicSharedMemorySize, LDS_BYTES) != hipSuccess) { fprintf(stderr, "kernel_launch: hipFuncSetAttribute failed\n"); }
        if (hipOccupancyMaxActiveBlocksPerMultiprocessor(&per_cu, (const void*)mega, 512, LDS_BYTES) != hipSuccess || per_cu < 1) { fprintf(stderr, "kernel_launch: occupancy query gave %d\n", per_cu); per_cu = 1; }
        (void)hipGetLastError();
        grid_blocks = cus * 1;
    }
    if (grid_blocks < 0) return;
    (void)hipMemsetAsync((char*)d_ws + WS_BAR, 0, XCD_BAR_WORDS * 4, stream);
    Params p{};
    for (int i = 0; i < 21; ++i) p.in[i] = (const float*)d_in[i];
    p.out = (float*)d_out; p.ws = (unsigned char*)d_ws;
    void* args[] = {&p};
    hipError_t e = hipLaunchCooperativeKernel((const void*)mega, dim3(grid_blocks), dim3(512), args, LDS_BYTES, stream);
    if (e != hipSuccess) fprintf(stderr, "cooperative launch failed: %s (grid %d)\n", hipGetErrorString(e), grid_blocks);
}
```

```cpp
#include <hip/hip_runtime.h>
#include <hip/hip_cooperative_groups.h>
#include <cstdio>
namespace cg = cooperative_groups;

#define LAS __attribute__((address_space(3)))
typedef unsigned short bf16_t;
typedef short bf16x8 __attribute__((ext_vector_type(8)));
typedef float f32x4 __attribute__((ext_vector_type(4)));
typedef float f32x2 __attribute__((ext_vector_type(2)));
typedef unsigned u32x4 __attribute__((ext_vector_type(4)));
typedef unsigned u32x2 __attribute__((ext_vector_type(2)));

constexpr int MP = 16384, MS = 512, MT = MP + MS;
constexpr int DM = 2048, NMOD = 12288, NINP = 5376, DFF = 8192;
constexpr float EPSN = 1e-6f;
constexpr float QSCALE = 0.07216878364870322f * 1.4426950408889634f;
constexpr int NCHUNK_P = 2048, NCHUNK = 2304;

constexpr size_t O_Y = 0, O_CKV_P = 34603008, O_KPE_P = 42991616, O_ST_P = 44040192, O_CKV_S = 44302336, O_KPE_S = 44564480, O_ST_S = 44597248;
constexpr size_t OB_G = 0, OB_QH = 69206016, OB_VH = 103809024;
constexpr size_t WS_CTL = 0, WS_MOD = 4096, WS_ZERO_BYTES = 4096 + 34 * 12288 * 4;
constexpr size_t WS_ROPE = 1675264;
constexpr size_t WS_WIN = WS_ROPE + 2097152;
constexpr size_t WS_WUQ = WS_WIN + (size_t)NINP * 2048 * 2;
constexpr size_t WS_WUK = WS_WUQ + 1536 * 512 * 2;
constexpr size_t WS_WUV = WS_WUK + 1024 * 512 * 2;
constexpr size_t WS_WUKO = WS_WUV + 1024 * 512 * 2;
constexpr size_t WS_WOUT = WS_WUKO + 1024 * 512 * 2;
constexpr size_t WS_WFF1 = WS_WOUT + 2048 * 2048 * 2;
constexpr size_t WS_WFF2 = WS_WFF1 + (size_t)8192 * 2048 * 2;
constexpr size_t WS_H = WS_WFF2 + (size_t)8192 * 2048 * 2;
constexpr size_t WS_KN = WS_H, WS_VT = WS_H + (size_t)MP * 1024 * 2;
constexpr size_t WS_ARENA = WS_H + (size_t)MT * 2048 * 2;
constexpr size_t WS_GATE = WS_ARENA;
constexpr size_t WS_KPE = WS_GATE + (size_t)MT * 1024 * 2;
constexpr size_t WS_CQKV = WS_KPE + (size_t)MT * 64 * 2;
constexpr size_t WS_Q = WS_CQKV;
constexpr size_t WS_CQN = WS_CQKV + (size_t)MT * 1024 * 4;
constexpr size_t WS_QLAT = WS_WIN;
constexpr size_t WS_PO = WS_CQKV + (size_t)MT * 1536 * 2;
constexpr size_t WS_PML = WS_PO + (size_t)256 * 8 * 16 * 512 * 2;
constexpr size_t WS_CKV = WS_CQN + (size_t)MT * 512 * 2;
constexpr size_t WS_U = WS_CKV + (size_t)MT * 512 * 2;
constexpr size_t WS_MIX = WS_U;
constexpr size_t WS_DD = WS_U + (size_t)NCHUNK * 16384 * 2;
constexpr size_t WS_S = WS_DD + (size_t)NCHUNK * 128 * 4;
constexpr size_t WS_END = WS_S + (size_t)NCHUNK * 16384 * 2;
constexpr size_t WS_FFH = WS_ARENA;
constexpr size_t WS_BAR = WS_END, WS_TOTAL = WS_END + 16384;
static_assert(WS_ARENA + (size_t)MT * DFF * 2 <= WS_END, "ffh overlay");
static_assert(WS_PML + 256 * 8 * 16 * 2 * 4 <= WS_CKV, "sample partials");
static_assert((size_t)32 * 8 * 16 * 576 * 2 <= (size_t)NINP * 2048 * 2, "qlat");

#ifndef P5MASK2
#define P5MASK2 0x380
#endif
#ifndef P5REPS
#define P5REPS 1
#endif
#ifndef PHMASK
#define PHMASK 0xFFFF
#endif
constexpr int LDS_BYTES = 131072 + 256;
constexpr int LDS_Q = 131072;

typedef __bf16 bf16v2 __attribute__((ext_vector_type(2)));
__device__ __forceinline__ unsigned pk2(float lo, float hi) { const f32x2 v = (f32x2){lo, hi}; const bf16v2 b = __builtin_convertvector(v, bf16v2); return __builtin_bit_cast(unsigned, b); }
__device__ __forceinline__ float bf2f(bf16_t b) { return __uint_as_float(((unsigned)b) << 16); }
__device__ __forceinline__ float wave_sum(float v) {
#pragma unroll
    for (int o = 1; o < 64; o <<= 1) v += __shfl_xor(v, o);
    return v;
}
__device__ __forceinline__ int ltid() { int t = threadIdx.x; asm volatile("" : "+v"(t)); return t; }
__device__ __forceinline__ float silu_f(float v) { return v * __builtin_amdgcn_rcpf(1.0f + __expf(-v)); }
__device__ __forceinline__ int row_pos(int r) { return r < MP ? (r & 8191) : 2048 + ((r - MP) & 15); }
__device__ __forceinline__ int row_ci(int r) { return r < MP ? (r >> 13) : 2 + ((r - MP) >> 4); }

namespace pg8 {
constexpr int BM = 256, BK = 64, HALF = 128, HTB = HALF * BK * 2, STAGE_BYTES = 8 * HTB, NXCD = 8, WGM = 8;
__host__ __device__ __forceinline__ int lds_byte(int r, int c) { const int st = (r >> 4) * 2 + (c >> 5), rr = r & 15, cc = c & 31, ob = rr * 64 + cc * 2; return st * 1024 + (ob ^ (((ob >> 9) & 1) << 5)); }
__host__ __device__ __forceinline__ void stage_rc(int b, int& R, int& C) { const int st = b / 1024, sb = b % 1024, swz = sb ^ (((sb >> 9) & 1) << 5); R = (st >> 1) * 16 + swz / 64; C = (st & 1) * 32 + (swz % 64) / 2; }
__host__ __device__ __forceinline__ int perm32(int rho) { const int n = rho >> 4, i = rho & 15; return 8 * (i >> 2) + 4 * n + (i & 3); }
struct Unit { int pm, pn, k0, nt, sl; };
struct Gemm { const bf16_t* A; const bf16_t* Bt; int M, N, K; };
struct StaticOrder {
    int nM, nN, nwg, G, c, ntK, ns, tail_pm0, ntail;
    __host__ __device__ void init(int M, int N, int K, int G_, int c_, int ns_ = 1, int tail_pm0_ = 0, int ntail_ = 0) { nM = M / BM; nN = N / BM; nwg = nM * nN; G = G_; c = c_; ntK = K / BK; ns = ns_; tail_pm0 = tail_pm0_; ntail = ntail_; }
    __host__ __device__ __forceinline__ void unit_of(int L, Unit& u) const {
        int wgid = L; { const int q = nwg / NXCD, r = nwg % NXCD, xcd = wgid % NXCD, off = wgid / NXCD; wgid = (xcd < r ? xcd * (q + 1) : r * (q + 1) + (xcd - r) * q) + off; }
        const int nig = WGM * nN, gid = wgid / nig, fm = gid * WGM, gsz = (nM - fm) < WGM ? (nM - fm) : WGM;
        u.pm = fm + ((wgid % nig) % gsz); u.pn = (wgid % nig) / gsz;
    }
    __host__ __device__ __forceinline__ bool next(int i, Unit& u) const {
        int L = i * G + c, k0 = 0, nt = ntK, sl = 0; bool ok = L < nwg;
        if (!ok) L = 0;
        unit_of(L, u);
        if (ns > 1) {
            const int rounds = nwg / G, idx = c / ns;
            const bool tail = (i == rounds) && (idx < ntail);
            if (tail) { nt = ntK / ns; k0 = (c % ns) * nt * BK; sl = 1; u.pm = tail_pm0 + idx / nN; u.pn = idx % nN; ok = true; }
        }
        u.k0 = k0; u.nt = nt; u.sl = sl; return ok;
    }
};
template <class Epi>
__device__ __forceinline__ void gemm_phase(LAS unsigned char* lds, const Gemm g, const StaticOrder& S, const Epi& E) {
    const int tid = ltid(), wid = __builtin_amdgcn_readfirstlane(tid >> 6), lane = tid & 63, wr = wid >> 2, wc = wid & 3, fr = lane & 15, fq = lane >> 4;
    const int K = g.K;
    unsigned voffA[2], voffB[2];
#pragma unroll
    for (int i = 0; i < 2; ++i) { int R, C; stage_rc(tid * 16 + i * 8192, R, C); const int Rb = Epi::PERM ? ((R & ~31) + perm32(R & 31)) : R; voffA[i] = (unsigned)(R * K + C) * 2u; voffB[i] = (unsigned)(Rb * K + C) * 2u; }
    const size_t kstep = (size_t)(BK * 2);
    const size_t hstep = (size_t)HALF * K * 2;
    const size_t tstep = 2 * hstep;
    const unsigned ldsw = (unsigned)wid * 1024u;
    const int aoff = lds_byte(wr * 64 + fr, fq * 8), boff = lds_byte(wc * 32 + fr, fq * 8);
#define PG8_SA(b, h) (((b) * 2 + (h)) * HTB)
#define PG8_SB(b, h) ((4 + (b) * 2 + (h)) * HTB)
#define PG8_STAGE(bufoff, gbase, voff) do { _Pragma("unroll") for (int _i = 0; _i < 2; ++_i) \
        __builtin_amdgcn_global_load_lds((const unsigned*)((const char*)(gbase) + (voff)[_i]), (LAS unsigned*)(lds + (bufoff) + ldsw + _i * 8192), 16, 0, 0); } while (0)
#define PG8_LDA(dst, b, h) do { _Pragma("unroll") for (int m = 0; m < 4; ++m) _Pragma("unroll") for (int k = 0; k < 2; ++k) dst[m][k] = *(const LAS bf16x8*)(lds + PG8_SA(b, h) + aoff + m * 2048 + k * 1024); } while (0)
#define PG8_LDB(dst, b, h) do { _Pragma("unroll") for (int n = 0; n < 2; ++n) _Pragma("unroll") for (int k = 0; k < 2; ++k) dst[n][k] = *(const LAS bf16x8*)(lds + PG8_SB(b, h) + boff + n * 2048 + k * 1024); } while (0)
#define PG8_MMA(ai, bj, At, Bt) do { __builtin_amdgcn_s_setprio(1); _Pragma("unroll") for (int m = 0; m < 4; ++m) _Pragma("unroll") for (int n = 0; n < 2; ++n) _Pragma("unroll") for (int k = 0; k < 2; ++k) \
        acc[ai][bj][m][n] = __builtin_amdgcn_mfma_f32_16x16x32_bf16(Bt[n][k], At[m][k], acc[ai][bj][m][n], 0, 0, 0); __builtin_amdgcn_s_setprio(0); } while (0)
#define PG8_WAIT_V(n) asm volatile("s_waitcnt vmcnt(" #n ")" ::: "memory")
#define PG8_WAIT_L(n) asm volatile("s_waitcnt lgkmcnt(" #n ")" ::: "memory")
#define PG8_BAR __builtin_amdgcn_s_barrier()
#define PG8_SCHED __builtin_amdgcn_sched_barrier(0)
    Unit cur, nxt; int ui = 0;
    if (!S.next(0, cur)) return;
    f32x4 acc[2][2][4][2];
#pragma unroll
    for (int a = 0; a < 2; ++a)
#pragma unroll
        for (int b = 0; b < 2; ++b)
#pragma unroll
            for (int m = 0; m < 4; ++m)
#pragma unroll
                for (int n = 0; n < 2; ++n) acc[a][b][m][n] = (f32x4){0.f, 0.f, 0.f, 0.f};
    bf16x8 At[4][2], B0[2][2], B1[2][2];
    const char* cA = (const char*)g.A + (size_t)cur.pm * tstep + (size_t)cur.k0 * 2; const char* cB = (const char*)g.Bt + (size_t)cur.pn * tstep + (size_t)cur.k0 * 2;
    PG8_STAGE(PG8_SB(0, 0), cB, voffB); PG8_STAGE(PG8_SA(0, 0), cA, voffA); PG8_STAGE(PG8_SB(0, 1), cB + hstep, voffB); PG8_STAGE(PG8_SA(0, 1), cA + hstep, voffA);
    if (wr == 1) PG8_BAR;
    PG8_WAIT_V(4); PG8_BAR;
    PG8_STAGE(PG8_SB(1, 0), cB + kstep, voffB); PG8_STAGE(PG8_SA(1, 0), cA + kstep, voffA); PG8_STAGE(PG8_SB(1, 1), cB + hstep + kstep, voffB);
    PG8_WAIT_V(6); PG8_BAR;
    for (;;) {
        const bool has_next = S.next(ui + 1, nxt);
        const char* nA = has_next ? (const char*)g.A + (size_t)nxt.pm * tstep + (size_t)nxt.k0 * 2 : cA; const char* nB = has_next ? (const char*)g.Bt + (size_t)nxt.pn * tstep + (size_t)nxt.k0 * 2 : cB;
        const int nt = cur.nt;
        for (int t = 0; t < nt; t += 2) {
            const bool last = (t == nt - 2);
            const char* a1 = cA + (size_t)(t + 1) * kstep;
            const char* a2 = last ? nA : cA + (size_t)(t + 2) * kstep; const char* b2 = last ? nB : cB + (size_t)(t + 2) * kstep;
            const char* a3 = a2 + kstep; const char* b3 = b2 + kstep;
            PG8_LDB(B0, 0, 0); PG8_SCHED; PG8_LDA(At, 0, 0); PG8_STAGE(PG8_SA(1, 1), a1 + hstep, voffA);
            PG8_WAIT_L(8); PG8_BAR; PG8_WAIT_L(0); PG8_MMA(0, 0, At, B0); PG8_BAR; PG8_SCHED;
            PG8_LDB(B1, 0, 1); PG8_STAGE(PG8_SB(0, 0), b2, voffB);
            PG8_BAR; PG8_WAIT_L(0); PG8_MMA(0, 1, At, B1); PG8_BAR;
            PG8_LDA(At, 0, 1); PG8_STAGE(PG8_SA(0, 0), a2, voffA);
            PG8_BAR; PG8_WAIT_L(0); PG8_MMA(1, 0, At, B0); PG8_BAR; PG8_SCHED;
            PG8_STAGE(PG8_SB(0, 1), b2 + hstep, voffB);
            PG8_WAIT_V(6); PG8_BAR; PG8_MMA(1, 1, At, B1); PG8_BAR;
            PG8_LDB(B0, 1, 0); PG8_SCHED; PG8_LDA(At, 1, 0); PG8_STAGE(PG8_SA(0, 1), a2 + hstep, voffA);
            PG8_WAIT_L(8); PG8_BAR; PG8_WAIT_L(0); PG8_MMA(0, 0, At, B0); PG8_BAR; PG8_SCHED;
            PG8_LDB(B1, 1, 1); PG8_STAGE(PG8_SB(1, 0), b3, voffB);
            PG8_BAR; PG8_WAIT_L(0); PG8_MMA(0, 1, At, B1); PG8_BAR;
            PG8_LDA(At, 1, 1); PG8_STAGE(PG8_SA(1, 0), a3, voffA);
            PG8_BAR; PG8_WAIT_L(0); PG8_MMA(1, 0, At, B0); PG8_BAR; PG8_SCHED;
            PG8_STAGE(PG8_SB(1, 1), b3 + hstep, voffB);
            PG8_WAIT_V(6); PG8_BAR; PG8_MMA(1, 1, At, B1); PG8_BAR;
        }
        E(acc, cur, wr, wc, fr, fq);
        if (!has_next) break;
#pragma unroll
        for (int a = 0; a < 2; ++a)
#pragma unroll
            for (int b = 0; b < 2; ++b)
#pragma unroll
                for (int m = 0; m < 4; ++m)
#pragma unroll
                    for (int n = 0; n < 2; ++n) acc[a][b][m][n] = (f32x4){0.f, 0.f, 0.f, 0.f};
        cur = nxt; cA = nA; cB = nB; ++ui;
    }
    PG8_WAIT_V(0);
    if (wr == 0) PG8_BAR;
    PG8_BAR;
#undef PG8_SA
#undef PG8_SB
#undef PG8_STAGE
#undef PG8_LDA
#undef PG8_LDB
#undef PG8_MMA
#undef PG8_WAIT_V
#undef PG8_WAIT_L
#undef PG8_BAR
#undef PG8_SCHED
}
}

template <class F>
__device__ __forceinline__ void epi_walk(const f32x4 (&acc)[2][2][4][2], const pg8::Unit& u, int wr, int wc, int fr, int fq, const F& f) {
    const int row0 = u.pm * 256 + wr * 64 + fr;
#pragma unroll
    for (int ai = 0; ai < 2; ++ai)
#pragma unroll
        for (int m = 0; m < 4; ++m) {
            const int r = row0 + ai * 128 + m * 16;
#pragma unroll
            for (int bj = 0; bj < 2; ++bj)
#pragma unroll
                for (int n = 0; n < 2; ++n) f(r, bj * 128 + wc * 32 + n * 16 + 4 * fq, acc[ai][bj][m][n]);
        }
}

struct EpiIn {
    static constexpr bool PERM = false;
    float* cqkv; bf16_t* qh; float* g; bf16_t* vh; bf16_t* gate; bf16_t* kpe; const f32x2* rope; float* okp; float* oks; const float* hglb;
    __device__ __forceinline__ void operator()(const f32x4 (&acc)[2][2][4][2], const pg8::Unit& u, int wr, int wc, int fr, int fq) const {
        const int pn = u.pn;
        epi_walk(acc, u, wr, wc, fr, fq, [&](int r, int cl, f32x4 v) {
            const int c = pn * 256 + cl;
            if (pn < 4) { *(f32x4*)(cqkv + (size_t)r * 1024 + c) = v; }
            else if (pn < 8) {
                const float sc = 0.08838834764831845f;
                u32x2 w; w.x = pk2(silu_f(v[0]) * sc, silu_f(v[1]) * sc); w.y = pk2(silu_f(v[2]) * sc, silu_f(v[3]) * sc);
                *(u32x2*)(qh + (size_t)r * 1024 + (c - 1024)) = w;
            } else if (pn < 12) {
                const int j = c - 2048;
                const f32x4 a0 = *(const f32x4*)(hglb + j), a1 = *(const f32x4*)(hglb + 1024 + j);
                f32x4 o;
#pragma unroll
                for (int e = 0; e < 4; ++e) { const float lb = __builtin_amdgcn_rcpf(1.0f + __expf(a1[e] - a0[e])); const float sg = __builtin_amdgcn_rcpf(1.0f + __expf(-v[e])); o[e] = __logf(lb + (1.0f - lb) * sg); }
                *(f32x4*)(g + (size_t)r * 1024 + j) = o;
            } else if (pn < 16) {
                u32x2 w; w.x = pk2(v[0], v[1]); w.y = pk2(v[2], v[3]);
                *(u32x2*)(vh + (size_t)r * 1024 + (c - 3072)) = w;
            } else if (pn < 20) {
                u32x2 w; w.x = pk2(silu_f(v[0]), silu_f(v[1])); w.y = pk2(silu_f(v[2]), silu_f(v[3]));
                *(u32x2*)(gate + (size_t)r * 1024 + (c - 4096)) = w;
            } else if (cl < 64) {
                const int i0 = cl >> 1, pos = row_pos(r);
                const f32x2 c0 = rope[pos * 32 + i0], c1 = rope[pos * 32 + i0 + 1];
                const float o1a = v[0] * c0.x - v[1] * c0.y, o2a = v[1] * c0.x + v[0] * c0.y;
                const float o1b = v[2] * c1.x - v[3] * c1.y, o2b = v[3] * c1.x + v[2] * c1.y;
                float* ob = r < MP ? okp + (size_t)r * 64 : oks + (size_t)(r - MP) * 64;
                *(f32x2*)(ob + i0) = (f32x2){o1a, o1b}; *(f32x2*)(ob + 32 + i0) = (f32x2){o2a, o2b};
                u32x2 w; w.x = pk2(o1a, o2a); w.y = pk2(o1b, o2b);
                *(u32x2*)(kpe + (size_t)r * 64 + cl) = w;
            }
        });
    }
};
struct EpiQ {
    static constexpr bool PERM = false;
    bf16_t* q; const f32x2* rope;
    __device__ __forceinline__ void operator()(const f32x4 (&acc)[2][2][4][2], const pg8::Unit& u, int wr, int wc, int fr, int fq) const {
        const int pn = u.pn;
        epi_walk(acc, u, wr, wc, fr, fq, [&](int r, int cl, f32x4 v) {
            const int c = pn * 256 + cl, h = c / 192, j = c - h * 192;
            u32x2 w;
            if (j < 128) { w.x = pk2(v[0] * QSCALE, v[1] * QSCALE); w.y = pk2(v[2] * QSCALE, v[3] * QSCALE); }
            else {
                const int i0 = (j - 128) >> 1, pos = row_pos(r);
                const f32x2 c0 = rope[pos * 32 + i0], c1 = rope[pos * 32 + i0 + 1];
                const float o1a = v[0] * c0.x - v[1] * c0.y, o2a = v[1] * c0.x + v[0] * c0.y;
                const float o1b = v[2] * c1.x - v[3] * c1.y, o2b = v[3] * c1.x + v[2] * c1.y;
                w.x = pk2(o1a * QSCALE, o2a * QSCALE); w.y = pk2(o1b * QSCALE, o2b * QSCALE);
            }
            *(u32x2*)(q + (size_t)r * 1536 + c) = w;
        });
    }
};
struct EpiPlain {
    static constexpr bool PERM = false;
    bf16_t* o; int ldc;
    __device__ __forceinline__ void operator()(const f32x4 (&acc)[2][2][4][2], const pg8::Unit& u, int wr, int wc, int fr, int fq) const {
        const int pn = u.pn;
        epi_walk(acc, u, wr, wc, fr, fq, [&](int r, int cl, f32x4 v) {
            u32x2 w; w.x = pk2(v[0], v[1]); w.y = pk2(v[2], v[3]);
            *(u32x2*)(o + (size_t)r * ldc + pn * 256 + cl) = w;
        });
    }
};
struct EpiRelu2 {
    static constexpr bool PERM = true;
    bf16_t* o;
    __device__ __forceinline__ void operator()(const f32x4 (&acc)[2][2][4][2], const pg8::Unit& u, int wr, int wc, int fr, int fq) const {
        const int row0 = u.pm * 256 + wr * 64 + fr, col0 = u.pn * 256 + wc * 32 + 8 * fq;
#pragma unroll
        for (int ai = 0; ai < 2; ++ai)
#pragma unroll
            for (int m = 0; m < 4; ++m) { bf16_t* rowp = o + (size_t)(row0 + ai * 128 + m * 16) * DFF + col0;
#pragma unroll
                for (int bj = 0; bj < 2; ++bj) { const f32x4 v0 = acc[ai][bj][m][0], v1 = acc[ai][bj][m][1]; float t[8];
#pragma unroll
                    for (int e = 0; e < 4; ++e) { const float a = fmaxf(v0[e], 0.f), b = fmaxf(v1[e], 0.f); t[e] = a * a; t[4 + e] = b * b; }
                    u32x4 w; w.x = pk2(t[0], t[1]); w.y = pk2(t[2], t[3]); w.z = pk2(t[4], t[5]); w.w = pk2(t[6], t[7]);
                    *(u32x4*)(rowp + bj * 128) = w; } }
    }
};
struct EpiRes {
    static constexpr bool PERM = false;
    const float* xa; const float* xb; float* xo; const float* mod; const float* bada; int goff; float* part;
    __device__ __forceinline__ void operator()(const f32x4 (&acc)[2][2][4][2], const pg8::Unit& u, int wr, int wc, int fr, int fq) const {
        const int pn = u.pn, sl = u.sl, sidx = u.k0 / (u.nt * 64);
        epi_walk(acc, u, wr, wc, fr, fq, [&](int r, int cl, f32x4 v) {
            const int c = pn * 256 + cl;
            if (sl) { *(f32x4*)(part + ((size_t)sidx * MS + (r - MP)) * DM + c) = v; }
            else {
                const int ci = row_ci(r);
                const float* xi = r < MP ? xa + (size_t)r * DM : xb + (size_t)(r - MP) * DM;
                const f32x4 gt = *(const f32x4*)(mod + (size_t)ci * NMOD + goff + c) + *(const f32x4*)(bada + goff + c);
                const f32x4 x = *(const f32x4*)(xi + c);
                *(f32x4*)(xo + (size_t)r * DM + c) = x + gt * v;
            }
        });
    }
};

__device__ __forceinline__ int map_row(int mat, int n) {
    if (mat == 0) { if (n < 1024) return n; if (n < 1088) { const int i = n - 1024; return 5120 + (i < 32 ? 2 * i : 2 * (i - 32) + 1); } return n - 64; }
    if (mat == 1) { const int h = n / 192, j = n - h * 192; if (j < 128) return n; const int i = j - 128; return h * 192 + 128 + (i < 32 ? 2 * i : 2 * (i - 32) + 1); }
    return n;
}
struct TrItem { const float* W; bf16_t* WT; int K, N, mat, item; };
__device__ __forceinline__ void tr_load(const TrItem& t, int lane, float (&tv)[32]) {
    const int nblk = t.N / 32, kb = t.item / nblk, nb = t.item % nblk, k0 = 64 * kb, n0 = 32 * nb;
#pragma unroll
    for (int i = 0; i < 32; ++i) { const int kk = 2 * i + (lane >> 5); tv[i] = t.W[(size_t)(k0 + kk) * t.N + n0 + (lane & 31)]; }
}
__device__ __forceinline__ void tr_store(const TrItem& t, int lane, const float (&tv)[32], LAS float* scr) {
    const int nblk = t.N / 32, kb = t.item / nblk, nb = t.item % nblk, k0 = 64 * kb, n0 = 32 * nb;
#pragma unroll
    for (int i = 0; i < 32; ++i) { const int kk = 2 * i + (lane >> 5); scr[kk * 33 + (lane & 31)] = tv[i]; }
    asm volatile("s_waitcnt lgkmcnt(0)" ::: "memory");
    const int c = lane & 7;
#pragma unroll
    for (int j = 0; j < 4; ++j) { const int n = (lane >> 3) + 8 * j; const LAS float* sp = scr + (8 * c) * 33 + n;
        u32x4 o; o.x = pk2(sp[0 * 33], sp[1 * 33]); o.y = pk2(sp[2 * 33], sp[3 * 33]); o.z = pk2(sp[4 * 33], sp[5 * 33]); o.w = pk2(sp[6 * 33], sp[7 * 33]);
        *(u32x4*)(t.WT + (size_t)map_row(t.mat, n0 + n) * t.K + k0 + 8 * c) = o; }
    asm volatile("s_waitcnt lgkmcnt(0)" ::: "memory");
}
__device__ __forceinline__ TrItem tr_item(const float* const* in, unsigned char* ws, int it) {
    constexpr int I0 = 32 * 162, I1 = 8 * 48, I2 = 8 * 32, I3 = 8 * 32, I4 = 32 * 64, I5 = 32 * 256;
    int r = it;
    if (r < I0) return TrItem{in[9], (bf16_t*)(ws + WS_WIN), 2048, 5184, 0, r}; r -= I0;
    if (r < I1) return TrItem{in[10], (bf16_t*)(ws + WS_WUQ), 512, 1536, 1, r}; r -= I1;
    if (r < I2) return TrItem{in[13], (bf16_t*)(ws + WS_WUK), 512, 1024, 2, r}; r -= I2;
    if (r < I3) return TrItem{in[14], (bf16_t*)(ws + WS_WUV), 512, 1024, 2, r}; r -= I3;
    if (r < I4) return TrItem{in[17], (bf16_t*)(ws + WS_WOUT), 2048, 2048, 2, r}; r -= I4;
    if (r < I5) return TrItem{in[18], (bf16_t*)(ws + WS_WFF1), 2048, 8192, 2, r}; r -= I5;
    return TrItem{in[19], (bf16_t*)(ws + WS_WFF2), 8192, 2048, 2, r};
}
constexpr int TR_NIT = 32 * 162 + 8 * 48 + 8 * 32 + 8 * 32 + 32 * 64 + 32 * 256 + 128 * 64;
__device__ __forceinline__ void transposes_range(const float* const* in, unsigned char* ws, unsigned char* lds, int i0, int i1, int gw, int NGW) {
    const int tid = ltid(), lane = tid & 63, wave = tid >> 6;
    LAS float* scr = (LAS float*)lds + wave * (64 * 33);
    float ta[32], tb[32];
    int it = i0 + gw;
    if (it < i1) tr_load(tr_item(in, ws, it), lane, ta);
    for (; it < i1; it += 2 * NGW) {
        if (it + NGW < i1) tr_load(tr_item(in, ws, it + NGW), lane, tb);
        tr_store(tr_item(in, ws, it), lane, ta, scr);
        if (it + NGW < i1) {
            if (it + 2 * NGW < i1) tr_load(tr_item(in, ws, it + 2 * NGW), lane, ta);
            tr_store(tr_item(in, ws, it + NGW), lane, tb, scr);
        }
    }
}
__device__ __forceinline__ void phase0(const float* const* in, unsigned char* ws, unsigned char* lds) {
    const int tid = ltid(), lane = tid & 63, wave = tid >> 6, G = gridDim.x, bx = blockIdx.x;
    {
        float* sl = (float*)lds;
        float* MOD = (float*)(ws + WS_MOD);
        const float* wada = in[7];
        if (bx == 0 && tid < 2) __hip_atomic_store((unsigned*)(ws + WS_CTL) + tid * 64, 0u, __ATOMIC_RELAXED, __HIP_MEMORY_SCOPE_AGENT);
        for (int it = bx; it < 192; it += G) {
            const int grp = tid >> 6, col = it * 64 + lane;
            float acc[34];
#pragma unroll
            for (int r = 0; r < 34; ++r) acc[r] = 0.f;
            for (int pass = 0; pass < 4; ++pass) {
                __syncthreads();
                for (int e = tid; e < 34 * 512; e += 512) { const int r = e >> 9, kl = e & 511, kg = (kl >> 6) * 256 + pass * 64 + (kl & 63);
                    const float cv = r < 2 ? in[2][r * DM + kg] : in[3][(r - 2) * DM + kg]; sl[e] = silu_f(cv); }
                __syncthreads();
                const int k0 = grp * 256 + pass * 64;
                for (int kk = 0; kk < 64; kk += 8) {
                    float w[8];
#pragma unroll
                    for (int j = 0; j < 8; ++j) w[j] = wada[(size_t)(k0 + kk + j) * NMOD + col];
#pragma unroll
                    for (int r = 0; r < 34; ++r) { const f32x4 sv = *(const f32x4*)(sl + r * 512 + grp * 64 + kk), sw = *(const f32x4*)(sl + r * 512 + grp * 64 + kk + 4);
                        acc[r] += (sv[0] * w[0] + sv[1] * w[1] + sv[2] * w[2] + sv[3] * w[3]) + (sw[0] * w[4] + sw[1] * w[5] + sw[2] * w[6] + sw[3] * w[7]); }
                }
            }
            __syncthreads();
            float* red = (float*)lds;
#pragma unroll
            for (int r = 0; r < 34; ++r) red[(grp * 34 + r) * 64 + lane] = acc[r];
            __syncthreads();
            for (int e = tid; e < 34 * 64; e += 512) { const int r = e >> 6, c = e & 63; float sum = 0.f;
#pragma unroll
                for (int g2 = 0; g2 < 8; ++g2) sum += red[(g2 * 34 + r) * 64 + c];
                MOD[(size_t)r * NMOD + it * 64 + c] = sum; }
            __syncthreads();
        }
    }
    transposes_range(in, ws, lds, 0, (G == 256) ? TR_NIT - 128 * 64 : TR_NIT, bx * 8 + wave, G * 8);
    const int gt = bx * 512 + tid, NGT = G * 512;
    { u32x4* z = (u32x4*)(ws + WS_WIN + (size_t)5184 * 2048 * 2); for (int i = gt; i < 192 * 2048 * 2 / 16; i += NGT) z[i] = (u32x4){0u, 0u, 0u, 0u}; }
    { const f32x4* s = (const f32x4*)in[13]; u32x2* d = (u32x2*)(ws + WS_WUKO); for (int i = gt; i < 512 * 1024 / 4; i += NGT) { const f32x4 v = s[i]; u32x2 w; w.x = pk2(v[0], v[1]); w.y = pk2(v[2], v[3]); d[i] = w; } }
    { f32x2* rp = (f32x2*)(ws + WS_ROPE);
      for (int i = gt; i < 8192 * 32; i += NGT) { const int pos = i >> 5, k = i & 31;
          const double invf = exp(-9.210340371976184 * (double)k / 32.0); const double t = (double)pos * invf * 0.15915494309189535; const float fr = (float)(t - rint(t));
          rp[i] = (f32x2){__builtin_amdgcn_cosf(fr), __builtin_amdgcn_sinf(fr)}; } }
}

template <int NSL, int PARTS = 3>
__device__ __forceinline__ void adaln_rows(float* xch, const float* xa, const float* xb, const float* mod, const float* bada, int off_sh, int off_sc, bf16_t* H,
                                           const float* part = nullptr, int off_gt = 0, float* xout = nullptr, int wg0 = 0, int nwg = 0) {
    const int tid_ = ltid(), lane = tid_ & 63;
    const int nw_ = nwg ? nwg : (int)gridDim.x, gw = ((int)blockIdx.x - wg0) * 8 + (tid_ >> 6), NGW = nw_ * 8;
    if (PARTS & 1) {
        f32x4 v[8], nx[8];
#pragma unroll
        for (int j = 0; j < 8; ++j) v[j] = *(const f32x4*)(xa + (size_t)gw * DM + 4 * lane + 256 * j);
        for (int row = gw; row < MP; row += NGW) {
            const int nrow = row + NGW;
            if (nrow < MP) {
#pragma unroll
                for (int j = 0; j < 8; ++j) nx[j] = *(const f32x4*)(xa + (size_t)nrow * DM + 4 * lane + 256 * j); }
            const int ci = row >> 13;
            float ss = 0.f;
#pragma unroll
            for (int j = 0; j < 8; ++j) ss += (v[j][0] * v[j][0] + v[j][1] * v[j][1]) + (v[j][2] * v[j][2] + v[j][3] * v[j][3]);
            const float* mr = mod + (size_t)ci * NMOD;
            const float rstd = 1.0f / sqrtf(wave_sum(ss) * (1.0f / DM) + EPSN);
#pragma unroll
            for (int j = 0; j < 8; ++j) { const int c = 4 * lane + 256 * j;
                const f32x4 scj = *(const f32x4*)(mr + off_sc + c) + *(const f32x4*)(bada + off_sc + c) + 1.0f;
                const f32x4 shj = *(const f32x4*)(mr + off_sh + c) + *(const f32x4*)(bada + off_sh + c);
                const f32x4 h = v[j] * rstd * scj + shj;
                u32x2 w; w.x = pk2(h[0], h[1]); w.y = pk2(h[2], h[3]);
                *(u32x2*)(H + (size_t)row * DM + c) = w; v[j] = nx[j]; }
        }
    }
    __builtin_amdgcn_sched_barrier(0);
    if (PARTS & 2) {
        const int wave = tid_ >> 6, q4 = wave & 3;
        for (int rp = blockIdx.x; rp < MS / 2; rp += gridDim.x) {
            const int sr = 2 * rp + (wave >> 2), row = MP + sr; const float* xr = xb + (size_t)sr * DM; const float* mr = mod + (size_t)row_ci(row) * NMOD;
            f32x4 v[2]; float ss = 0.f;
#pragma unroll
            for (int j = 0; j < 2; ++j) { const int c = q4 * 512 + 4 * lane + 256 * j; v[j] = *(const f32x4*)(xr + c);
                if (NSL > 0) { f32x4 a = (f32x4){0.f, 0.f, 0.f, 0.f};
#pragma unroll
                    for (int s2 = 0; s2 < NSL; ++s2) a += *(const f32x4*)(part + ((size_t)s2 * MS + sr) * DM + c);
                    const f32x4 gt = *(const f32x4*)(mr + off_gt + c) + *(const f32x4*)(bada + off_gt + c);
                    v[j] += gt * a; *(f32x4*)(xout + (size_t)row * DM + c) = v[j]; }
                ss += (v[j][0] * v[j][0] + v[j][1] * v[j][1]) + (v[j][2] * v[j][2] + v[j][3] * v[j][3]); }
            ss = wave_sum(ss);
            __syncthreads();
            if (lane == 0) xch[wave] = ss;
            __syncthreads();
            const int w0 = wave & 4;
            const float rstd = 1.0f / sqrtf(((xch[w0] + xch[w0 + 1]) + (xch[w0 + 2] + xch[w0 + 3])) * (1.0f / DM) + EPSN);
#pragma unroll
            for (int j = 0; j < 2; ++j) { const int c = q4 * 512 + 4 * lane + 256 * j;
                const f32x4 sc = *(const f32x4*)(mr + off_sc + c) + *(const f32x4*)(bada + off_sc + c) + 1.0f;
                const f32x4 sh = *(const f32x4*)(mr + off_sh + c) + *(const f32x4*)(bada + off_sh + c);
                const f32x4 h = v[j] * rstd * sc + sh;
                u32x2 w; w.x = pk2(h[0], h[1]); w.y = pk2(h[2], h[3]);
                *(u32x2*)(H + (size_t)row * DM + c) = w; }
        }
    }
}
template <int NSL>
__device__ __forceinline__ void final_rows(float* xch, float* X, const float* gf, const float* part, const float* mod, const float* bada) {
    const int tid_ = ltid(), lane = tid_ & 63, gw = blockIdx.x * 8 + (tid_ >> 6), NGW = gridDim.x * 8;
    {
        f32x4 v[8], nx[8], gn[8];
#pragma unroll
        for (int j = 0; j < 8; ++j) { gn[j] = *(const f32x4*)(gf + 4 * lane + 256 * j); v[j] = *(const f32x4*)(X + (size_t)gw * DM + 4 * lane + 256 * j); }
        for (int row = gw; row < MP; row += NGW) {
            const int nrow = row + NGW;
            if (nrow < MP) {
#pragma unroll
                for (int j = 0; j < 8; ++j) nx[j] = *(const f32x4*)(X + (size_t)nrow * DM + 4 * lane + 256 * j); }
            float ss = 0.f;
#pragma unroll
            for (int j = 0; j < 8; ++j) ss += (v[j][0] * v[j][0] + v[j][1] * v[j][1]) + (v[j][2] * v[j][2] + v[j][3] * v[j][3]);
            const float rstd = 1.0f / sqrtf(wave_sum(ss) * (1.0f / DM) + EPSN);
#pragma unroll
            for (int j = 0; j < 8; ++j) { *(f32x4*)(X + (size_t)row * DM + 4 * lane + 256 * j) = v[j] * rstd * gn[j]; v[j] = nx[j]; }
        }
    }
    __builtin_amdgcn_sched_barrier(0);
    {
        const int wave = tid_ >> 6, q4 = wave & 3;
        for (int rp = blockIdx.x; rp < MS / 2; rp += gridDim.x) {
            const int sr = 2 * rp + (wave >> 2), row = MP + sr;
            f32x4 v[2]; float ss = 0.f;
#pragma unroll
            for (int j = 0; j < 2; ++j) { const int c = q4 * 512 + 4 * lane + 256 * j; v[j] = *(const f32x4*)(X + (size_t)row * DM + c);
                if (NSL > 0) { f32x4 a = (f32x4){0.f, 0.f, 0.f, 0.f};
#pragma unroll
                    for (int s2 = 0; s2 < NSL; ++s2) a += *(const f32x4*)(part + ((size_t)s2 * MS + sr) * DM + c);
                    const f32x4 gt = *(const f32x4*)(mod + (size_t)row_ci(row) * NMOD + 10240 + c) + *(const f32x4*)(bada + 10240 + c);
                    v[j] += gt * a; }
                ss += (v[j][0] * v[j][0] + v[j][1] * v[j][1]) + (v[j][2] * v[j][2] + v[j][3] * v[j][3]); }
            ss = wave_sum(ss);
            __syncthreads();
            if (lane == 0) xch[wave] = ss;
            __syncthreads();
            const int w0 = wave & 4;
            const float rstd = 1.0f / sqrtf(((xch[w0] + xch[w0 + 1]) + (xch[w0 + 2] + xch[w0 + 3])) * (1.0f / DM) + EPSN);
#pragma unroll
            for (int j = 0; j < 2; ++j) { const int c = q4 * 512 + 4 * lane + 256 * j; *(f32x4*)(X + (size_t)row * DM + c) = v[j] * rstd * *(const f32x4*)(gf + c); }
        }
    }
}
__device__ __forceinline__ void latent_rows(const float* cqkv, const float* gq, const float* gkv, bf16_t* cqn, bf16_t* ckv, float* ockp, float* ocks) {
    const int tid_ = ltid(), lane = tid_ & 63, gw = blockIdx.x * 8 + (tid_ >> 6), NGW = gridDim.x * 8;
    for (int row = gw; row < MT; row += NGW) {
        const float* sr = cqkv + (size_t)row * 1024;
        f32x4 a[2], b[2]; float sa = 0.f, sb = 0.f;
#pragma unroll
        for (int j = 0; j < 2; ++j) { a[j] = *(const f32x4*)(sr + 4 * lane + 256 * j); b[j] = *(const f32x4*)(sr + 512 + 4 * lane + 256 * j);
            sa += (a[j][0] * a[j][0] + a[j][1] * a[j][1]) + (a[j][2] * a[j][2] + a[j][3] * a[j][3]); sb += (b[j][0] * b[j][0] + b[j][1] * b[j][1]) + (b[j][2] * b[j][2] + b[j][3] * b[j][3]); }
        const float ra = 1.0f / sqrtf(wave_sum(sa) * (1.0f / 512) + EPSN), rb = 1.0f / sqrtf(wave_sum(sb) * (1.0f / 512) + EPSN);
        float* oc = row < MP ? ockp + (size_t)row * 512 : ocks + (size_t)(row - MP) * 512;
#pragma unroll
        for (int j = 0; j < 2; ++j) { const int c = 4 * lane + 256 * j;
            const f32x4 qa = a[j] * ra * *(const f32x4*)(gq + c), kb = b[j] * rb * *(const f32x4*)(gkv + c);
            u32x2 w; w.x = pk2(qa[0], qa[1]); w.y = pk2(qa[2], qa[3]); *(u32x2*)(cqn + (size_t)row * 512 + c) = w;
            *(f32x4*)(oc + c) = kb;
            w.x = pk2(kb[0], kb[1]); w.y = pk2(kb[2], kb[3]); *(u32x2*)(ckv + (size_t)row * 512 + c) = w; }
    }
}

template <int L>
__device__ __forceinline__ void hgrn_cumsum(const float* G, int row0, int h, int lreal, float* Bs, float* tot, float (&gv)[L / 4]) {
    constexpr int SEG = L / 4;
    const int tid = ltid(), k = tid & 127, seg = tid >> 7;
    float run = 0.f;
#pragma unroll
    for (int i = 0; i < SEG; ++i) { const int t = seg * SEG + i; gv[i] = t < lreal ? G[(size_t)(row0 + t) * 1024 + h * 128 + k] : 0.f; }
#pragma unroll
    for (int i = 0; i < SEG; ++i) { run += gv[i]; Bs[(seg * SEG + i) * 128 + k] = run; }
    tot[seg * 128 + k] = run;
    __syncthreads();
    float off = 0.f;
#pragma unroll
    for (int s2 = 0; s2 < 3; ++s2) if (s2 < seg) off += tot[s2 * 128 + k];
#pragma unroll
    for (int i = 0; i < SEG; ++i) Bs[(seg * SEG + i) * 128 + k] += off;
    __syncthreads();
}
template <int L>
__device__ __forceinline__ void hgrn_a(int it, int bh, int row0, int lreal, const float* G, const bf16_t* VH, bf16_t* U, float* DD, unsigned char* lds) {
    constexpr int SEG = L / 4, ST = L + 8;
    const int tid = ltid(), lane = tid & 63, wave = tid >> 6, k = tid & 127, seg = tid >> 7, h = bh & 7;
    float* Bs = (float*)lds; float* tot = (float*)(lds + 32768);
    bf16_t* KDT = (bf16_t*)(lds + 34816); bf16_t* VT = (bf16_t*)(lds + 34816 + 128 * ST * 2);
    float gv[SEG]; bf16_t vraw[SEG];
#pragma unroll
    for (int i = 0; i < SEG; ++i) { const int s = seg * SEG + i; vraw[i] = s < lreal ? VH[(size_t)(row0 + s) * 1024 + h * 128 + k] : (bf16_t)0; }
    hgrn_cumsum<L>(G, row0, h, lreal, Bs, tot, gv);
    const float blast = Bs[(L - 1) * 128 + k];
#pragma unroll
    for (int i = 0; i < SEG; ++i) { const int s = seg * SEG + i;
        const float kd = (1.0f - __expf(gv[i])) * __expf(blast - Bs[s * 128 + k]);
        KDT[k * ST + s] = (bf16_t)(pk2(kd, 0.f) & 0xffffu);
        VT[k * ST + s] = vraw[i]; }
    if (seg == 0) DD[(size_t)it * 128 + k] = __expf(blast);
    __syncthreads();
    const int r = lane & 15, g = lane >> 4;
#pragma unroll
    for (int vt = 0; vt < 8; ++vt) {
        f32x4 acc = (f32x4){0.f, 0.f, 0.f, 0.f};
#pragma unroll
        for (int ks = 0; ks < L / 32; ++ks) {
            const bf16x8 a = *(const bf16x8*)(KDT + (16 * wave + r) * ST + 32 * ks + 8 * g);
            const bf16x8 b = *(const bf16x8*)(VT + (16 * vt + r) * ST + 32 * ks + 8 * g);
            acc = __builtin_amdgcn_mfma_f32_16x16x32_bf16(a, b, acc, 0, 0, 0);
        }
        bf16_t* up = U + (size_t)it * 16384 + (16 * wave + 4 * g) * 128 + 16 * vt + r;
        const unsigned p01 = pk2(acc[0], acc[1]), p23 = pk2(acc[2], acc[3]);
        up[0] = (bf16_t)(p01 & 0xffffu); up[128] = (bf16_t)(p01 >> 16); up[256] = (bf16_t)(p23 & 0xffffu); up[384] = (bf16_t)(p23 >> 16);
    }
    __syncthreads();
}
__device__ __forceinline__ void hgrn_b(const bf16_t* U, const float* DD, bf16_t* Sn, const float* st0, float* ostp, float* osts) {
    const int gt = blockIdx.x * 512 + ltid(), NGT = gridDim.x * 512;
#ifdef HB_TEST
    for (int e = gt; e < 16 * 16384; e += NGT) { const int bh = e >> 14, kv = e & 16383; ostp[e] = bf2f(U[((size_t)bh * 128 + 127) * 16384 + kv]); }
    for (int e = gt; e < 256 * 16384; e += NGT) { const int bh = e >> 14, kv = e & 16383; osts[e] = bf2f(U[((size_t)2048 + bh) * 16384 + kv]) + DD[((size_t)2048 + bh) * 128 + (kv >> 7)]; }
    return;
#endif
    for (int e = gt; e < 8 * 16384; e += NGT) {
        const int e1 = e + 8 * 16384;
        const int bh0 = e >> 14, kv0 = e & 16383, bh1 = e1 >> 14, kv1 = e1 & 16383;
        float S0 = 0.f, S1 = 0.f;
        const bf16_t* up0 = U + (size_t)bh0 * 128 * 16384 + kv0; const float* dp0 = DD + (size_t)bh0 * 128 * 128 + (kv0 >> 7); bf16_t* sp0 = Sn + (size_t)bh0 * 128 * 16384 + kv0;
        const bf16_t* up1 = U + (size_t)bh1 * 128 * 16384 + kv1; const float* dp1 = DD + (size_t)bh1 * 128 * 128 + (kv1 >> 7); bf16_t* sp1 = Sn + (size_t)bh1 * 128 * 16384 + kv1;
        for (int n0 = 0; n0 < 128; n0 += 16) {
            bf16_t ur0[16], ur1[16]; float dr0[16], dr1[16];
#pragma unroll
            for (int j = 0; j < 16; ++j) { ur0[j] = up0[(size_t)(n0 + j) * 16384]; dr0[j] = dp0[(n0 + j) * 128]; ur1[j] = up1[(size_t)(n0 + j) * 16384]; dr1[j] = dp1[(n0 + j) * 128]; }
#pragma unroll
            for (int j = 0; j < 16; ++j) { sp0[(size_t)(n0 + j) * 16384] = (bf16_t)(pk2(S0, 0.f) & 0xffffu); S0 = dr0[j] * S0 + bf2f(ur0[j]);
                                           sp1[(size_t)(n0 + j) * 16384] = (bf16_t)(pk2(S1, 0.f) & 0xffffu); S1 = dr1[j] * S1 + bf2f(ur1[j]); }
        }
        ostp[e] = S0; ostp[e1] = S1;
    }
    for (int e = gt; e < 256 * 16384; e += 8 * NGT) {
        float s0[8], dd[8]; bf16_t uu[8];
#pragma unroll
        for (int j = 0; j < 8; ++j) { const int ej = e + j * NGT; const int bh = ej >> 14, kv = ej & 16383; const size_t it = 2048 + bh;
            const bool ok = ej < 256 * 16384;
            s0[j] = ok ? st0[ej] : 0.f; dd[j] = ok ? DD[it * 128 + (kv >> 7)] : 0.f; uu[j] = ok ? U[it * 16384 + kv] : (bf16_t)0; }
#pragma unroll
        for (int j = 0; j < 8; ++j) { const int ej = e + j * NGT; const int bh = ej >> 14, kv = ej & 16383; const size_t it = 2048 + bh;
            if (ej < 256 * 16384) { Sn[it * 16384 + kv] = (bf16_t)(pk2(s0[j], 0.f) & 0xffffu); osts[ej] = dd[j] * s0[j] + bf2f(uu[j]); } }
    }
}
template <int L>
__device__ __forceinline__ void hgrn_c(int it, int bh, int row0, int lreal, const float* G, const bf16_t* QH, const bf16_t* VH, const bf16_t* GATE, const bf16_t* Sn, const float* ghg, bf16_t* MIX, unsigned char* lds) {
    constexpr int SEG = L / 4, VS = L + 8;
    const int tid = ltid(), lane = tid & 63, wave = tid >> 6, k = tid & 127, seg = tid >> 7, h = bh & 7;
    float* Bs = (float*)lds; float* tot = (float*)(lds + 32768);
    bf16_t* QT = (bf16_t*)(lds + 34816); bf16_t* KT = (bf16_t*)(lds + 52224); bf16_t* VT = (bf16_t*)(lds + 69632); bf16_t* ST = (bf16_t*)(lds + 88064);
    float gv[SEG];
    bf16_t qraw[SEG], vraw[SEG]; u32x4 sraw[4];
#pragma unroll
    for (int i = 0; i < SEG; ++i) { const int s = seg * SEG + i;
        qraw[i] = s < lreal ? QH[(size_t)(row0 + s) * 1024 + h * 128 + k] : (bf16_t)0;
        vraw[i] = s < lreal ? VH[(size_t)(row0 + s) * 1024 + h * 128 + k] : (bf16_t)0; }
#pragma unroll
    for (int i = 0; i < 4; ++i) sraw[i] = *(const u32x4*)(Sn + (size_t)it * 16384 + (size_t)k * 128 + (seg + 4 * i) * 8);
    hgrn_cumsum<L>(G, row0, h, lreal, Bs, tot, gv);
#pragma unroll
    for (int i = 0; i < SEG; ++i) { const int s = seg * SEG + i; const float bs = Bs[s * 128 + k];
        QT[s * 136 + k] = (bf16_t)(pk2(bf2f(qraw[i]) * __expf(bs), 0.f) & 0xffffu);
        KT[s * 136 + k] = (bf16_t)(pk2((1.0f - __expf(gv[i])) * __expf(-bs), 0.f) & 0xffffu);
        VT[k * VS + s] = vraw[i]; }
#pragma unroll
    for (int i = 0; i < 4; ++i) { const int kk = k, v0 = (seg + 4 * i) * 8;
        const unsigned w4[4] = {sraw[i].x, sraw[i].y, sraw[i].z, sraw[i].w};
#pragma unroll
        for (int e = 0; e < 4; ++e) { ST[(v0 + 2 * e) * 136 + kk] = (bf16_t)(w4[e] & 0xffffu); ST[(v0 + 2 * e + 1) * 136 + kk] = (bf16_t)(w4[e] >> 16); } }
    __syncthreads();
    const int tt = wave;
    if (tt * 16 < lreal) {
        const int r = lane & 15, g = lane >> 4;
        bf16x8 qf[4];
#pragma unroll
        for (int ks = 0; ks < 4; ++ks) qf[ks] = *(const bf16x8*)(QT + (16 * tt + r) * 136 + 32 * ks + 8 * g);
        bf16x8 pf[L / 32];
#pragma unroll
        for (int p = 0; p < L / 32; ++p) {
            unsigned pw[4];
#pragma unroll
            for (int hs = 0; hs < 2; ++hs) { const int st = 2 * p + hs;
                f32x4 acc = (f32x4){0.f, 0.f, 0.f, 0.f};
                if (st <= tt) {
#pragma unroll
                    for (int ks = 0; ks < 4; ++ks) { const bf16x8 a = *(const bf16x8*)(KT + (16 * st + r) * 136 + 32 * ks + 8 * g); acc = __builtin_amdgcn_mfma_f32_16x16x32_bf16(a, qf[ks], acc, 0, 0, 0); }
#pragma unroll
                    for (int e = 0; e < 4; ++e) if (16 * st + 4 * g + e > 16 * tt + r) acc[e] = 0.f;
                }
                pw[2 * hs] = pk2(acc[0], acc[1]); pw[2 * hs + 1] = pk2(acc[2], acc[3]); }
            u32x4 t4 = (u32x4){pw[0], pw[1], pw[2], pw[3]};
            pf[p] = __builtin_bit_cast(bf16x8, t4);
        }
        f32x4 o[8]; float ss = 0.f;
#pragma unroll
        for (int vt = 0; vt < 8; ++vt) {
            f32x4 acc = (f32x4){0.f, 0.f, 0.f, 0.f};
#pragma unroll
            for (int p = 0; p < L / 32; ++p) if (2 * p <= tt) {
                const u32x2 lo = *(const u32x2*)(VT + (16 * vt + r) * VS + 32 * p + 4 * g), hi = *(const u32x2*)(VT + (16 * vt + r) * VS + 32 * p + 16 + 4 * g);
                u32x4 t4 = (u32x4){lo.x, lo.y, hi.x, hi.y};
                acc = __builtin_amdgcn_mfma_f32_16x16x32_bf16(__builtin_bit_cast(bf16x8, t4), pf[p], acc, 0, 0, 0); }
#pragma unroll
            for (int ks = 0; ks < 4; ++ks) { const bf16x8 a = *(const bf16x8*)(ST + (16 * vt + r) * 136 + 32 * ks + 8 * g); acc = __builtin_amdgcn_mfma_f32_16x16x32_bf16(a, qf[ks], acc, 0, 0, 0); }
            o[vt] = acc; ss += (acc[0] * acc[0] + acc[1] * acc[1]) + (acc[2] * acc[2] + acc[3] * acc[3]);
        }
        ss += __shfl_xor(ss, 16); ss += __shfl_xor(ss, 32);
        const float rstd = 1.0f / sqrtf(ss * (1.0f / 128) + EPSN);
        const int t = 16 * tt + r;
        if (t < lreal) {
            const size_t row = (size_t)(row0 + t);
#pragma unroll
            for (int vt = 0; vt < 8; ++vt) { const int v0 = 16 * vt + 4 * g;
                const u32x2 gw2 = *(const u32x2*)(GATE + row * 1024 + h * 128 + v0); const f32x4 gh = *(const f32x4*)(ghg + v0);
                const float g0 = __uint_as_float(gw2.x << 16), g1 = __uint_as_float(gw2.x & 0xffff0000u), g2 = __uint_as_float(gw2.y << 16), g3 = __uint_as_float(gw2.y & 0xffff0000u);
                u32x2 w; w.x = pk2(o[vt][0] * rstd * gh[0] * g0, o[vt][1] * rstd * gh[1] * g1); w.y = pk2(o[vt][2] * rstd * gh[2] * g2, o[vt][3] * rstd * gh[3] * g3);
                *(u32x2*)(MIX + row * 2048 + 1024 + h * 128 + v0) = w; }
        }
    }
    __syncthreads();
}

template <int NKS, int NDT, int KSTR, int VSTR, bool QG, int NQF>
__device__ __forceinline__ void attn_step(const bf16x8 (&qf)[NQF], const bf16_t* qg, f32x4 (&o)[NDT], float& m, float& l, const LAS unsigned char* kimg, const LAS unsigned char* vimg, int lane, bool half_valid) {
    const int r = lane & 15, g = lane >> 4;
    f32x4 s0 = (f32x4){0.f, 0.f, 0.f, 0.f}, s1 = (f32x4){0.f, 0.f, 0.f, 0.f};
    const LAS unsigned char* kp = kimg + r * (KSTR * 2) + g * 16;
    if constexpr (QG) {
#pragma unroll 1
        for (int ks3 = 0; ks3 < NKS; ks3 += 3) {
#pragma unroll
            for (int k2 = 0; k2 < 3; ++k2) { const int ks = ks3 + k2;
                const bf16x8 a0 = *(const LAS bf16x8*)(kp + ks * 64), a1 = *(const LAS bf16x8*)(kp + 16 * KSTR * 2 + ks * 64);
                const bf16x8 qv = *(const bf16x8*)(qg + 32 * ks);
                s0 = __builtin_amdgcn_mfma_f32_16x16x32_bf16(a0, qv, s0, 0, 0, 0);
                s1 = __builtin_amdgcn_mfma_f32_16x16x32_bf16(a1, qv, s1, 0, 0, 0); }
        }
    } else {
#pragma unroll
        for (int ks = 0; ks < NKS; ++ks) {
            const bf16x8 a0 = *(const LAS bf16x8*)(kp + ks * 64), a1 = *(const LAS bf16x8*)(kp + 16 * KSTR * 2 + ks * 64);
            s0 = __builtin_amdgcn_mfma_f32_16x16x32_bf16(a0, qf[ks], s0, 0, 0, 0);
            s1 = __builtin_amdgcn_mfma_f32_16x16x32_bf16(a1, qf[ks], s1, 0, 0, 0);
        }
    }
    if (half_valid) s1 = (f32x4){-INFINITY, -INFINITY, -INFINITY, -INFINITY};
    float mx = fmaxf(fmaxf(fmaxf(s0[0], s0[1]), fmaxf(s0[2], s0[3])), fmaxf(fmaxf(s1[0], s1[1]), fmaxf(s1[2], s1[3])));
    mx = fmaxf(mx, __shfl_xor(mx, 16)); mx = fmaxf(mx, __shfl_xor(mx, 32));
    const float mn = fmaxf(m, mx), alpha = exp2f(m - mn);
    f32x4 p0, p1;
#pragma unroll
    for (int e = 0; e < 4; ++e) { p0[e] = exp2f(s0[e] - mn); p1[e] = exp2f(s1[e] - mn); }
    float ls = (p0[0] + p0[1]) + (p0[2] + p0[3]) + (p1[0] + p1[1]) + (p1[2] + p1[3]);
    ls += __shfl_xor(ls, 16); ls += __shfl_xor(ls, 32);
    l = l * alpha + ls; m = mn;
    u32x4 pw = (u32x4){pk2(p0[0], p0[1]), pk2(p0[2], p0[3]), pk2(p1[0], p1[1]), pk2(p1[2], p1[3])};
    const bf16x8 pf = __builtin_bit_cast(bf16x8, pw);
    const LAS unsigned char* vp = vimg + r * (VSTR * 2) + g * 8;
#pragma unroll
    for (int dt = 0; dt < NDT; ++dt) {
        const u32x2 lo = *(const LAS u32x2*)(vp + dt * 16 * VSTR * 2), hi = *(const LAS u32x2*)(vp + dt * 16 * VSTR * 2 + 32);
        u32x4 t4 = (u32x4){lo.x, lo.y, hi.x, hi.y};
        o[dt] = __builtin_amdgcn_mfma_f32_16x16x32_bf16(__builtin_bit_cast(bf16x8, t4), pf, o[dt] * alpha, 0, 0, 0);
        if ((dt & 3) == 3) __builtin_amdgcn_sched_barrier(0);
    }
}

typedef float f32x16 __attribute__((ext_vector_type(16)));
__device__ __forceinline__ void attn_prompt_item(int b, int h, int qb, const bf16_t* Q, const bf16_t* KN, const bf16_t* KPE, const bf16_t* VT, bf16_t* MIX, LAS unsigned char* lds) {
    constexpr int KSTR = 200, VSTR = 72, KIMG = 64 * KSTR * 2, BUFB = KIMG + 128 * VSTR * 2;
    const int tid = ltid(), lane = tid & 63, wave = tid >> 6, r = lane & 31, hh = lane >> 5;
    const int nkt = 4 * qb + 4, nkw = 4 * qb + (wave >> 1) + 1;
    const size_t qrow = (size_t)b * 8192 + 256 * qb + 32 * wave + r;
    bf16x8 qf[12];
#pragma unroll
    for (int ks = 0; ks < 12; ++ks) qf[ks] = *(const bf16x8*)(Q + qrow * 1536 + h * 192 + 16 * ks + 8 * hh);
    f32x16 o[4];
#pragma unroll
    for (int dt = 0; dt < 4; ++dt)
#pragma unroll
        for (int i = 0; i < 16; ++i) o[dt][i] = 0.f;
    float m = -INFINITY, l = 0.f;
    const bf16_t* kn_src = KN + ((size_t)b * 8192 + (tid >> 4)) * 1024 + h * 128 + 8 * (tid & 15);
    const bf16_t* kp_src = KPE + ((size_t)b * 8192 + (tid >> 3)) * 64 + 8 * (tid & 7);
    const bf16_t* vt_src = VT + ((size_t)h * 128 + (tid >> 3)) * 16384 + (size_t)b * 8192 + 8 * (tid & 7);
    const int wk = (tid >> 4) * (KSTR * 2) + (tid & 15) * 16, wp = (tid >> 3) * (KSTR * 2) + 256 + (tid & 7) * 16, wv = KIMG + (tid >> 3) * (VSTR * 2) + ((tid & 7) >> 1) * 32 + ((tid & 7) & 1) * 8;
    u32x4 ak0, ak1, ap, av0, av1;
#define AT_LOAD(S_, t) do { S_##k0 = *(const u32x4*)(kn_src + (size_t)(t) * 64 * 1024); S_##k1 = *(const u32x4*)(kn_src + ((size_t)(t) * 64 + 32) * 1024); S_##p = *(const u32x4*)(kp_src + (size_t)(t) * 64 * 64); \
        S_##v0 = *(const u32x4*)(vt_src + (t) * 64); S_##v1 = *(const u32x4*)(vt_src + (size_t)64 * 16384 + (t) * 64); } while (0)
#define AT_STORE(S_, t) do { const int bo_ = ((t) & 1) * BUFB; *(LAS u32x4*)(lds + bo_ + wk) = S_##k0; *(LAS u32x4*)(lds + bo_ + wk + 32 * KSTR * 2) = S_##k1; *(LAS u32x4*)(lds + bo_ + wp) = S_##p; \
        *(LAS u32x2*)(lds + bo_ + wv) = (u32x2){S_##v0.x, S_##v0.y}; *(LAS u32x2*)(lds + bo_ + wv + 16) = (u32x2){S_##v0.z, S_##v0.w}; \
        *(LAS u32x2*)(lds + bo_ + wv + 64 * VSTR * 2) = (u32x2){S_##v1.x, S_##v1.y}; *(LAS u32x2*)(lds + bo_ + wv + 64 * VSTR * 2 + 16) = (u32x2){S_##v1.z, S_##v1.w}; } while (0)
#define AT_SUB(kt, u) do { \
            const LAS unsigned char* kimg = lds + ((kt) & 1) * BUFB + (u) * 32 * KSTR * 2; const LAS unsigned char* vimg = lds + ((kt) & 1) * BUFB + KIMG + (u) * 64; \
            f32x16 sc; \
            _Pragma("unroll") for (int i = 0; i < 16; ++i) sc[i] = 0.f; \
            const LAS unsigned char* kp = kimg + r * (KSTR * 2) + hh * 16; \
            _Pragma("unroll") for (int ks = 0; ks < 12; ++ks) { const bf16x8 a = *(const LAS bf16x8*)(kp + ks * 32); sc = __builtin_amdgcn_mfma_f32_32x32x16_bf16(a, qf[ks], sc, 0, 0, 0); } \
            float mx = sc[0]; \
            _Pragma("unroll") for (int i = 1; i < 16; ++i) mx = fmaxf(mx, sc[i]); \
            mx = fmaxf(mx, __shfl_xor(mx, 32)); \
            const float mn = fmaxf(m, mx), alpha = __builtin_amdgcn_exp2f(m - mn); \
            float ls = 0.f; \
            _Pragma("unroll") for (int i = 0; i < 16; ++i) { sc[i] = __builtin_amdgcn_exp2f(sc[i] - mn); ls += sc[i]; } \
            ls += __shfl_xor(ls, 32); \
            l = l * alpha + ls; m = mn; \
            bf16x8 pf[2]; \
            _Pragma("unroll") for (int s2 = 0; s2 < 2; ++s2) { u32x4 pw = (u32x4){pk2(sc[8 * s2], sc[8 * s2 + 1]), pk2(sc[8 * s2 + 2], sc[8 * s2 + 3]), pk2(sc[8 * s2 + 4], sc[8 * s2 + 5]), pk2(sc[8 * s2 + 6], sc[8 * s2 + 7])}; pf[s2] = __builtin_bit_cast(bf16x8, pw); } \
            const LAS unsigned char* vp = vimg + r * (VSTR * 2) + hh * 16; \
            _Pragma("unroll") for (int dt = 0; dt < 4; ++dt) { \
                f32x16 acc = o[dt] * alpha; \
                _Pragma("unroll") for (int s2 = 0; s2 < 2; ++s2) { \
                    const bf16x8 va = *(const LAS bf16x8*)(vp + dt * 32 * VSTR * 2 + s2 * 32); \
                    acc = __builtin_amdgcn_mfma_f32_32x32x16_bf16(va, pf[s2], acc, 0, 0, 0); } \
                o[dt] = acc; } } while (0)
#define AT_COMPUTE(kt) do { if ((kt) < nkw) { AT_SUB(kt, 0); AT_SUB(kt, 1); } } while (0)
    AT_LOAD(a, 0); AT_STORE(a, 0); AT_LOAD(a, 1);
    __syncthreads();
    for (int kt = 0; kt < nkt; ++kt) {
        AT_COMPUTE(kt);
        if (kt + 1 < nkt) AT_STORE(a, kt + 1);
        if (kt + 2 < nkt) AT_LOAD(a, kt + 2);
        __syncthreads();
    }
#undef AT_LOAD
#undef AT_STORE
#undef AT_SUB
#undef AT_COMPUTE
    const float inv = 1.0f / l;
#pragma unroll
    for (int dt = 0; dt < 4; ++dt)
#pragma unroll
        for (int ig = 0; ig < 4; ++ig) { u32x2 w; w.x = pk2(o[dt][4 * ig] * inv, o[dt][4 * ig + 1] * inv); w.y = pk2(o[dt][4 * ig + 2] * inv, o[dt][4 * ig + 3] * inv);
            *(u32x2*)(MIX + qrow * 2048 + h * 128 + 32 * dt + 8 * ig + 4 * hh) = w; }
}

constexpr int NSPL = 8;
__device__ __forceinline__ void attn_sample_item(int b, int sp, const bf16_t* Q, const bf16_t* WUKO, const float* cckv, const float* ckpe, const bf16_t* CKV, const bf16_t* KPE, bf16_t* QLAT, bf16_t* PO, float* PML, LAS unsigned char* lds) {
    constexpr int KSTR = 584, VSTR = 36;
    const int tid = ltid(), lane = tid & 63, h = tid >> 6, r = lane & 15, g = lane >> 4;
    LAS unsigned char* kimg = lds; LAS unsigned char* vimg = lds + 32 * KSTR * 2;
    const size_t qrow0 = (size_t)MP + (size_t)b * 16;
    bf16_t* ql = QLAT + ((size_t)b * 8 + h) * 16 * 576;
    {
        bf16x8 aq[4];
#pragma unroll
        for (int ks = 0; ks < 4; ++ks) aq[ks] = *(const bf16x8*)(Q + (qrow0 + r) * 1536 + h * 192 + 32 * ks + 8 * g);
#pragma unroll 8
        for (int ct = 0; ct < 32; ++ct) {
            f32x4 acc = (f32x4){0.f, 0.f, 0.f, 0.f};
#pragma unroll
            for (int ks = 0; ks < 4; ++ks) { const bf16x8 bw = *(const bf16x8*)(WUKO + (size_t)(16 * ct + r) * 1024 + h * 128 + 32 * ks + 8 * g); acc = __builtin_amdgcn_mfma_f32_16x16x32_bf16(bw, aq[ks], acc, 0, 0, 0); }
            u32x2 w; w.x = pk2(acc[0], acc[1]); w.y = pk2(acc[2], acc[3]);
            *(u32x2*)(ql + r * 576 + 16 * ct + 4 * g) = w;
        }
#pragma unroll
        for (int i = 0; i < 2; ++i) { const int pc = lane + 64 * i, qq = pc >> 3, cc = pc & 7;
            *(u32x4*)(ql + qq * 576 + 512 + 8 * cc) = *(const u32x4*)(Q + (qrow0 + qq) * 1536 + h * 192 + 128 + 8 * cc); }
    }
    __threadfence(); __syncthreads();
    const bf16_t* qg = ql + r * 576 + 8 * g;
    f32x4 o[32];
#pragma unroll
    for (int dt = 0; dt < 32; ++dt) o[dt] = (f32x4){0.f, 0.f, 0.f, 0.f};
    float m = -INFINITY, l = 0.f;
    const float* cb = cckv + (size_t)b * 2048 * 512; const float* pb = ckpe + (size_t)b * 2048 * 64;
    const int kt0 = sp * 8, kt1 = (sp == NSPL - 1) ? 65 : kt0 + 8;
    for (int kt = kt0; kt < kt1; ++kt) {
        __syncthreads();
        if (kt < 64) {
            const int c = tid;
            float v[32];
#pragma unroll
            for (int kk = 0; kk < 32; ++kk) v[kk] = cb[(size_t)(32 * kt + kk) * 512 + c];
            const int key = tid >> 4, i4 = (tid & 15) * 4; const f32x4 pv = *(const f32x4*)(pb + (size_t)(32 * kt + key) * 64 + i4);
#pragma unroll
            for (int kk = 0; kk < 32; kk += 2) {
                const unsigned pw = pk2(v[kk], v[kk + 1]);
                *(LAS bf16_t*)(kimg + kk * (KSTR * 2) + c * 2) = (bf16_t)(pw & 0xffffu);
                *(LAS bf16_t*)(kimg + (kk + 1) * (KSTR * 2) + c * 2) = (bf16_t)(pw >> 16);
                *(LAS unsigned*)(vimg + c * (VSTR * 2) + kk * 2) = pw;
            }
#pragma unroll
            for (int e = 0; e < 4; ++e) { const int i = i4 + e, pi = i < 32 ? 2 * i : 2 * (i - 32) + 1;
                *(LAS bf16_t*)(kimg + key * (KSTR * 2) + (512 + pi) * 2) = (bf16_t)(pk2(pv[e], 0.f) & 0xffffu); }
        } else {
            const int c = tid;
#pragma unroll 4
            for (int kk = 0; kk < 32; kk += 2) {
                unsigned pw = 0u;
                if (kk < 16) { const unsigned a = CKV[(qrow0 + kk) * 512 + c], bb = CKV[(qrow0 + kk + 1) * 512 + c]; pw = a | (bb << 16); }
                *(LAS bf16_t*)(kimg + kk * (KSTR * 2) + c * 2) = (bf16_t)(pw & 0xffffu);
                *(LAS bf16_t*)(kimg + (kk + 1) * (KSTR * 2) + c * 2) = (bf16_t)(pw >> 16);
                *(LAS unsigned*)(vimg + c * (VSTR * 2) + kk * 2) = pw;
            }
            { const int key = tid >> 4, i4 = (tid & 15) * 4;
              u32x2 w = (u32x2){0u, 0u}; if (key < 16) w = *(const u32x2*)(KPE + (qrow0 + key) * 64 + i4);
              *(LAS u32x2*)(kimg + key * (KSTR * 2) + (512 + i4) * 2) = w; }
        }
        bf16x8 qv[18];
#pragma unroll
        for (int ks = 0; ks < 18; ++ks) qv[ks] = *(const bf16x8*)(qg + 32 * ks);
        __syncthreads();
        attn_step<18, 32, KSTR, VSTR, false, 18>(qv, nullptr, o, m, l, kimg, vimg, lane, kt == 64);
    }
    const float inv = 1.0f / l;
    const size_t pi = (((size_t)b * NSPL + sp) * 8 + h) * 16 + r;
    bf16_t* po = PO + pi * 512 + 4 * g;
#pragma unroll
    for (int dt = 0; dt < 32; ++dt) { u32x2 w; w.x = pk2(o[dt][0] * inv, o[dt][1] * inv); w.y = pk2(o[dt][2] * inv, o[dt][3] * inv); *(u32x2*)(po + 16 * dt) = w; }
    if (g == 0) *(f32x2*)(PML + pi * 2) = (f32x2){m, l};
    __syncthreads();
}
__device__ __forceinline__ void attn_sample_combine(int b, int h, const bf16_t* PO, const float* PML, const bf16_t* WUVT, bf16_t* MIX, LAS unsigned char* lds) {
    const int tid = ltid(), lane = tid & 63, wave = tid >> 6, r = lane & 15, g = lane >> 4;
    float ms[NSPL], cs[NSPL], M = -INFINITY, L = 0.f;
#pragma unroll
    for (int sp = 0; sp < NSPL; ++sp) { const f32x2 ml = *(const f32x2*)(PML + ((((size_t)b * NSPL + sp) * 8 + h) * 16 + r) * 2); ms[sp] = ml.x; cs[sp] = ml.y; M = fmaxf(M, ml.x); }
#pragma unroll
    for (int sp = 0; sp < NSPL; ++sp) { cs[sp] *= __builtin_amdgcn_exp2f(ms[sp] - M); L += cs[sp]; }
    const float invL = 1.0f / L;
#pragma unroll
    for (int sp = 0; sp < NSPL; ++sp) cs[sp] *= invL;
#pragma unroll
    for (int s2 = 0; s2 < 2; ++s2) { const int s = 2 * wave + s2;
        f32x4 a0 = (f32x4){0.f, 0.f, 0.f, 0.f}, a1 = (f32x4){0.f, 0.f, 0.f, 0.f};
#pragma unroll
        for (int sp = 0; sp < NSPL; ++sp) {
            const bf16_t* po = PO + ((((size_t)b * NSPL + sp) * 8 + h) * 16 + r) * 512 + 32 * s + 4 * g;
            const u32x2 w0 = *(const u32x2*)po, w1 = *(const u32x2*)(po + 16);
            a0 += cs[sp] * (f32x4){__uint_as_float(w0.x << 16), __uint_as_float(w0.x & 0xffff0000u), __uint_as_float(w0.y << 16), __uint_as_float(w0.y & 0xffff0000u)};
            a1 += cs[sp] * (f32x4){__uint_as_float(w1.x << 16), __uint_as_float(w1.x & 0xffff0000u), __uint_as_float(w1.y << 16), __uint_as_float(w1.y & 0xffff0000u)};
        }
        *(LAS u32x4*)(lds + (s * 64 + lane) * 16) = (u32x4){pk2(a0[0], a0[1]), pk2(a0[2], a0[3]), pk2(a1[0], a1[1]), pk2(a1[2], a1[3])};
    }
    __syncthreads();
    const size_t qrow0 = (size_t)MP + (size_t)b * 16;
    const int dt = wave;
    f32x4 acc = (f32x4){0.f, 0.f, 0.f, 0.f};
    const bf16_t* wp = WUVT + (size_t)(h * 128 + 16 * dt + r) * 512 + 4 * g;
#pragma unroll
    for (int s = 0; s < 16; ++s) {
        const u32x2 lo = *(const u32x2*)(wp + 32 * s), hi = *(const u32x2*)(wp + 32 * s + 16);
        u32x4 t4 = (u32x4){lo.x, lo.y, hi.x, hi.y};
        const bf16x8 pf = *(const LAS bf16x8*)(lds + (s * 64 + lane) * 16);
        acc = __builtin_amdgcn_mfma_f32_16x16x32_bf16(__builtin_bit_cast(bf16x8, t4), pf, acc, 0, 0, 0);
    }
    u32x2 w; w.x = pk2(acc[0], acc[1]); w.y = pk2(acc[2], acc[3]);
    *(u32x2*)(MIX + (qrow0 + r) * 2048 + h * 128 + 16 * dt + 4 * g) = w;
    __syncthreads();
}

#define XB_TMO      128
#define XB_XCNT(j)  (256  + 64 * (j))
#define XB_XSUB(j)  (1280 + 64 * (j))
#define XB_XGEN(j)  (2304 + 64 * (j))
#define XB_TOP      3328
#define XB_TOPGEN   3392
#define XCD_BAR_WORDS 3456
#define XB_SPIN_CAP (1u << 18)
__device__ __forceinline__ unsigned xb_ld(unsigned* p)              { return __hip_atomic_load(p, __ATOMIC_RELAXED, __HIP_MEMORY_SCOPE_AGENT); }
__device__ __forceinline__ unsigned xb_add(unsigned* p, unsigned v) { return __hip_atomic_fetch_add(p, v, __ATOMIC_RELAXED, __HIP_MEMORY_SCOPE_AGENT); }
__device__ __forceinline__ unsigned xb_xcc_id() { return (unsigned)__builtin_amdgcn_s_getreg((3 << 11) | 20) & 0xFu; }
#define XB_SPIN(cond, bar) do { unsigned _sp = 0; while (cond) { __builtin_amdgcn_s_sleep(1); \
    if ((++_sp & 255u) == 0u) { if (xb_ld(&(bar)[XB_TMO])) break; if (_sp > XB_SPIN_CAP) { atomicAdd(&(bar)[XB_TMO], 1u); break; } } } } while (0)
struct XcdBarrier { unsigned* bar; unsigned x; volatile LAS unsigned* st; };
__device__ __forceinline__ XcdBarrier xcd_barrier_post(unsigned* bar, volatile LAS unsigned* st) {
    XcdBarrier b; b.bar = bar; b.x = xb_xcc_id(); b.st = st;
    if (threadIdx.x == 0) (void)xb_add(&bar[XB_XCNT(b.x)], 1u);
    return b;
}
__device__ __forceinline__ void xcd_barrier_complete(unsigned* bar, unsigned x, unsigned& nloc, unsigned& nx) {
    const unsigned G = gridDim.x * gridDim.y * gridDim.z;
    unsigned sum, cnt, mine, sp = 0u;
    for (;;) {
        sum = 0u; cnt = 0u; mine = 0u;
#pragma unroll
        for (unsigned j = 0; j < 16; ++j) { const unsigned c = xb_ld(&bar[XB_XCNT(j)]); sum += c; cnt += (c > 0u) ? 1u : 0u; mine = (j == x) ? c : mine; }
        if (sum == G) break;
        __builtin_amdgcn_s_sleep(1);
        if ((++sp & 255u) == 0u) { if (xb_ld(&bar[XB_TMO])) break; if (sp > XB_SPIN_CAP) { atomicAdd(&bar[XB_TMO], 1u); break; } }
    }
    nloc = mine > 0u ? mine : 1u; nx = cnt > 0u ? cnt : 1u;
}
__device__ __forceinline__ void xcd_barrier(const XcdBarrier& b) {
    asm volatile("s_waitcnt vmcnt(0)" ::: "memory");
    __syncthreads();
    if (threadIdx.x == 0) {
        unsigned* bar = b.bar;
        __builtin_amdgcn_s_waitcnt(0);
        unsigned nloc = b.st[0], nx = b.st[1];
        if (nloc == 0u) { xcd_barrier_complete(bar, b.x, nloc, nx); b.st[0] = nloc; b.st[1] = nx; }
        const unsigned old = xb_add(&bar[XB_XSUB(b.x)], 1u);
        const unsigned gen = old / nloc;
        if (old + 1u == (gen + 1u) * nloc) {
            __builtin_amdgcn_fence(__ATOMIC_RELEASE, "agent");
            asm volatile("s_waitcnt vmcnt(0)" ::: "memory");
            const unsigned og = xb_add(&bar[XB_TOP], 1u);
            const unsigned tg = og / nx;
            if (og + 1u == (tg + 1u) * nx) xb_add(&bar[XB_TOPGEN], 1u);
            else XB_SPIN(xb_ld(&bar[XB_TOPGEN]) == tg, bar);
            __builtin_amdgcn_fence(__ATOMIC_ACQUIRE, "agent");
            xb_add(&bar[XB_XGEN(b.x)], 1u);
            asm volatile("s_waitcnt vmcnt(0)" ::: "memory");
        } else {
            XB_SPIN(xb_ld(&bar[XB_XGEN(b.x)]) == gen, bar);
            __builtin_amdgcn_fence(__ATOMIC_ACQUIRE, "agent");
            asm volatile("s_waitcnt vmcnt(0)" ::: "memory");
        }
    }
    __syncthreads();
}

__device__ __forceinline__ void gsync(cg::grid_group& grid) {
    asm volatile("s_waitcnt vmcnt(0) lgkmcnt(0)" ::: "memory");
    grid.sync();
    __builtin_amdgcn_fence(__ATOMIC_ACQUIRE, "agent");
    asm volatile("s_waitcnt vmcnt(0)" ::: "memory");
}
struct Params { const float* in[21]; float* out; unsigned char* ws; };

__global__ void __launch_bounds__(512) mega(Params p) {
    extern __shared__ __attribute__((aligned(16))) unsigned char lds[];
    cg::grid_group grid = cg::this_grid();
    LAS unsigned char* ldsl = (LAS unsigned char*)lds;
    unsigned char* ws = p.ws; float* out = p.out; unsigned char* outb = (unsigned char*)p.out;
    const int G = gridDim.x, bx = blockIdx.x, tid = threadIdx.x;
    float* MOD = (float*)(ws + WS_MOD); const float* bada = p.in[8];
    const f32x2* ROPE = (const f32x2*)(ws + WS_ROPE);
    bf16_t* H = (bf16_t*)(ws + WS_H);
    float* Gb = (float*)(outb + OB_G); bf16_t* QH = (bf16_t*)(outb + OB_QH); bf16_t* VH = (bf16_t*)(outb + OB_VH);
    bf16_t* GATE = (bf16_t*)(ws + WS_GATE); bf16_t* KPE = (bf16_t*)(ws + WS_KPE); float* CQKV = (float*)(ws + WS_CQKV);
    bf16_t* Qb = (bf16_t*)(ws + WS_Q); bf16_t* CQN = (bf16_t*)(ws + WS_CQN); bf16_t* QLAT = (bf16_t*)(ws + WS_QLAT); bf16_t* CKV = (bf16_t*)(ws + WS_CKV);
    bf16_t* U = (bf16_t*)(ws + WS_U); bf16_t* MIX = (bf16_t*)(ws + WS_MIX); float* DD = (float*)(ws + WS_DD); bf16_t* Sn = (bf16_t*)(ws + WS_S);
    bf16_t* KN = (bf16_t*)(ws + WS_KN); bf16_t* VT = (bf16_t*)(ws + WS_VT); bf16_t* FFH = (bf16_t*)(ws + WS_FFH);
    float* X = out + O_Y;
    pg8::StaticOrder S;
    volatile LAS unsigned* xst = (volatile LAS unsigned*)(ldsl + LDS_Q + 16);
    if (tid == 0) { xst[0] = 0u; xst[1] = 0u; }
    __syncthreads();
    const XcdBarrier xbar = xcd_barrier_post((unsigned*)(ws + WS_BAR), xst);

#ifdef FILLTEST
    for (size_t i = (size_t)bx * 512 + tid; i < 48791552; i += (size_t)G * 512) out[i] = 0.5f;
#endif
    if (PHMASK & 1) phase0(p.in, ws, lds);
#ifdef PROBE_P0
    gsync(grid);
    phase0(p.in, ws, lds);
#endif
    xcd_barrier(xbar);
#ifdef PROBE_SYNC
    for (int z = 0; z < 10; ++z) xcd_barrier(xbar);
#endif
    if (PHMASK & 2) adaln_rows<0>((float*)lds, p.in[0], p.in[1], MOD, bada, 0, 2048, H);
    xcd_barrier(xbar);
    if (PHMASK & 4) { EpiIn E{CQKV, QH, Gb, VH, GATE, KPE, ROPE, out + O_KPE_P, out + O_KPE_S, p.in[15]};
      S.init(MT, NINP, 2048, G, bx); pg8::gemm_phase(ldsl, pg8::Gemm{H, (const bf16_t*)(ws + WS_WIN), MT, NINP, 2048}, S, E); }
    if (G == 256 && bx >= (MT / 256) * (NINP / 256) - 5 * 256) {
        __syncthreads();
        transposes_range(p.in, ws, lds, TR_NIT - 128 * 64, TR_NIT, (bx - 106) * 8 + (tid >> 6), 150 * 8);
    }
    xcd_barrier(xbar);
    if (PHMASK & 8) latent_rows(CQKV, p.in[11], p.in[12], CQN, CKV, out + O_CKV_P, out + O_CKV_S);
    if (PHMASK & 16) for (int it = bx; it < NCHUNK; it += G) {
        if (it < NCHUNK_P) hgrn_a<64>(it, it >> 7, (it >> 10) * 8192 + (it & 127) * 64, 64, Gb, VH, U, DD, lds);
        else hgrn_a<32>(it, it - NCHUNK_P, MP + ((it - NCHUNK_P) >> 3) * 16, 16, Gb, VH, U, DD, lds);
    }
#ifdef PROBE_MISC
    xcd_barrier(xbar);
    latent_rows(CQKV, p.in[11], p.in[12], CQN, CKV, out + O_CKV_P, out + O_CKV_S);
    for (int it = bx; it < NCHUNK; it += G) {
        if (it < NCHUNK_P) hgrn_a<64>(it, it >> 7, (it >> 10) * 8192 + (it & 127) * 64, 64, Gb, VH, U, DD, lds);
        else hgrn_a<32>(it, it - NCHUNK_P, MP + ((it - NCHUNK_P) >> 3) * 16, 16, Gb, VH, U, DD, lds);
    }
#endif
    xcd_barrier(xbar);
    if (PHMASK & 32) { EpiQ E{Qb, ROPE}; S.init(MT, 1536, 512, G, bx); pg8::gemm_phase(ldsl, pg8::Gemm{CQN, (const bf16_t*)(ws + WS_WUQ), MT, 1536, 512}, S, E); }
    if (PHMASK & 32) { EpiPlain E{KN, 1024}; S.init(MP, 1024, 512, G, bx); pg8::gemm_phase(ldsl, pg8::Gemm{CKV, (const bf16_t*)(ws + WS_WUK), MP, 1024, 512}, S, E); }
    if (PHMASK & 32) { EpiPlain E{VT, 16384}; S.init(1024, MP, 512, G, bx); pg8::gemm_phase(ldsl, pg8::Gemm{(const bf16_t*)(ws + WS_WUV), CKV, 1024, MP, 512}, S, E); }
    if (PHMASK & 64) hgrn_b(U, DD, Sn, p.in[6], out + O_ST_P, out + O_ST_S);
#ifdef PROBE_MISC
    xcd_barrier(xbar);
    hgrn_b(U, DD, Sn, p.in[6], out + O_ST_P, out + O_ST_S);
#endif
    xcd_barrier(xbar);
    for (int p5rep = 0; p5rep < P5REPS; ++p5rep) {
    if (p5rep) xcd_barrier(xbar);
    if (PHMASK & 0x380) {
        unsigned* ctr = (unsigned*)(ws + WS_CTL) + p5rep * 64;
        volatile int* qslot = (volatile int*)(lds + LDS_Q);
        for (;;) {
            __syncthreads();
            if (tid == 0) *qslot = (int)__hip_atomic_fetch_add(ctr, 1u, __ATOMIC_RELAXED, __HIP_MEMORY_SCOPE_AGENT);
            __syncthreads();
            const int it = *qslot;
            if (it >= 256 + 512 + NCHUNK) break;
            const int pm_ = p5rep ? (P5MASK2) : 0x380;
            if (it < 256) { if (pm_ & 128) attn_sample_item(it >> 3, it & 7, Qb, (const bf16_t*)(ws + WS_WUKO), p.in[4], p.in[5], CKV, KPE, QLAT, (bf16_t*)(ws + WS_PO), (float*)(ws + WS_PML), ldsl); }
            else if (it < 256 + 512) { if (pm_ & 256) { const int j = it - 256, qb = 31 - (j >> 4), bh = j & 15; attn_prompt_item(bh >> 3, bh & 7, qb, Qb, KN, KPE, VT, MIX, ldsl); } }
            else if (pm_ & 512) { const int c = it - 768;
                if (c < NCHUNK_P) hgrn_c<64>(c, c >> 7, (c >> 10) * 8192 + (c & 127) * 64, 64, Gb, QH, VH, GATE, Sn, p.in[16], MIX, lds);
                else hgrn_c<32>(c, c - NCHUNK_P, MP + ((c - NCHUNK_P) >> 3) * 16, 16, Gb, QH, VH, GATE, Sn, p.in[16], MIX, lds); }
        }
    }
    }
    xcd_barrier(xbar);
    for (int ci = bx; ci < 256; ci += G) attn_sample_combine(ci >> 3, ci & 7, (const bf16_t*)(ws + WS_PO), (const float*)(ws + WS_PML), (const bf16_t*)(ws + WS_WUV), MIX, ldsl);
    xcd_barrier(xbar);
    if (PHMASK & 1024) { EpiRes E{p.in[0], p.in[1], X, MOD, bada, 4096, (float*)(ws + WS_CQKV)}; if (G == 256) S.init(MP, 2048, 2048, G, bx, 8, 64, 16); else S.init(MT, 2048, 2048, G, bx); pg8::gemm_phase(ldsl, pg8::Gemm{MIX, (const bf16_t*)(ws + WS_WOUT), MT, 2048, 2048}, S, E); }
    xcd_barrier(xbar);
    if (G == 256) {
        adaln_rows<8, 2>((float*)lds, X, p.in[1], MOD, bada, 6144, 8192, H, (const float*)(ws + WS_CQKV), 4096, X);
        xcd_barrier(xbar);
        if (bx < 64) { EpiRelu2 E{FFH + (size_t)MP * DFF}; S.init(MS, DFF, 2048, 64, bx); pg8::gemm_phase(ldsl, pg8::Gemm{H + (size_t)MP * DM, (const bf16_t*)(ws + WS_WFF1), MS, DFF, 2048}, S, E); }
        else adaln_rows<0, 1>((float*)lds, X, p.in[1], MOD, bada, 6144, 8192, H, nullptr, 0, nullptr, 64, 192);
        xcd_barrier(xbar);
        { EpiRelu2 E{FFH}; S.init(MP, DFF, 2048, G, bx); pg8::gemm_phase(ldsl, pg8::Gemm{H, (const bf16_t*)(ws + WS_WFF1), MP, DFF, 2048}, S, E); }
    } else {
        adaln_rows<0>((float*)lds, X, X + (size_t)MP * DM, MOD, bada, 6144, 8192, H);
        xcd_barrier(xbar);
        { EpiRelu2 E{FFH}; S.init(MT, DFF, 2048, G, bx); pg8::gemm_phase(ldsl, pg8::Gemm{H, (const bf16_t*)(ws + WS_WFF1), MT, DFF, 2048}, S, E); }
    }
    xcd_barrier(xbar);
    if (PHMASK & 8192) { EpiRes E{X, X + (size_t)MP * DM, X, MOD, bada, 10240, (float*)(ws + WS_H)}; if (G == 256) S.init(MP, 2048, DFF, G, bx, 16, 64, 16); else S.init(MT, 2048, DFF, G, bx); pg8::gemm_phase(ldsl, pg8::Gemm{FFH, (const bf16_t*)(ws + WS_WFF2), MT, 2048, DFF}, S, E); }
    xcd_barrier(xbar);
    if (PHMASK & 16384) { if (G == 256) final_rows<16>((float*)lds, X, p.in[20], (const float*)(ws + WS_H), MOD, bada); else final_rows<0>((float*)lds, X, p.in[20], nullptr, MOD, bada); }
}

extern "C" void kernel_launch(void* const* d_in, const int* in_sizes, int n_in, void* d_out, int out_size, void* d_ws, size_t ws_size, hipStream_t stream) {
    static int grid_blocks = 0;
    if (grid_blocks == 0) {
        if (n_in != 21 || ws_size < WS_TOTAL) { fprintf(stderr, "kernel_launch: unexpected n_in %d or workspace %zu < %zu\n", n_in, ws_size, (size_t)WS_END); grid_blocks = -1; return; }
        int dev = 0, cus = 0, per_cu = 0;
        hipGetDevice(&dev);
        hipDeviceGetAttribute(&cus, hipDeviceAttributeMultiprocessorCount, dev);
        if (hipFuncSetAttribute((const void*)mega, hipFuncAttributeMaxDynamicSharedMemorySize, LDS_BYTES) != hipSuccess) { fprintf(stderr, "kernel_launch: hipFuncSetAttribute failed\n"); }
        if (hipOccupancyMaxActiveBlocksPerMultiprocessor(&per_cu, (const void*)mega, 512, LDS_BYTES) != hipSuccess || per_cu < 1) { fprintf(stderr, "kernel_launch: occupancy query gave %d\n", per_cu); per_cu = 1; }
        (void)hipGetLastError();
        grid_blocks = cus * 1;
    }
    if (grid_blocks < 0) return;
    (void)hipMemsetAsync((char*)d_ws + WS_BAR, 0, XCD_BAR_WORDS * 4, stream);
    Params p{};
    for (int i = 0; i < 21; ++i) p.in[i] = (const float*)d_in[i];
    p.out = (float*)d_out; p.ws = (unsigned char*)d_ws;
    void* args[] = {&p};
    hipError_t e = hipLaunchCooperativeKernel((const void*)mega, dim3(grid_blocks), dim3(512), args, LDS_BYTES, stream);
    if (e != hipSuccess) fprintf(stderr, "cooperative launch failed: %s (grid %d)\n", hipGetErrorString(e), grid_blocks);
}
```

```cpp
#include <hip/hip_runtime.h>
#include <hip/hip_cooperative_groups.h>
#include <cstdio>
namespace cg = cooperative_groups;

#define LAS __attribute__((address_space(3)))
typedef unsigned short bf16_t;
typedef short bf16x8 __attribute__((ext_vector_type(8)));
typedef float f32x4 __attribute__((ext_vector_type(4)));
typedef float f32x2 __attribute__((ext_vector_type(2)));
typedef unsigned u32x4 __attribute__((ext_vector_type(4)));
typedef unsigned u32x2 __attribute__((ext_vector_type(2)));

constexpr int MP = 16384, MS = 512, MT = MP + MS;
constexpr int DM = 2048, NMOD = 12288, NINP = 5376, DFF = 8192;
constexpr float EPSN = 1e-6f;
constexpr float QSCALE = 0.07216878364870322f * 1.4426950408889634f;
constexpr int NCHUNK_P = 2048, NCHUNK = 2304;

constexpr size_t O_Y = 0, O_CKV_P = 34603008, O_KPE_P = 42991616, O_ST_P = 44040192, O_CKV_S = 44302336, O_KPE_S = 44564480, O_ST_S = 44597248;
constexpr size_t OB_G = 0, OB_QH = 69206016, OB_VH = 103809024;
constexpr size_t WS_CTL = 0, WS_MOD = 4096, WS_ZERO_BYTES = 4096 + 34 * 12288 * 4;
constexpr size_t WS_ROPE = 1675264;
constexpr size_t WS_WIN = WS_ROPE + 2097152;
constexpr size_t WS_WUQ = WS_WIN + (size_t)NINP * 2048 * 2;
constexpr size_t WS_WUK = WS_WUQ + 1536 * 512 * 2;
constexpr size_t WS_WUV = WS_WUK + 1024 * 512 * 2;
constexpr size_t WS_WUKO = WS_WUV + 1024 * 512 * 2;
constexpr size_t WS_WOUT = WS_WUKO + 1024 * 512 * 2;
constexpr size_t WS_WFF1 = WS_WOUT + 2048 * 2048 * 2;
constexpr size_t WS_WFF2 = WS_WFF1 + (size_t)8192 * 2048 * 2;
constexpr size_t WS_H = WS_WFF2 + (size_t)8192 * 2048 * 2;
constexpr size_t WS_KN = WS_H, WS_VT = WS_H + (size_t)MP * 1024 * 2;
constexpr size_t WS_ARENA = WS_H + (size_t)MT * 2048 * 2;
constexpr size_t WS_GATE = WS_ARENA;
constexpr size_t WS_KPE = WS_GATE + (size_t)MT * 1024 * 2;
constexpr size_t WS_CQKV = WS_KPE + (size_t)MT * 64 * 2;
constexpr size_t WS_Q = WS_CQKV;
constexpr size_t WS_CQN = WS_CQKV + (size_t)MT * 1024 * 4;
constexpr size_t WS_QLAT = WS_WIN;
constexpr size_t WS_PO = WS_CQKV + (size_t)MT * 1536 * 2;
constexpr size_t WS_PML = WS_PO + (size_t)256 * 8 * 16 * 512 * 2;
constexpr size_t WS_CKV = WS_CQN + (size_t)MT * 512 * 2;
constexpr size_t WS_U = WS_CKV + (size_t)MT * 512 * 2;
constexpr size_t WS_MIX = WS_U;
constexpr size_t WS_DD = WS_U + (size_t)NCHUNK * 16384 * 2;
constexpr size_t WS_S = WS_DD + (size_t)NCHUNK * 128 * 4;
constexpr size_t WS_END = WS_S + (size_t)NCHUNK * 16384 * 2;
constexpr size_t WS_FFH = WS_ARENA;
constexpr size_t WS_BAR = WS_END, WS_TOTAL = WS_END + 16384;
static_assert(WS_ARENA + (size_t)MT * DFF * 2 <= WS_END, "ffh overlay");
static_assert(WS_PML + 256 * 8 * 16 * 2 * 4 <= WS_CKV, "sample partials");
static_assert((size_t)32 * 8 * 16 * 576 * 2 <= (size_t)NINP * 2048 * 2, "qlat");

#ifndef P5MASK2
#define P5MASK2 0x380
#endif
#ifndef P5REPS
#define P5REPS 1
#endif
#ifndef PHMASK
#define PHMASK 0xFFFF
#endif
constexpr int LDS_BYTES = 131072 + 256;
constexpr int LDS_Q = 131072;

typedef __bf16 bf16v2 __attribute__((ext_vector_type(2)));
__device__ __forceinline__ unsigned pk2(float lo, float hi) { const f32x2 v = (f32x2){lo, hi}; const bf16v2 b = __builtin_convertvector(v, bf16v2); return __builtin_bit_cast(unsigned, b); }
__device__ __forceinline__ float bf2f(bf16_t b) { return __uint_as_float(((unsigned)b) << 16); }
__device__ __forceinline__ float wave_sum(float v) {
#pragma unroll
    for (int o = 1; o < 64; o <<= 1) v += __shfl_xor(v, o);
    return v;
}
__device__ __forceinline__ int ltid() { int t = threadIdx.x; asm volatile("" : "+v"(t)); return t; }
__device__ __forceinline__ float silu_f(float v) { return v * __builtin_amdgcn_rcpf(1.0f + __expf(-v)); }
__device__ __forceinline__ int row_pos(int r) { return r < MP ? (r & 8191) : 2048 + ((r - MP) & 15); }
__device__ __forceinline__ int row_ci(int r) { return r < MP ? (r >> 13) : 2 + ((r - MP) >> 4); }

namespace pg8 {
constexpr int BM = 256, BK = 64, HALF = 128, HTB = HALF * BK * 2, STAGE_BYTES = 8 * HTB, NXCD = 8, WGM = 8;
__host__ __device__ __forceinline__ int lds_byte(int r, int c) { const int st = (r >> 4) * 2 + (c >> 5), rr = r & 15, cc = c & 31, ob = rr * 64 + cc * 2; return st * 1024 + (ob ^ (((ob >> 9) & 1) << 5)); }
__host__ __device__ __forceinline__ void stage_rc(int b, int& R, int& C) { const int st = b / 1024, sb = b % 1024, swz = sb ^ (((sb >> 9) & 1) << 5); R = (st >> 1) * 16 + swz / 64; C = (st & 1) * 32 + (swz % 64) / 2; }
__host__ __device__ __forceinline__ int perm32(int rho) { const int n = rho >> 4, i = rho & 15; return 8 * (i >> 2) + 4 * n + (i & 3); }
struct Unit { int pm, pn, k0, nt, sl; };
struct Gemm { const bf16_t* A; const bf16_t* Bt; int M, N, K; };
struct StaticOrder {
    int nM, nN, nwg, G, c, ntK, ns, tail_pm0, ntail;
    __host__ __device__ void init(int M, int N, int K, int G_, int c_, int ns_ = 1, int tail_pm0_ = 0, int ntail_ = 0) { nM = M / BM; nN = N / BM; nwg = nM * nN; G = G_; c = c_; ntK = K / BK; ns = ns_; tail_pm0 = tail_pm0_; ntail = ntail_; }
    __host__ __device__ __forceinline__ void unit_of(int L, Unit& u) const {
        int wgid = L; { const int q = nwg / NXCD, r = nwg % NXCD, xcd = wgid % NXCD, off = wgid / NXCD; wgid = (xcd < r ? xcd * (q + 1) : r * (q + 1) + (xcd - r) * q) + off; }
        const int nig = WGM * nN, gid = wgid / nig, fm = gid * WGM, gsz = (nM - fm) < WGM ? (nM - fm) : WGM;
        u.pm = fm + ((wgid % nig) % gsz); u.pn = (wgid % nig) / gsz;
    }
    __host__ __device__ __forceinline__ bool next(int i, Unit& u) const {
        int L = i * G + c, k0 = 0, nt = ntK, sl = 0; bool ok = L < nwg;
        if (!ok) L = 0;
        unit_of(L, u);
        if (ns > 1) {
            const int rounds = nwg / G, idx = c / ns;
            const bool tail = (i == rounds) && (idx < ntail);
            if (tail) { nt = ntK / ns; k0 = (c % ns) * nt * BK; sl = 1; u.pm = tail_pm0 + idx / nN; u.pn = idx % nN; ok = true; }
        }
        u.k0 = k0; u.nt = nt; u.sl = sl; return ok;
    }
};
template <class Epi>
__device__ __forceinline__ void gemm_phase(LAS unsigned char* lds, const Gemm g, const StaticOrder& S, const Epi& E) {
    const int tid = ltid(), wid = __builtin_amdgcn_readfirstlane(tid >> 6), lane = tid & 63, wr = wid >> 2, wc = wid & 3, fr = lane & 15, fq = lane >> 4;
    const int K = g.K;
    unsigned voffA[2], voffB[2];
#pragma unroll
    for (int i = 0; i < 2; ++i) { int R, C; stage_rc(tid * 16 + i * 8192, R, C); const int Rb = Epi::PERM ? ((R & ~31) + perm32(R & 31)) : R; voffA[i] = (unsigned)(R * K + C) * 2u; voffB[i] = (unsigned)(Rb * K + C) * 2u; }
    const size_t kstep = (size_t)(BK * 2);
    const size_t hstep = (size_t)HALF * K * 2;
    const size_t tstep = 2 * hstep;
    const unsigned ldsw = (unsigned)wid * 1024u;
    const int aoff = lds_byte(wr * 64 + fr, fq * 8), boff = lds_byte(wc * 32 + fr, fq * 8);
#define PG8_SA(b, h) (((b) * 2 + (h)) * HTB)
#define PG8_SB(b, h) ((4 + (b) * 2 + (h)) * HTB)
#define PG8_STAGE(bufoff, gbase, voff) do { _Pragma("unroll") for (int _i = 0; _i < 2; ++_i) \
        __builtin_amdgcn_global_load_lds((const unsigned*)((const char*)(gbase) + (voff)[_i]), (LAS unsigned*)(lds + (bufoff) + ldsw + _i * 8192), 16, 0, 0); } while (0)
#define PG8_LDA(dst, b, h) do { _Pragma("unroll") for (int m = 0; m < 4; ++m) _Pragma("unroll") for (int k = 0; k < 2; ++k) dst[m][k] = *(const LAS bf16x8*)(lds + PG8_SA(b, h) + aoff + m * 2048 + k * 1024); } while (0)
#define PG8_LDB(dst, b, h) do { _Pragma("unroll") for (int n = 0; n < 2; ++n) _Pragma("unroll") for (int k = 0; k < 2; ++k) dst[n][k] = *(const LAS bf16x8*)(lds + PG8_SB(b, h) + boff + n * 2048 + k * 1024); } while (0)
#define PG8_MMA(ai, bj, At, Bt) do { __builtin_amdgcn_s_setprio(1); _Pragma("unroll") for (int m = 0; m < 4; ++m) _Pragma("unroll") for (int n = 0; n < 2; ++n) _Pragma("unroll") for (int k = 0; k < 2; ++k) \
        acc[ai][bj][m][n] = __builtin_amdgcn_mfma_f32_16x16x32_bf16(Bt[n][k], At[m][k], acc[ai][bj][m][n], 0, 0, 0); __builtin_amdgcn_s_setprio(0); } while (0)
#define PG8_WAIT_V(n) asm volatile("s_waitcnt vmcnt(" #n ")" ::: "memory")
#define PG8_WAIT_L(n) asm volatile("s_waitcnt lgkmcnt(" #n ")" ::: "memory")
#define PG8_BAR __builtin_amdgcn_s_barrier()
#define PG8_SCHED __builtin_amdgcn_sched_barrier(0)
    Unit cur, nxt; int ui = 0;
    if (!S.next(0, cur)) return;
    f32x4 acc[2][2][4][2];
#pragma unroll
    for (int a = 0; a < 2; ++a)
#pragma unroll
        for (int b = 0; b < 2; ++b)
#pragma unroll
            for (int m = 0; m < 4; ++m)
#pragma unroll
                for (int n = 0; n < 2; ++n) acc[a][b][m][n] = (f32x4){0.f, 0.f, 0.f, 0.f};
    bf16x8 At[4][2], B0[2][2], B1[2][2];
    const char* cA = (const char*)g.A + (size_t)cur.pm * tstep + (size_t)cur.k0 * 2; const char* cB = (const char*)g.Bt + (size_t)cur.pn * tstep + (size_t)cur.k0 * 2;
    PG8_STAGE(PG8_SB(0, 0), cB, voffB); PG8_STAGE(PG8_SA(0, 0), cA, voffA); PG8_STAGE(PG8_SB(0, 1), cB + hstep, voffB); PG8_STAGE(PG8_SA(0, 1), cA + hstep, voffA);
    if (wr == 1) PG8_BAR;
    PG8_WAIT_V(4); PG8_BAR;
    PG8_STAGE(PG8_SB(1, 0), cB + kstep, voffB); PG8_STAGE(PG8_SA(1, 0), cA + kstep, voffA); PG8_STAGE(PG8_SB(1, 1), cB + hstep + kstep, voffB);
    PG8_WAIT_V(6); PG8_BAR;
    for (;;) {
        const bool has_next = S.next(ui + 1, nxt);
        const char* nA = has_next ? (const char*)g.A + (size_t)nxt.pm * tstep + (size_t)nxt.k0 * 2 : cA; const char* nB = has_next ? (const char*)g.Bt + (size_t)nxt.pn * tstep + (size_t)nxt.k0 * 2 : cB;
        const int nt = cur.nt;
        for (int t = 0; t < nt; t += 2) {
            const bool last = (t == nt - 2);
            const char* a1 = cA + (size_t)(t + 1) * kstep;
            const char* a2 = last ? nA : cA + (size_t)(t + 2) * kstep; const char* b2 = last ? nB : cB + (size_t)(t + 2) * kstep;
            const char* a3 = a2 + kstep; const char* b3 = b2 + kstep;
            PG8_LDB(B0, 0, 0); PG8_SCHED; PG8_LDA(At, 0, 0); PG8_STAGE(PG8_SA(1, 1), a1 + hstep, voffA);
            PG8_WAIT_L(8); PG8_BAR; PG8_WAIT_L(0); PG8_MMA(0, 0, At, B0); PG8_BAR; PG8_SCHED;
            PG8_LDB(B1, 0, 1); PG8_STAGE(PG8_SB(0, 0), b2, voffB);
            PG8_BAR; PG8_WAIT_L(0); PG8_MMA(0, 1, At, B1); PG8_BAR;
            PG8_LDA(At, 0, 1); PG8_STAGE(PG8_SA(0, 0), a2, voffA);
            PG8_BAR; PG8_WAIT_L(0); PG8_MMA(1, 0, At, B0); PG8_BAR; PG8_SCHED;
            PG8_STAGE(PG8_SB(0, 1), b2 + hstep, voffB);
            PG8_WAIT_V(6); PG8_BAR; PG8_MMA(1, 1, At, B1); PG8_BAR;
            PG8_LDB(B0, 1, 0); PG8_SCHED; PG8_LDA(At, 1, 0); PG8_STAGE(PG8_SA(0, 1), a2 + hstep, voffA);
            PG8_WAIT_L(8); PG8_BAR; PG8_WAIT_L(0); PG8_MMA(0, 0, At, B0); PG8_BAR; PG8_SCHED;
            PG8_LDB(B1, 1, 1); PG8_STAGE(PG8_SB(1, 0), b3, voffB);
            PG8_BAR; PG8_WAIT_L(0); PG8_MMA(0, 1, At, B1); PG8_BAR;
            PG8_LDA(At, 1, 1); PG8_STAGE(PG8_SA(1, 0), a3, voffA);
            PG8_BAR; PG8_WAIT_L(0); PG8_MMA(1, 0, At, B0); PG8_BAR; PG8_SCHED;
            PG8_STAGE(PG8_SB(1, 1), b3 + hstep, voffB);
            PG8_WAIT_V(6); PG8_BAR; PG8_MMA(1, 1, At, B1); PG8_BAR;
        }
        E(acc, cur, wr, wc, fr, fq);
        if (!has_next) break;
#pragma unroll
        for (int a = 0; a < 2; ++a)
#pragma unroll
            for (int b = 0; b < 2; ++b)
#pragma unroll
                for (int m = 0; m < 4; ++m)
#pragma unroll
                    for (int n = 0; n < 2; ++n) acc[a][b][m][n] = (f32x4){0.f, 0.f, 0.f, 0.f};
        cur = nxt; cA = nA; cB = nB; ++ui;
    }
    PG8_WAIT_V(0);
    if (wr == 0) PG8_BAR;
    PG8_BAR;
#undef PG8_SA
#undef PG8_SB
#undef PG8_STAGE
#undef PG8_LDA
#undef PG8_LDB
#undef PG8_MMA
#undef PG8_WAIT_V
#undef PG8_WAIT_L
#undef PG8_BAR
#undef PG8_SCHED
}
}

template <class F>
__device__ __forceinline__ void epi_walk(const f32x4 (&acc)[2][2][4][2], const pg8::Unit& u, int wr, int wc, int fr, int fq, const F& f) {
    const int row0 = u.pm * 256 + wr * 64 + fr;
#pragma unroll
    for (int ai = 0; ai < 2; ++ai)
#pragma unroll
        for (int m = 0; m < 4; ++m) {
            const int r = row0 + ai * 128 + m * 16;
#pragma unroll
            for (int bj = 0; bj < 2; ++bj)
#pragma unroll
                for (int n = 0; n < 2; ++n) f(r, bj * 128 + wc * 32 + n * 16 + 4 * fq, acc[ai][bj][m][n]);
        }
}

template <class F>
__device__ __forceinline__ void epi_walk8(const f32x4 (&acc)[2][2][4][2], const pg8::Unit& u, int wr, int wc, int fr, int fq, const F& f) {
    const int row0 = u.pm * 256 + wr * 64 + fr;
#pragma unroll
    for (int ai = 0; ai < 2; ++ai)
#pragma unroll
        for (int m = 0; m < 4; ++m) {
            const int r = row0 + ai * 128 + m * 16;
#pragma unroll
            for (int bj = 0; bj < 2; ++bj) f(r, bj * 128 + wc * 32 + 8 * fq, acc[ai][bj][m][0], acc[ai][bj][m][1]);
        }
}
struct EpiIn {
    static constexpr bool PERM = true;
    float* cqkv; bf16_t* qh; float* g; bf16_t* vh; bf16_t* gate; bf16_t* kpe; const f32x2* rope; float* okp; float* oks; const float* hglb;
    __device__ __forceinline__ void operator()(const f32x4 (&acc)[2][2][4][2], const pg8::Unit& u, int wr, int wc, int fr, int fq) const {
        const int pn = u.pn;
        epi_walk8(acc, u, wr, wc, fr, fq, [&](int r, int cl, f32x4 v0, f32x4 v1) {
            const int c = pn * 256 + cl;
            if (pn < 4) { *(f32x4*)(cqkv + (size_t)r * 1024 + c) = v0; *(f32x4*)(cqkv + (size_t)r * 1024 + c + 4) = v1; }
            else if (pn < 8) {
                const float sc = 0.08838834764831845f;
                u32x4 w; w.x = pk2(silu_f(v0[0]) * sc, silu_f(v0[1]) * sc); w.y = pk2(silu_f(v0[2]) * sc, silu_f(v0[3]) * sc); w.z = pk2(silu_f(v1[0]) * sc, silu_f(v1[1]) * sc); w.w = pk2(silu_f(v1[2]) * sc, silu_f(v1[3]) * sc);
                *(u32x4*)(qh + (size_t)r * 1024 + (c - 1024)) = w;
            } else if (pn < 12) {
                const int j = c - 2048;
#pragma unroll
                for (int hhalf = 0; hhalf < 2; ++hhalf) { const f32x4 v = hhalf ? v1 : v0;
                    const f32x4 a0 = *(const f32x4*)(hglb + j + 4 * hhalf), a1 = *(const f32x4*)(hglb + 1024 + j + 4 * hhalf);
                    f32x4 o;
#pragma unroll
                    for (int e = 0; e < 4; ++e) { const float lb = __builtin_amdgcn_rcpf(1.0f + __expf(a1[e] - a0[e])); const float sg = __builtin_amdgcn_rcpf(1.0f + __expf(-v[e])); o[e] = __logf(lb + (1.0f - lb) * sg); }
                    *(f32x4*)(g + (size_t)r * 1024 + j + 4 * hhalf) = o; }
            } else if (pn < 16) {
                u32x4 w; w.x = pk2(v0[0], v0[1]); w.y = pk2(v0[2], v0[3]); w.z = pk2(v1[0], v1[1]); w.w = pk2(v1[2], v1[3]);
                *(u32x4*)(vh + (size_t)r * 1024 + (c - 3072)) = w;
            } else if (pn < 20) {
                u32x4 w; w.x = pk2(silu_f(v0[0]), silu_f(v0[1])); w.y = pk2(silu_f(v0[2]), silu_f(v0[3])); w.z = pk2(silu_f(v1[0]), silu_f(v1[1])); w.w = pk2(silu_f(v1[2]), silu_f(v1[3]));
                *(u32x4*)(gate + (size_t)r * 1024 + (c - 4096)) = w;
            } else if (cl < 64) {
                const int pos = row_pos(r);
                float* ob = r < MP ? okp + (size_t)r * 64 : oks + (size_t)(r - MP) * 64;
                u32x4 w;
#pragma unroll
                for (int hhalf = 0; hhalf < 2; ++hhalf) { const f32x4 v = hhalf ? v1 : v0; const int i0 = (cl >> 1) + 2 * hhalf;
                    const f32x2 c0 = rope[pos * 32 + i0], c1 = rope[pos * 32 + i0 + 1];
                    const float o1a = v[0] * c0.x - v[1] * c0.y, o2a = v[1] * c0.x + v[0] * c0.y;
                    const float o1b = v[2] * c1.x - v[3] * c1.y, o2b = v[3] * c1.x + v[2] * c1.y;
                    *(f32x2*)(ob + i0) = (f32x2){o1a, o1b}; *(f32x2*)(ob + 32 + i0) = (f32x2){o2a, o2b};
                    if (hhalf) { w.z = pk2(o1a, o2a); w.w = pk2(o1b, o2b); } else { w.x = pk2(o1a, o2a); w.y = pk2(o1b, o2b); } }
                *(u32x4*)(kpe + (size_t)r * 64 + cl) = w;
            }
        });
    }
};
struct EpiQ {
    static constexpr bool PERM = true;
    bf16_t* q; const f32x2* rope;
    __device__ __forceinline__ void operator()(const f32x4 (&acc)[2][2][4][2], const pg8::Unit& u, int wr, int wc, int fr, int fq) const {
        const int pn = u.pn;
        epi_walk8(acc, u, wr, wc, fr, fq, [&](int r, int cl, f32x4 v0, f32x4 v1) {
            const int c = pn * 256 + cl, h = c / 192, j = c - h * 192;
            u32x4 w;
            if (j < 128) { w.x = pk2(v0[0] * QSCALE, v0[1] * QSCALE); w.y = pk2(v0[2] * QSCALE, v0[3] * QSCALE); w.z = pk2(v1[0] * QSCALE, v1[1] * QSCALE); w.w = pk2(v1[2] * QSCALE, v1[3] * QSCALE); }
            else {
                const int pos = row_pos(r);
#pragma unroll
                for (int hhalf = 0; hhalf < 2; ++hhalf) { const f32x4 v = hhalf ? v1 : v0; const int i0 = ((j - 128) >> 1) + 2 * hhalf;
                    const f32x2 c0 = rope[pos * 32 + i0], c1 = rope[pos * 32 + i0 + 1];
                    const float o1a = v[0] * c0.x - v[1] * c0.y, o2a = v[1] * c0.x + v[0] * c0.y;
                    const float o1b = v[2] * c1.x - v[3] * c1.y, o2b = v[3] * c1.x + v[2] * c1.y;
                    if (hhalf) { w.z = pk2(o1a * QSCALE, o2a * QSCALE); w.w = pk2(o1b * QSCALE, o2b * QSCALE); } else { w.x = pk2(o1a * QSCALE, o2a * QSCALE); w.y = pk2(o1b * QSCALE, o2b * QSCALE); } }
            }
            *(u32x4*)(q + (size_t)r * 1536 + c) = w;
        });
    }
};
struct EpiPlain {
    static constexpr bool PERM = true;
    bf16_t* o; int ldc;
    __device__ __forceinline__ void operator()(const f32x4 (&acc)[2][2][4][2], const pg8::Unit& u, int wr, int wc, int fr, int fq) const {
        const int pn = u.pn;
        epi_walk8(acc, u, wr, wc, fr, fq, [&](int r, int cl, f32x4 v0, f32x4 v1) {
            u32x4 w; w.x = pk2(v0[0], v0[1]); w.y = pk2(v0[2], v0[3]); w.z = pk2(v1[0], v1[1]); w.w = pk2(v1[2], v1[3]);
            *(u32x4*)(o + (size_t)r * ldc + pn * 256 + cl) = w;
        });
    }
};
struct EpiRelu2 {
    static constexpr bool PERM = true;
    bf16_t* o;
    __device__ __forceinline__ void operator()(const f32x4 (&acc)[2][2][4][2], const pg8::Unit& u, int wr, int wc, int fr, int fq) const {
        const int row0 = u.pm * 256 + wr * 64 + fr, col0 = u.pn * 256 + wc * 32 + 8 * fq;
#pragma unroll
        for (int ai = 0; ai < 2; ++ai)
#pragma unroll
            for (int m = 0; m < 4; ++m) { bf16_t* rowp = o + (size_t)(row0 + ai * 128 + m * 16) * DFF + col0;
#pragma unroll
                for (int bj = 0; bj < 2; ++bj) { const f32x4 v0 = acc[ai][bj][m][0], v1 = acc[ai][bj][m][1]; float t[8];
#pragma unroll
                    for (int e = 0; e < 4; ++e) { const float a = fmaxf(v0[e], 0.f), b = fmaxf(v1[e], 0.f); t[e] = a * a; t[4 + e] = b * b; }
                    u32x4 w; w.x = pk2(t[0], t[1]); w.y = pk2(t[2], t[3]); w.z = pk2(t[4], t[5]); w.w = pk2(t[6], t[7]);
                    *(u32x4*)(rowp + bj * 128) = w; } }
    }
};
struct EpiRes {
    static constexpr bool PERM = true;
    const float* xa; const float* xb; float* xo; const float* mod; const float* bada; int goff; float* part;
    __device__ __forceinline__ void operator()(const f32x4 (&acc)[2][2][4][2], const pg8::Unit& u, int wr, int wc, int fr, int fq) const {
        const int pn = u.pn, sl = u.sl, sidx = u.k0 / (u.nt * 64);
        epi_walk8(acc, u, wr, wc, fr, fq, [&](int r, int cl, f32x4 v0, f32x4 v1) {
            const int c = pn * 256 + cl;
            if (sl) { float* d = part + ((size_t)sidx * MS + (r - MP)) * DM + c; *(f32x4*)d = v0; *(f32x4*)(d + 4) = v1; }
            else {
                const int ci = row_ci(r);
                const float* xi = r < MP ? xa + (size_t)r * DM : xb + (size_t)(r - MP) * DM;
                const float* mp = mod + (size_t)ci * NMOD + goff + c; const float* bp = bada + goff + c;
                const f32x4 g0 = *(const f32x4*)mp + *(const f32x4*)bp, g1 = *(const f32x4*)(mp + 4) + *(const f32x4*)(bp + 4);
                const f32x4 x0 = *(const f32x4*)(xi + c), x1 = *(const f32x4*)(xi + c + 4);
                float* d = xo + (size_t)r * DM + c; *(f32x4*)d = x0 + g0 * v0; *(f32x4*)(d + 4) = x1 + g1 * v1;
            }
        });
    }
};

__device__ __forceinline__ int map_row(int mat, int n) {
    if (mat == 0) { if (n < 1024) return n; if (n < 1088) { const int i = n - 1024; return 5120 + (i < 32 ? 2 * i : 2 * (i - 32) + 1); } return n - 64; }
    if (mat == 1) { const int h = n / 192, j = n - h * 192; if (j < 128) return n; const int i = j - 128; return h * 192 + 128 + (i < 32 ? 2 * i : 2 * (i - 32) + 1); }
    return n;
}
struct TrItem { const float* W; bf16_t* WT; int K, N, mat, item; };
__device__ __forceinline__ void tr_load(const TrItem& t, int lane, float (&tv)[32]) {
    const int nblk = t.N / 32, kb = t.item / nblk, nb = t.item % nblk, k0 = 64 * kb, n0 = 32 * nb;
#pragma unroll
    for (int i = 0; i < 32; ++i) { const int kk = 2 * i + (lane >> 5); tv[i] = t.W[(size_t)(k0 + kk) * t.N + n0 + (lane & 31)]; }
}
__device__ __forceinline__ void tr_store(const TrItem& t, int lane, const float (&tv)[32], LAS float* scr) {
    const int nblk = t.N / 32, kb = t.item / nblk, nb = t.item % nblk, k0 = 64 * kb, n0 = 32 * nb;
#pragma unroll
    for (int i = 0; i < 32; ++i) { const int kk = 2 * i + (lane >> 5); scr[kk * 33 + (lane & 31)] = tv[i]; }
    asm volatile("s_waitcnt lgkmcnt(0)" ::: "memory");
    const int c = lane & 7;
#pragma unroll
    for (int j = 0; j < 4; ++j) { const int n = (lane >> 3) + 8 * j; const LAS float* sp = scr + (8 * c) * 33 + n;
        u32x4 o; o.x = pk2(sp[0 * 33], sp[1 * 33]); o.y = pk2(sp[2 * 33], sp[3 * 33]); o.z = pk2(sp[4 * 33], sp[5 * 33]); o.w = pk2(sp[6 * 33], sp[7 * 33]);
        *(u32x4*)(t.WT + (size_t)map_row(t.mat, n0 + n) * t.K + k0 + 8 * c) = o; }
    asm volatile("s_waitcnt lgkmcnt(0)" ::: "memory");
}
__device__ __forceinline__ TrItem tr_item(const float* const* in, unsigned char* ws, int it) {
    constexpr int I0 = 32 * 162, I1 = 8 * 48, I2 = 8 * 32, I3 = 8 * 32, I4 = 32 * 64, I5 = 32 * 256;
    int r = it;
    if (r < I0) return TrItem{in[9], (bf16_t*)(ws + WS_WIN), 2048, 5184, 0, r}; r -= I0;
    if (r < I1) return TrItem{in[10], (bf16_t*)(ws + WS_WUQ), 512, 1536, 1, r}; r -= I1;
    if (r < I2) return TrItem{in[13], (bf16_t*)(ws + WS_WUK), 512, 1024, 2, r}; r -= I2;
    if (r < I3) return TrItem{in[14], (bf16_t*)(ws + WS_WUV), 512, 1024, 2, r}; r -= I3;
    if (r < I4) return TrItem{in[17], (bf16_t*)(ws + WS_WOUT), 2048, 2048, 2, r}; r -= I4;
    if (r < I5) return TrItem{in[18], (bf16_t*)(ws + WS_WFF1), 2048, 8192, 2, r}; r -= I5;
    return TrItem{in[19], (bf16_t*)(ws + WS_WFF2), 8192, 2048, 2, r};
}
constexpr int TR_NIT = 32 * 162 + 8 * 48 + 8 * 32 + 8 * 32 + 32 * 64 + 32 * 256 + 128 * 64;
__device__ __forceinline__ void transposes_range(const float* const* in, unsigned char* ws, unsigned char* lds, int i0, int i1, int gw, int NGW) {
    const int tid = ltid(), lane = tid & 63, wave = tid >> 6;
    LAS float* scr = (LAS float*)lds + wave * (64 * 33);
    float ta[32], tb[32];
    int it = i0 + gw;
    if (it < i1) tr_load(tr_item(in, ws, it), lane, ta);
    for (; it < i1; it += 2 * NGW) {
        if (it + NGW < i1) tr_load(tr_item(in, ws, it + NGW), lane, tb);
        tr_store(tr_item(in, ws, it), lane, ta, scr);
        if (it + NGW < i1) {
            if (it + 2 * NGW < i1) tr_load(tr_item(in, ws, it + 2 * NGW), lane, ta);
            tr_store(tr_item(in, ws, it + NGW), lane, tb, scr);
        }
    }
}
__device__ __forceinline__ void phase0(const float* const* in, unsigned char* ws, unsigned char* lds) {
    const int tid = ltid(), lane = tid & 63, wave = tid >> 6, G = gridDim.x, bx = blockIdx.x;
    {
        float* sl = (float*)lds;
        float* MOD = (float*)(ws + WS_MOD);
        const float* wada = in[7];
        if (bx == 0 && tid < 2) __hip_atomic_store((unsigned*)(ws + WS_CTL) + tid * 64, 0u, __ATOMIC_RELAXED, __HIP_MEMORY_SCOPE_AGENT);
        for (int it = bx; it < 192; it += G) {
            const int grp = tid >> 6, col = it * 64 + lane;
            float acc[34];
#pragma unroll
            for (int r = 0; r < 34; ++r) acc[r] = 0.f;
            for (int pass = 0; pass < 4; ++pass) {
                __syncthreads();
                for (int e = tid; e < 34 * 512; e += 512) { const int r = e >> 9, kl = e & 511, kg = (kl >> 6) * 256 + pass * 64 + (kl & 63);
                    const float cv = r < 2 ? in[2][r * DM + kg] : in[3][(r - 2) * DM + kg]; sl[e] = silu_f(cv); }
                __syncthreads();
                const int k0 = grp * 256 + pass * 64;
                for (int kk = 0; kk < 64; kk += 8) {
                    float w[8];
#pragma unroll
                    for (int j = 0; j < 8; ++j) w[j] = wada[(size_t)(k0 + kk + j) * NMOD + col];
#pragma unroll
                    for (int r = 0; r < 34; ++r) { const f32x4 sv = *(const f32x4*)(sl + r * 512 + grp * 64 + kk), sw = *(const f32x4*)(sl + r * 512 + grp * 64 + kk + 4);
                        acc[r] += (sv[0] * w[0] + sv[1] * w[1] + sv[2] * w[2] + sv[3] * w[3]) + (sw[0] * w[4] + sw[1] * w[5] + sw[2] * w[6] + sw[3] * w[7]); }
                }
            }
            __syncthreads();
            float* red = (float*)lds;
#pragma unroll
            for (int r = 0; r < 34; ++r) red[(grp * 34 + r) * 64 + lane] = acc[r];
            __syncthreads();
            for (int e = tid; e < 34 * 64; e += 512) { const int r = e >> 6, c = e & 63; float sum = 0.f;
#pragma unroll
                for (int g2 = 0; g2 < 8; ++g2) sum += red[(g2 * 34 + r) * 64 + c];
                MOD[(size_t)r * NMOD + it * 64 + c] = sum; }
            __syncthreads();
        }
    }
    transposes_range(in, ws, lds, 0, (G == 256) ? TR_NIT - 128 * 64 : TR_NIT, bx * 8 + wave, G * 8);
    const int gt = bx * 512 + tid, NGT = G * 512;
    { u32x4* z = (u32x4*)(ws + WS_WIN + (size_t)5184 * 2048 * 2); for (int i = gt; i < 192 * 2048 * 2 / 16; i += NGT) z[i] = (u32x4){0u, 0u, 0u, 0u}; }
    { const f32x4* s = (const f32x4*)in[13]; u32x2* d = (u32x2*)(ws + WS_WUKO); for (int i = gt; i < 512 * 1024 / 4; i += NGT) { const f32x4 v = s[i]; u32x2 w; w.x = pk2(v[0], v[1]); w.y = pk2(v[2], v[3]); d[i] = w; } }
    { f32x2* rp = (f32x2*)(ws + WS_ROPE);
      for (int i = gt; i < 8192 * 32; i += NGT) { const int pos = i >> 5, k = i & 31;
          const double invf = exp(-9.210340371976184 * (double)k / 32.0); const double t = (double)pos * invf * 0.15915494309189535; const float fr = (float)(t - rint(t));
          rp[i] = (f32x2){__builtin_amdgcn_cosf(fr), __builtin_amdgcn_sinf(fr)}; } }
}

template <int NSL, int PARTS = 3>
__device__ __forceinline__ void adaln_rows(float* xch, const float* xa, const float* xb, const float* mod, const float* bada, int off_sh, int off_sc, bf16_t* H,
                                           const float* part = nullptr, int off_gt = 0, float* xout = nullptr, int wg0 = 0, int nwg = 0) {
    const int tid_ = ltid(), lane = tid_ & 63;
    const int nw_ = nwg ? nwg : (int)gridDim.x, gw = ((int)blockIdx.x - wg0) * 8 + (tid_ >> 6), NGW = nw_ * 8;
    if (PARTS & 1) {
        f32x4 v[8], nx[8];
#pragma unroll
        for (int j = 0; j < 8; ++j) v[j] = *(const f32x4*)(xa + (size_t)gw * DM + 4 * lane + 256 * j);
        for (int row = gw; row < MP; row += NGW) {
            const int nrow = row + NGW;
            if (nrow < MP) {
#pragma unroll
                for (int j = 0; j < 8; ++j) nx[j] = *(const f32x4*)(xa + (size_t)nrow * DM + 4 * lane + 256 * j); }
            const int ci = row >> 13;
            float ss = 0.f;
#pragma unroll
            for (int j = 0; j < 8; ++j) ss += (v[j][0] * v[j][0] + v[j][1] * v[j][1]) + (v[j][2] * v[j][2] + v[j][3] * v[j][3]);
            const float* mr = mod + (size_t)ci * NMOD;
            const float rstd = 1.0f / sqrtf(wave_sum(ss) * (1.0f / DM) + EPSN);
#pragma unroll
            for (int j = 0; j < 8; ++j) { const int c = 4 * lane + 256 * j;
                const f32x4 scj = *(const f32x4*)(mr + off_sc + c) + *(const f32x4*)(bada + off_sc + c) + 1.0f;
                const f32x4 shj = *(const f32x4*)(mr + off_sh + c) + *(const f32x4*)(bada + off_sh + c);
                const f32x4 h = v[j] * rstd * scj + shj;
                u32x2 w; w.x = pk2(h[0], h[1]); w.y = pk2(h[2], h[3]);
                *(u32x2*)(H + (size_t)row * DM + c) = w; v[j] = nx[j]; }
        }
    }
    __builtin_amdgcn_sched_barrier(0);
    if (PARTS & 2) {
        const int wave = tid_ >> 6, q4 = wave & 3;
        for (int rp = blockIdx.x; rp < MS / 2; rp += gridDim.x) {
            const int sr = 2 * rp + (wave >> 2), row = MP + sr; const float* xr = xb + (size_t)sr * DM; const float* mr = mod + (size_t)row_ci(row) * NMOD;
            f32x4 v[2]; float ss = 0.f;
#pragma unroll
            for (int j = 0; j < 2; ++j) { const int c = q4 * 512 + 4 * lane + 256 * j; v[j] = *(const f32x4*)(xr + c);
                if (NSL > 0) { f32x4 a = (f32x4){0.f, 0.f, 0.f, 0.f};
#pragma unroll
                    for (int s2 = 0; s2 < NSL; ++s2) a += *(const f32x4*)(part + ((size_t)s2 * MS + sr) * DM + c);
                    const f32x4 gt = *(const f32x4*)(mr + off_gt + c) + *(const f32x4*)(bada + off_gt + c);
                    v[j] += gt * a; *(f32x4*)(xout + (size_t)row * DM + c) = v[j]; }
                ss += (v[j][0] * v[j][0] + v[j][1] * v[j][1]) + (v[j][2] * v[j][2] + v[j][3] * v[j][3]); }
            ss = wave_sum(ss);
            __syncthreads();
            if (lane == 0) xch[wave] = ss;
            __syncthreads();
            const int w0 = wave & 4;
            const float rstd = 1.0f / sqrtf(((xch[w0] + xch[w0 + 1]) + (xch[w0 + 2] + xch[w0 + 3])) * (1.0f / DM) + EPSN);
#pragma unroll
            for (int j = 0; j < 2; ++j) { const int c = q4 * 512 + 4 * lane + 256 * j;
                const f32x4 sc = *(const f32x4*)(mr + off_sc + c) + *(const f32x4*)(bada + off_sc + c) + 1.0f;
                const f32x4 sh = *(const f32x4*)(mr + off_sh + c) + *(const f32x4*)(bada + off_sh + c);
                const f32x4 h = v[j] * rstd * sc + sh;
                u32x2 w; w.x = pk2(h[0], h[1]); w.y = pk2(h[2], h[3]);
                *(u32x2*)(H + (size_t)row * DM + c) = w; }
        }
    }
}
template <int NSL>
__device__ __forceinline__ void final_rows(float* xch, float* X, const float* gf, const float* part, const float* mod, const float* bada) {
    const int tid_ = ltid(), lane = tid_ & 63, gw = blockIdx.x * 8 + (tid_ >> 6), NGW = gridDim.x * 8;
    {
        f32x4 v[8], nx[8], gn[8];
#pragma unroll
        for (int j = 0; j < 8; ++j) { gn[j] = *(const f32x4*)(gf + 4 * lane + 256 * j); v[j] = *(const f32x4*)(X + (size_t)gw * DM + 4 * lane + 256 * j); }
        for (int row = gw; row < MP; row += NGW) {
            const int nrow = row + NGW;
            if (nrow < MP) {
#pragma unroll
                for (int j = 0; j < 8; ++j) nx[j] = *(const f32x4*)(X + (size_t)nrow * DM + 4 * lane + 256 * j); }
            float ss = 0.f;
#pragma unroll
            for (int j = 0; j < 8; ++j) ss += (v[j][0] * v[j][0] + v[j][1] * v[j][1]) + (v[j][2] * v[j][2] + v[j][3] * v[j][3]);
            const float rstd = 1.0f / sqrtf(wave_sum(ss) * (1.0f / DM) + EPSN);
#pragma unroll
            for (int j = 0; j < 8; ++j) { *(f32x4*)(X + (size_t)row * DM + 4 * lane + 256 * j) = v[j] * rstd * gn[j]; v[j] = nx[j]; }
        }
    }
    __builtin_amdgcn_sched_barrier(0);
    {
        const int wave = tid_ >> 6, q4 = wave & 3;
        for (int rp = blockIdx.x; rp < MS / 2; rp += gridDim.x) {
            const int sr = 2 * rp + (wave >> 2), row = MP + sr;
            f32x4 v[2]; float ss = 0.f;
#pragma unroll
            for (int j = 0; j < 2; ++j) { const int c = q4 * 512 + 4 * lane + 256 * j; v[j] = *(const f32x4*)(X + (size_t)row * DM + c);
                if (NSL > 0) { f32x4 a = (f32x4){0.f, 0.f, 0.f, 0.f};
#pragma unroll
                    for (int s2 = 0; s2 < NSL; ++s2) a += *(const f32x4*)(part + ((size_t)s2 * MS + sr) * DM + c);
                    const f32x4 gt = *(const f32x4*)(mod + (size_t)row_ci(row) * NMOD + 10240 + c) + *(const f32x4*)(bada + 10240 + c);
                    v[j] += gt * a; }
                ss += (v[j][0] * v[j][0] + v[j][1] * v[j][1]) + (v[j][2] * v[j][2] + v[j][3] * v[j][3]); }
            ss = wave_sum(ss);
            __syncthreads();
            if (lane == 0) xch[wave] = ss;
            __syncthreads();
            const int w0 = wave & 4;
            const float rstd = 1.0f / sqrtf(((xch[w0] + xch[w0 + 1]) + (xch[w0 + 2] + xch[w0 + 3])) * (1.0f / DM) + EPSN);
#pragma unroll
            for (int j = 0; j < 2; ++j) { const int c = q4 * 512 + 4 * lane + 256 * j; *(f32x4*)(X + (size_t)row * DM + c) = v[j] * rstd * *(const f32x4*)(gf + c); }
        }
    }
}
__device__ __forceinline__ void latent_rows(const float* cqkv, const float* gq, const float* gkv, bf16_t* cqn, bf16_t* ckv, float* ockp, float* ocks) {
    const int tid_ = ltid(), lane = tid_ & 63, gw = blockIdx.x * 8 + (tid_ >> 6), NGW = gridDim.x * 8;
    for (int row = gw; row < MT; row += NGW) {
        const float* sr = cqkv + (size_t)row * 1024;
        f32x4 a[2], b[2]; float sa = 0.f, sb = 0.f;
#pragma unroll
        for (int j = 0; j < 2; ++j) { a[j] = *(const f32x4*)(sr + 4 * lane + 256 * j); b[j] = *(const f32x4*)(sr + 512 + 4 * lane + 256 * j);
            sa += (a[j][0] * a[j][0] + a[j][1] * a[j][1]) + (a[j][2] * a[j][2] + a[j][3] * a[j][3]); sb += (b[j][0] * b[j][0] + b[j][1] * b[j][1]) + (b[j][2] * b[j][2] + b[j][3] * b[j][3]); }
        const float ra = 1.0f / sqrtf(wave_sum(sa) * (1.0f / 512) + EPSN), rb = 1.0f / sqrtf(wave_sum(sb) * (1.0f / 512) + EPSN);
        float* oc = row < MP ? ockp + (size_t)row * 512 : ocks + (size_t)(row - MP) * 512;
#pragma unroll
        for (int j = 0; j < 2; ++j) { const int c = 4 * lane + 256 * j;
            const f32x4 qa = a[j] * ra * *(const f32x4*)(gq + c), kb = b[j] * rb * *(const f32x4*)(gkv + c);
            u32x2 w; w.x = pk2(qa[0], qa[1]); w.y = pk2(qa[2], qa[3]); *(u32x2*)(cqn + (size_t)row * 512 + c) = w;
            *(f32x4*)(oc + c) = kb;
            w.x = pk2(kb[0], kb[1]); w.y = pk2(kb[2], kb[3]); *(u32x2*)(ckv + (size_t)row * 512 + c) = w; }
    }
}

template <int L>
__device__ __forceinline__ void hgrn_cumsum(const float* G, int row0, int h, int lreal, float* Bs, float* tot, float (&gv)[L / 4]) {
    constexpr int SEG = L / 4;
    const int tid = ltid(), k = tid & 127, seg = tid >> 7;
    float run = 0.f;
#pragma unroll
    for (int i = 0; i < SEG; ++i) { const int t = seg * SEG + i; gv[i] = t < lreal ? G[(size_t)(row0 + t) * 1024 + h * 128 + k] : 0.f; }
#pragma unroll
    for (int i = 0; i < SEG; ++i) { run += gv[i]; Bs[(seg * SEG + i) * 128 + k] = run; }
    tot[seg * 128 + k] = run;
    __syncthreads();
    float off = 0.f;
#pragma unroll
    for (int s2 = 0; s2 < 3; ++s2) if (s2 < seg) off += tot[s2 * 128 + k];
#pragma unroll
    for (int i = 0; i < SEG; ++i) Bs[(seg * SEG + i) * 128 + k] += off;
    __syncthreads();
}
template <int L>
__device__ __forceinline__ void hgrn_a(int it, int bh, int row0, int lreal, const float* G, const bf16_t* VH, bf16_t* U, float* DD, unsigned char* lds) {
    constexpr int SEG = L / 4, ST = L + 8;
    const int tid = ltid(), lane = tid & 63, wave = tid >> 6, k = tid & 127, seg = tid >> 7, h = bh & 7;
    float* Bs = (float*)lds; float* tot = (float*)(lds + 32768);
    bf16_t* KDT = (bf16_t*)(lds + 34816); bf16_t* VT = (bf16_t*)(lds + 34816 + 128 * ST * 2);
    float gv[SEG]; bf16_t vraw[SEG];
#pragma unroll
    for (int i = 0; i < SEG; ++i) { const int s = seg * SEG + i; vraw[i] = s < lreal ? VH[(size_t)(row0 + s) * 1024 + h * 128 + k] : (bf16_t)0; }
    hgrn_cumsum<L>(G, row0, h, lreal, Bs, tot, gv);
    const float blast = Bs[(L - 1) * 128 + k];
#pragma unroll
    for (int i = 0; i < SEG; ++i) { const int s = seg * SEG + i;
        const float kd = (1.0f - __expf(gv[i])) * __expf(blast - Bs[s * 128 + k]);
        KDT[k * ST + s] = (bf16_t)(pk2(kd, 0.f) & 0xffffu);
        VT[k * ST + s] = vraw[i]; }
    if (seg == 0) DD[(size_t)it * 128 + k] = __expf(blast);
    __syncthreads();
    const int r = lane & 15, g = lane >> 4;
#pragma unroll
    for (int vt = 0; vt < 8; ++vt) {
        f32x4 acc = (f32x4){0.f, 0.f, 0.f, 0.f};
#pragma unroll
        for (int ks = 0; ks < L / 32; ++ks) {
            const bf16x8 a = *(const bf16x8*)(KDT + (16 * wave + r) * ST + 32 * ks + 8 * g);
            const bf16x8 b = *(const bf16x8*)(VT + (16 * vt + r) * ST + 32 * ks + 8 * g);
            acc = __builtin_amdgcn_mfma_f32_16x16x32_bf16(a, b, acc, 0, 0, 0);
        }
        bf16_t* up = U + (size_t)it * 16384 + (16 * wave + 4 * g) * 128 + 16 * vt + r;
        const unsigned p01 = pk2(acc[0], acc[1]), p23 = pk2(acc[2], acc[3]);
        up[0] = (bf16_t)(p01 & 0xffffu); up[128] = (bf16_t)(p01 >> 16); up[256] = (bf16_t)(p23 & 0xffffu); up[384] = (bf16_t)(p23 >> 16);
    }
    __syncthreads();
}
__device__ __forceinline__ void hgrn_b(const bf16_t* U, const float* DD, bf16_t* Sn, const float* st0, float* ostp, float* osts) {
    const int gt = blockIdx.x * 512 + ltid(), NGT = gridDim.x * 512;
#ifdef HB_TEST
    for (int e = gt; e < 16 * 16384; e += NGT) { const int bh = e >> 14, kv = e & 16383; ostp[e] = bf2f(U[((size_t)bh * 128 + 127) * 16384 + kv]); }
    for (int e = gt; e < 256 * 16384; e += NGT) { const int bh = e >> 14, kv = e & 16383; osts[e] = bf2f(U[((size_t)2048 + bh) * 16384 + kv]) + DD[((size_t)2048 + bh) * 128 + (kv >> 7)]; }
    return;
#endif
    for (int e = gt; e < 8 * 16384; e += NGT) {
        const int e1 = e + 8 * 16384;
        const int bh0 = e >> 14, kv0 = e & 16383, bh1 = e1 >> 14, kv1 = e1 & 16383;
        float S0 = 0.f, S1 = 0.f;
        const bf16_t* up0 = U + (size_t)bh0 * 128 * 16384 + kv0; const float* dp0 = DD + (size_t)bh0 * 128 * 128 + (kv0 >> 7); bf16_t* sp0 = Sn + (size_t)bh0 * 128 * 16384 + kv0;
        const bf16_t* up1 = U + (size_t)bh1 * 128 * 16384 + kv1; const float* dp1 = DD + (size_t)bh1 * 128 * 128 + (kv1 >> 7); bf16_t* sp1 = Sn + (size_t)bh1 * 128 * 16384 + kv1;
        for (int n0 = 0; n0 < 128; n0 += 16) {
            bf16_t ur0[16], ur1[16]; float dr0[16], dr1[16];
#pragma unroll
            for (int j = 0; j < 16; ++j) { ur0[j] = up0[(size_t)(n0 + j) * 16384]; dr0[j] = dp0[(n0 + j) * 128]; ur1[j] = up1[(size_t)(n0 + j) * 16384]; dr1[j] = dp1[(n0 + j) * 128]; }
#pragma unroll
            for (int j = 0; j < 16; ++j) { sp0[(size_t)(n0 + j) * 16384] = (bf16_t)(pk2(S0, 0.f) & 0xffffu); S0 = dr0[j] * S0 + bf2f(ur0[j]);
                                           sp1[(size_t)(n0 + j) * 16384] = (bf16_t)(pk2(S1, 0.f) & 0xffffu); S1 = dr1[j] * S1 + bf2f(ur1[j]); }
        }
        ostp[e] = S0; ostp[e1] = S1;
    }
    for (int e = gt; e < 256 * 16384; e += 8 * NGT) {
        float s0[8], dd[8]; bf16_t uu[8];
#pragma unroll
        for (int j = 0; j < 8; ++j) { const int ej = e + j * NGT; const int bh = ej >> 14, kv = ej & 16383; const size_t it = 2048 + bh;
            const bool ok = ej < 256 * 16384;
            s0[j] = ok ? st0[ej] : 0.f; dd[j] = ok ? DD[it * 128 + (kv >> 7)] : 0.f; uu[j] = ok ? U[it * 16384 + kv] : (bf16_t)0; }
#pragma unroll
        for (int j = 0; j < 8; ++j) { const int ej = e + j * NGT; const int bh = ej >> 14, kv = ej & 16383; const size_t it = 2048 + bh;
            if (ej < 256 * 16384) { Sn[it * 16384 + kv] = (bf16_t)(pk2(s0[j], 0.f) & 0xffffu); osts[ej] = dd[j] * s0[j] + bf2f(uu[j]); } }
    }
}
template <int L>
__device__ __forceinline__ void hgrn_c(int it, int bh, int row0, int lreal, const float* G, const bf16_t* QH, const bf16_t* VH, const bf16_t* GATE, const bf16_t* Sn, const float* ghg, bf16_t* MIX, unsigned char* lds) {
    constexpr int SEG = L / 4, VS = L + 8;
    const int tid = ltid(), lane = tid & 63, wave = tid >> 6, k = tid & 127, seg = tid >> 7, h = bh & 7;
    float* Bs = (float*)lds; float* tot = (float*)(lds + 32768);
    bf16_t* QT = (bf16_t*)(lds + 34816); bf16_t* KT = (bf16_t*)(lds + 52224); bf16_t* VT = (bf16_t*)(lds + 69632); bf16_t* ST = (bf16_t*)(lds + 88064);
    float gv[SEG];
    bf16_t qraw[SEG], vraw[SEG]; u32x4 sraw[4];
#pragma unroll
    for (int i = 0; i < SEG; ++i) { const int s = seg * SEG + i;
        qraw[i] = s < lreal ? QH[(size_t)(row0 + s) * 1024 + h * 128 + k] : (bf16_t)0;
        vraw[i] = s < lreal ? VH[(size_t)(row0 + s) * 1024 + h * 128 + k] : (bf16_t)0; }
#pragma unroll
    for (int i = 0; i < 4; ++i) sraw[i] = *(const u32x4*)(Sn + (size_t)it * 16384 + (size_t)k * 128 + (seg + 4 * i) * 8);
    hgrn_cumsum<L>(G, row0, h, lreal, Bs, tot, gv);
#pragma unroll
    for (int i = 0; i < SEG; ++i) { const int s = seg * SEG + i; const float bs = Bs[s * 128 + k];
        QT[s * 136 + k] = (bf16_t)(pk2(bf2f(qraw[i]) * __expf(bs), 0.f) & 0xffffu);
        KT[s * 136 + k] = (bf16_t)(pk2((1.0f - __expf(gv[i])) * __expf(-bs), 0.f) & 0xffffu);
        VT[k * VS + s] = vraw[i]; }
#pragma unroll
    for (int i = 0; i < 4; ++i) { const int kk = k, v0 = (seg + 4 * i) * 8;
        const unsigned w4[4] = {sraw[i].x, sraw[i].y, sraw[i].z, sraw[i].w};
#pragma unroll
        for (int e = 0; e < 4; ++e) { ST[(v0 + 2 * e) * 136 + kk] = (bf16_t)(w4[e] & 0xffffu); ST[(v0 + 2 * e + 1) * 136 + kk] = (bf16_t)(w4[e] >> 16); } }
    __syncthreads();
    const int tt = wave;
    if (tt * 16 < lreal) {
        const int r = lane & 15, g = lane >> 4;
        bf16x8 qf[4];
#pragma unroll
        for (int ks = 0; ks < 4; ++ks) qf[ks] = *(const bf16x8*)(QT + (16 * tt + r) * 136 + 32 * ks + 8 * g);
        bf16x8 pf[L / 32];
#pragma unroll
        for (int p = 0; p < L / 32; ++p) {
            unsigned pw[4];
#pragma unroll
            for (int hs = 0; hs < 2; ++hs) { const int st = 2 * p + hs;
                f32x4 acc = (f32x4){0.f, 0.f, 0.f, 0.f};
                if (st <= tt) {
#pragma unroll
                    for (int ks = 0; ks < 4; ++ks) { const bf16x8 a = *(const bf16x8*)(KT + (16 * st + r) * 136 + 32 * ks + 8 * g); acc = __builtin_amdgcn_mfma_f32_16x16x32_bf16(a, qf[ks], acc, 0, 0, 0); }
#pragma unroll
                    for (int e = 0; e < 4; ++e) if (16 * st + 4 * g + e > 16 * tt + r) acc[e] = 0.f;
                }
                pw[2 * hs] = pk2(acc[0], acc[1]); pw[2 * hs + 1] = pk2(acc[2], acc[3]); }
            u32x4 t4 = (u32x4){pw[0], pw[1], pw[2], pw[3]};
            pf[p] = __builtin_bit_cast(bf16x8, t4);
        }
        f32x4 o[8]; float ss = 0.f;
#pragma unroll
        for (int vt = 0; vt < 8; ++vt) {
            f32x4 acc = (f32x4){0.f, 0.f, 0.f, 0.f};
#pragma unroll
            for (int p = 0; p < L / 32; ++p) if (2 * p <= tt) {
                const u32x2 lo = *(const u32x2*)(VT + (16 * vt + r) * VS + 32 * p + 4 * g), hi = *(const u32x2*)(VT + (16 * vt + r) * VS + 32 * p + 16 + 4 * g);
                u32x4 t4 = (u32x4){lo.x, lo.y, hi.x, hi.y};
                acc = __builtin_amdgcn_mfma_f32_16x16x32_bf16(__builtin_bit_cast(bf16x8, t4), pf[p], acc, 0, 0, 0); }
#pragma unroll
            for (int ks = 0; ks < 4; ++ks) { const bf16x8 a = *(const bf16x8*)(ST + (16 * vt + r) * 136 + 32 * ks + 8 * g); acc = __builtin_amdgcn_mfma_f32_16x16x32_bf16(a, qf[ks], acc, 0, 0, 0); }
            o[vt] = acc; ss += (acc[0] * acc[0] + acc[1] * acc[1]) + (acc[2] * acc[2] + acc[3] * acc[3]);
        }
        ss += __shfl_xor(ss, 16); ss += __shfl_xor(ss, 32);
        const float rstd = 1.0f / sqrtf(ss * (1.0f / 128) + EPSN);
        const int t = 16 * tt + r;
        if (t < lreal) {
            const size_t row = (size_t)(row0 + t);
#pragma unroll
            for (int vt = 0; vt < 8; ++vt) { const int v0 = 16 * vt + 4 * g;
                const u32x2 gw2 = *(const u32x2*)(GATE + row * 1024 + h * 128 + v0); const f32x4 gh = *(const f32x4*)(ghg + v0);
                const float g0 = __uint_as_float(gw2.x << 16), g1 = __uint_as_float(gw2.x & 0xffff0000u), g2 = __uint_as_float(gw2.y << 16), g3 = __uint_as_float(gw2.y & 0xffff0000u);
                u32x2 w; w.x = pk2(o[vt][0] * rstd * gh[0] * g0, o[vt][1] * rstd * gh[1] * g1); w.y = pk2(o[vt][2] * rstd * gh[2] * g2, o[vt][3] * rstd * gh[3] * g3);
                *(u32x2*)(MIX + row * 2048 + 1024 + h * 128 + v0) = w; }
        }
    }
    __syncthreads();
}

template <int NKS, int NDT, int KSTR, int VSTR, bool QG, int NQF>
__device__ __forceinline__ void attn_step(const bf16x8 (&qf)[NQF], const bf16_t* qg, f32x4 (&o)[NDT], float& m, float& l, const LAS unsigned char* kimg, const LAS unsigned char* vimg, int lane, bool half_valid) {
    const int r = lane & 15, g = lane >> 4;
    f32x4 s0 = (f32x4){0.f, 0.f, 0.f, 0.f}, s1 = (f32x4){0.f, 0.f, 0.f, 0.f};
    const LAS unsigned char* kp = kimg + r * (KSTR * 2) + g * 16;
    if constexpr (QG) {
#pragma unroll 1
        for (int ks3 = 0; ks3 < NKS; ks3 += 3) {
#pragma unroll
            for (int k2 = 0; k2 < 3; ++k2) { const int ks = ks3 + k2;
                const bf16x8 a0 = *(const LAS bf16x8*)(kp + ks * 64), a1 = *(const LAS bf16x8*)(kp + 16 * KSTR * 2 + ks * 64);
                const bf16x8 qv = *(const bf16x8*)(qg + 32 * ks);
                s0 = __builtin_amdgcn_mfma_f32_16x16x32_bf16(a0, qv, s0, 0, 0, 0);
                s1 = __builtin_amdgcn_mfma_f32_16x16x32_bf16(a1, qv, s1, 0, 0, 0); }
        }
    } else {
#pragma unroll
        for (int ks = 0; ks < NKS; ++ks) {
            const bf16x8 a0 = *(const LAS bf16x8*)(kp + ks * 64), a1 = *(const LAS bf16x8*)(kp + 16 * KSTR * 2 + ks * 64);
            s0 = __builtin_amdgcn_mfma_f32_16x16x32_bf16(a0, qf[ks], s0, 0, 0, 0);
            s1 = __builtin_amdgcn_mfma_f32_16x16x32_bf16(a1, qf[ks], s1, 0, 0, 0);
        }
    }
    if (half_valid) s1 = (f32x4){-INFINITY, -INFINITY, -INFINITY, -INFINITY};
    float mx = fmaxf(fmaxf(fmaxf(s0[0], s0[1]), fmaxf(s0[2], s0[3])), fmaxf(fmaxf(s1[0], s1[1]), fmaxf(s1[2], s1[3])));
    mx = fmaxf(mx, __shfl_xor(mx, 16)); mx = fmaxf(mx, __shfl_xor(mx, 32));
    const float mn = fmaxf(m, mx), alpha = exp2f(m - mn);
    f32x4 p0, p1;
#pragma unroll
    for (int e = 0; e < 4; ++e) { p0[e] = exp2f(s0[e] - mn); p1[e] = exp2f(s1[e] - mn); }
    float ls = (p0[0] + p0[1]) + (p0[2] + p0[3]) + (p1[0] + p1[1]) + (p1[2] + p1[3]);
    ls += __shfl_xor(ls, 16); ls += __shfl_xor(ls, 32);
    l = l * alpha + ls; m = mn;
    u32x4 pw = (u32x4){pk2(p0[0], p0[1]), pk2(p0[2], p0[3]), pk2(p1[0], p1[1]), pk2(p1[2], p1[3])};
    const bf16x8 pf = __builtin_bit_cast(bf16x8, pw);
    const LAS unsigned char* vp = vimg + r * (VSTR * 2) + g * 8;
#pragma unroll
    for (int dt = 0; dt < NDT; ++dt) {
        const u32x2 lo = *(const LAS u32x2*)(vp + dt * 16 * VSTR * 2), hi = *(const LAS u32x2*)(vp + dt * 16 * VSTR * 2 + 32);
        u32x4 t4 = (u32x4){lo.x, lo.y, hi.x, hi.y};
        o[dt] = __builtin_amdgcn_mfma_f32_16x16x32_bf16(__builtin_bit_cast(bf16x8, t4), pf, o[dt] * alpha, 0, 0, 0);
        if ((dt & 3) == 3) __builtin_amdgcn_sched_barrier(0);
    }
}

typedef float f32x16 __attribute__((ext_vector_type(16)));
__device__ __forceinline__ void attn_prompt_item(int b, int h, int qb, const bf16_t* Q, const bf16_t* KN, const bf16_t* KPE, const bf16_t* VT, bf16_t* MIX, LAS unsigned char* lds) {
    constexpr int KSTR = 200, VSTR = 72, KIMG = 64 * KSTR * 2, BUFB = KIMG + 128 * VSTR * 2;
    const int tid = ltid(), lane = tid & 63, wave = tid >> 6, r = lane & 31, hh = lane >> 5;
    const int nkt = 4 * qb + 4, nkw = 4 * qb + (wave >> 1) + 1;
    const size_t qrow = (size_t)b * 8192 + 256 * qb + 32 * wave + r;
    bf16x8 qf[12];
#pragma unroll
    for (int ks = 0; ks < 12; ++ks) qf[ks] = *(const bf16x8*)(Q + qrow * 1536 + h * 192 + 16 * ks + 8 * hh);
    f32x16 o[4];
#pragma unroll
    for (int dt = 0; dt < 4; ++dt)
#pragma unroll
        for (int i = 0; i < 16; ++i) o[dt][i] = 0.f;
    float m = -INFINITY, l = 0.f;
    const bf16_t* kn_src = KN + ((size_t)b * 8192 + (tid >> 4)) * 1024 + h * 128 + 8 * (tid & 15);
    const bf16_t* kp_src = KPE + ((size_t)b * 8192 + (tid >> 3)) * 64 + 8 * (tid & 7);
    const bf16_t* vt_src = VT + ((size_t)h * 128 + (tid >> 3)) * 16384 + (size_t)b * 8192 + 8 * (tid & 7);
    const int wk = (tid >> 4) * (KSTR * 2) + (tid & 15) * 16, wp = (tid >> 3) * (KSTR * 2) + 256 + (tid & 7) * 16, wv = KIMG + (tid >> 3) * (VSTR * 2) + ((tid & 7) >> 1) * 32 + ((tid & 7) & 1) * 8;
    u32x4 ak0, ak1, ap, av0, av1;
#define AT_LOAD(S_, t) do { S_##k0 = *(const u32x4*)(kn_src + (size_t)(t) * 64 * 1024); S_##k1 = *(const u32x4*)(kn_src + ((size_t)(t) * 64 + 32) * 1024); S_##p = *(const u32x4*)(kp_src + (size_t)(t) * 64 * 64); \
        S_##v0 = *(const u32x4*)(vt_src + (t) * 64); S_##v1 = *(const u32x4*)(vt_src + (size_t)64 * 16384 + (t) * 64); } while (0)
#define AT_STORE(S_, t) do { const int bo_ = ((t) & 1) * BUFB; *(LAS u32x4*)(lds + bo_ + wk) = S_##k0; *(LAS u32x4*)(lds + bo_ + wk + 32 * KSTR * 2) = S_##k1; *(LAS u32x4*)(lds + bo_ + wp) = S_##p; \
        *(LAS u32x2*)(lds + bo_ + wv) = (u32x2){S_##v0.x, S_##v0.y}; *(LAS u32x2*)(lds + bo_ + wv + 16) = (u32x2){S_##v0.z, S_##v0.w}; \
        *(LAS u32x2*)(lds + bo_ + wv + 64 * VSTR * 2) = (u32x2){S_##v1.x, S_##v1.y}; *(LAS u32x2*)(lds + bo_ + wv + 64 * VSTR * 2 + 16) = (u32x2){S_##v1.z, S_##v1.w}; } while (0)
#define AT_SUB(kt, u) do { \
            const LAS unsigned char* kimg = lds + ((kt) & 1) * BUFB + (u) * 32 * KSTR * 2; const LAS unsigned char* vimg = lds + ((kt) & 1) * BUFB + KIMG + (u) * 64; \
            f32x16 sc; \
            _Pragma("unroll") for (int i = 0; i < 16; ++i) sc[i] = 0.f; \
            const LAS unsigned char* kp = kimg + r * (KSTR * 2) + hh * 16; \
            _Pragma("unroll") for (int ks = 0; ks < 12; ++ks) { const bf16x8 a = *(const LAS bf16x8*)(kp + ks * 32); sc = __builtin_amdgcn_mfma_f32_32x32x16_bf16(a, qf[ks], sc, 0, 0, 0); } \
            float mx = sc[0]; \
            _Pragma("unroll") for (int i = 1; i < 16; ++i) mx = fmaxf(mx, sc[i]); \
            mx = fmaxf(mx, __shfl_xor(mx, 32)); \
            const float mn = fmaxf(m, mx), alpha = __builtin_amdgcn_exp2f(m - mn); \
            float ls = 0.f; \
            _Pragma("unroll") for (int i = 0; i < 16; ++i) { sc[i] = __builtin_amdgcn_exp2f(sc[i] - mn); ls += sc[i]; } \
            ls += __shfl_xor(ls, 32); \
            l = l * alpha + ls; m = mn; \
            bf16x8 pf[2]; \
            _Pragma("unroll") for (int s2 = 0; s2 < 2; ++s2) { u32x4 pw = (u32x4){pk2(sc[8 * s2], sc[8 * s2 + 1]), pk2(sc[8 * s2 + 2], sc[8 * s2 + 3]), pk2(sc[8 * s2 + 4], sc[8 * s2 + 5]), pk2(sc[8 * s2 + 6], sc[8 * s2 + 7])}; pf[s2] = __builtin_bit_cast(bf16x8, pw); } \
            const LAS unsigned char* vp = vimg + r * (VSTR * 2) + hh * 16; \
            _Pragma("unroll") for (int dt = 0; dt < 4; ++dt) { \
                f32x16 acc = o[dt] * alpha; \
                _Pragma("unroll") for (int s2 = 0; s2 < 2; ++s2) { \
                    const bf16x8 va = *(const LAS bf16x8*)(vp + dt * 32 * VSTR * 2 + s2 * 32); \
                    acc = __builtin_amdgcn_mfma_f32_32x32x16_bf16(va, pf[s2], acc, 0, 0, 0); } \
                o[dt] = acc; } } while (0)
#define AT_COMPUTE(kt) do { if ((kt) < nkw) { AT_SUB(kt, 0); AT_SUB(kt, 1); } } while (0)
    AT_LOAD(a, 0); AT_STORE(a, 0); AT_LOAD(a, 1);
    __syncthreads();
    for (int kt = 0; kt < nkt; ++kt) {
        AT_COMPUTE(kt);
        if (kt + 1 < nkt) AT_STORE(a, kt + 1);
        if (kt + 2 < nkt) AT_LOAD(a, kt + 2);
        __syncthreads();
    }
#undef AT_LOAD
#undef AT_STORE
#undef AT_SUB
#undef AT_COMPUTE
    const float inv = 1.0f / l;
#pragma unroll
    for (int dt = 0; dt < 4; ++dt)
#pragma unroll
        for (int ig = 0; ig < 4; ++ig) { u32x2 w; w.x = pk2(o[dt][4 * ig] * inv, o[dt][4 * ig + 1] * inv); w.y = pk2(o[dt][4 * ig + 2] * inv, o[dt][4 * ig + 3] * inv);
            *(u32x2*)(MIX + qrow * 2048 + h * 128 + 32 * dt + 8 * ig + 4 * hh) = w; }
}

constexpr int NSPL = 8;
__device__ __forceinline__ void attn_sample_item(int b, int sp, const bf16_t* Q, const bf16_t* WUKO, const float* cckv, const float* ckpe, const bf16_t* CKV, const bf16_t* KPE, bf16_t* QLAT, bf16_t* PO, float* PML, LAS unsigned char* lds) {
    constexpr int KSTR = 584, VSTR = 36;
    const int tid = ltid(), lane = tid & 63, h = tid >> 6, r = lane & 15, g = lane >> 4;
    LAS unsigned char* kimg = lds; LAS unsigned char* vimg = lds + 32 * KSTR * 2;
    const size_t qrow0 = (size_t)MP + (size_t)b * 16;
    bf16_t* ql = QLAT + ((size_t)b * 8 + h) * 16 * 576;
    {
        bf16x8 aq[4];
#pragma unroll
        for (int ks = 0; ks < 4; ++ks) aq[ks] = *(const bf16x8*)(Q + (qrow0 + r) * 1536 + h * 192 + 32 * ks + 8 * g);
#pragma unroll 8
        for (int ct = 0; ct < 32; ++ct) {
            f32x4 acc = (f32x4){0.f, 0.f, 0.f, 0.f};
#pragma unroll
            for (int ks = 0; ks < 4; ++ks) { const bf16x8 bw = *(const bf16x8*)(WUKO + (size_t)(16 * ct + r) * 1024 + h * 128 + 32 * ks + 8 * g); acc = __builtin_amdgcn_mfma_f32_16x16x32_bf16(bw, aq[ks], acc, 0, 0, 0); }
            u32x2 w; w.x = pk2(acc[0], acc[1]); w.y = pk2(acc[2], acc[3]);
            *(u32x2*)(ql + r * 576 + 16 * ct + 4 * g) = w;
        }
#pragma unroll
        for (int i = 0; i < 2; ++i) { const int pc = lane + 64 * i, qq = pc >> 3, cc = pc & 7;
            *(u32x4*)(ql + qq * 576 + 512 + 8 * cc) = *(const u32x4*)(Q + (qrow0 + qq) * 1536 + h * 192 + 128 + 8 * cc); }
    }
    __threadfence(); __syncthreads();
    const bf16_t* qg = ql + r * 576 + 8 * g;
    f32x4 o[32];
#pragma unroll
    for (int dt = 0; dt < 32; ++dt) o[dt] = (f32x4){0.f, 0.f, 0.f, 0.f};
    float m = -INFINITY, l = 0.f;
    const float* cb = cckv + (size_t)b * 2048 * 512; const float* pb = ckpe + (size_t)b * 2048 * 64;
    const int kt0 = sp * 8, kt1 = (sp == NSPL - 1) ? 65 : kt0 + 8;
    for (int kt = kt0; kt < kt1; ++kt) {
        __syncthreads();
        if (kt < 64) {
            const int c = tid;
            float v[32];
#pragma unroll
            for (int kk = 0; kk < 32; ++kk) v[kk] = cb[(size_t)(32 * kt + kk) * 512 + c];
            const int key = tid >> 4, i4 = (tid & 15) * 4; const f32x4 pv = *(const f32x4*)(pb + (size_t)(32 * kt + key) * 64 + i4);
#pragma unroll
            for (int kk = 0; kk < 32; kk += 2) {
                const unsigned pw = pk2(v[kk], v[kk + 1]);
                *(LAS bf16_t*)(kimg + kk * (KSTR * 2) + c * 2) = (bf16_t)(pw & 0xffffu);
                *(LAS bf16_t*)(kimg + (kk + 1) * (KSTR * 2) + c * 2) = (bf16_t)(pw >> 16);
                *(LAS unsigned*)(vimg + c * (VSTR * 2) + kk * 2) = pw;
            }
#pragma unroll
            for (int e = 0; e < 4; ++e) { const int i = i4 + e, pi = i < 32 ? 2 * i : 2 * (i - 32) + 1;
                *(LAS bf16_t*)(kimg + key * (KSTR * 2) + (512 + pi) * 2) = (bf16_t)(pk2(pv[e], 0.f) & 0xffffu); }
        } else {
            const int c = tid;
#pragma unroll 4
            for (int kk = 0; kk < 32; kk += 2) {
                unsigned pw = 0u;
                if (kk < 16) { const unsigned a = CKV[(qrow0 + kk) * 512 + c], bb = CKV[(qrow0 + kk + 1) * 512 + c]; pw = a | (bb << 16); }
                *(LAS bf16_t*)(kimg + kk * (KSTR * 2) + c * 2) = (bf16_t)(pw & 0xffffu);
                *(LAS bf16_t*)(kimg + (kk + 1) * (KSTR * 2) + c * 2) = (bf16_t)(pw >> 16);
                *(LAS unsigned*)(vimg + c * (VSTR * 2) + kk * 2) = pw;
            }
            { const int key = tid >> 4, i4 = (tid & 15) * 4;
              u32x2 w = (u32x2){0u, 0u}; if (key < 16) w = *(const u32x2*)(KPE + (qrow0 + key) * 64 + i4);
              *(LAS u32x2*)(kimg + key * (KSTR * 2) + (512 + i4) * 2) = w; }
        }
        bf16x8 qv[18];
#pragma unroll
        for (int ks = 0; ks < 18; ++ks) qv[ks] = *(const bf16x8*)(qg + 32 * ks);
        __syncthreads();
        attn_step<18, 32, KSTR, VSTR, false, 18>(qv, nullptr, o, m, l, kimg, vimg, lane, kt == 64);
    }
    const float inv = 1.0f / l;
    const size_t pi = (((size_t)b * NSPL + sp) * 8 + h) * 16 + r;
    bf16_t* po = PO + pi * 512 + 4 * g;
#pragma unroll
    for (int dt = 0; dt < 32; ++dt) { u32x2 w; w.x = pk2(o[dt][0] * inv, o[dt][1] * inv); w.y = pk2(o[dt][2] * inv, o[dt][3] * inv); *(u32x2*)(po + 16 * dt) = w; }
    if (g == 0) *(f32x2*)(PML + pi * 2) = (f32x2){m, l};
    __syncthreads();
}
__device__ __forceinline__ void attn_sample_combine(int b, int h, const bf16_t* PO, const float* PML, const bf16_t* WUVT, bf16_t* MIX, LAS unsigned char* lds) {
    const int tid = ltid(), lane = tid & 63, wave = tid >> 6, r = lane & 15, g = lane >> 4;
    float ms[NSPL], cs[NSPL], M = -INFINITY, L = 0.f;
#pragma unroll
    for (int sp = 0; sp < NSPL; ++sp) { const f32x2 ml = *(const f32x2*)(PML + ((((size_t)b * NSPL + sp) * 8 + h) * 16 + r) * 2); ms[sp] = ml.x; cs[sp] = ml.y; M = fmaxf(M, ml.x); }
#pragma unroll
    for (int sp = 0; sp < NSPL; ++sp) { cs[sp] *= __builtin_amdgcn_exp2f(ms[sp] - M); L += cs[sp]; }
    const float invL = 1.0f / L;
#pragma unroll
    for (int sp = 0; sp < NSPL; ++sp) cs[sp] *= invL;
#pragma unroll
    for (int s2 = 0; s2 < 2; ++s2) { const int s = 2 * wave + s2;
        f32x4 a0 = (f32x4){0.f, 0.f, 0.f, 0.f}, a1 = (f32x4){0.f, 0.f, 0.f, 0.f};
#pragma unroll
        for (int sp = 0; sp < NSPL; ++sp) {
            const bf16_t* po = PO + ((((size_t)b * NSPL + sp) * 8 + h) * 16 + r) * 512 + 32 * s + 4 * g;
            const u32x2 w0 = *(const u32x2*)po, w1 = *(const u32x2*)(po + 16);
            a0 += cs[sp] * (f32x4){__uint_as_float(w0.x << 16), __uint_as_float(w0.x & 0xffff0000u), __uint_as_float(w0.y << 16), __uint_as_float(w0.y & 0xffff0000u)};
            a1 += cs[sp] * (f32x4){__uint_as_float(w1.x << 16), __uint_as_float(w1.x & 0xffff0000u), __uint_as_float(w1.y << 16), __uint_as_float(w1.y & 0xffff0000u)};
        }
        *(LAS u32x4*)(lds + (s * 64 + lane) * 16) = (u32x4){pk2(a0[0], a0[1]), pk2(a0[2], a0[3]), pk2(a1[0], a1[1]), pk2(a1[2], a1[3])};
    }
    __syncthreads();
    const size_t qrow0 = (size_t)MP + (size_t)b * 16;
    const int dt = wave;
    f32x4 acc = (f32x4){0.f, 0.f, 0.f, 0.f};
    const bf16_t* wp = WUVT + (size_t)(h * 128 + 16 * dt + r) * 512 + 4 * g;
#pragma unroll
    for (int s = 0; s < 16; ++s) {
        const u32x2 lo = *(const u32x2*)(wp + 32 * s), hi = *(const u32x2*)(wp + 32 * s + 16);
        u32x4 t4 = (u32x4){lo.x, lo.y, hi.x, hi.y};
        const bf16x8 pf = *(const LAS bf16x8*)(lds + (s * 64 + lane) * 16);
        acc = __builtin_amdgcn_mfma_f32_16x16x32_bf16(__builtin_bit_cast(bf16x8, t4), pf, acc, 0, 0, 0);
    }
    u32x2 w; w.x = pk2(acc[0], acc[1]); w.y = pk2(acc[2], acc[3]);
    *(u32x2*)(MIX + (qrow0 + r) * 2048 + h * 128 + 16 * dt + 4 * g) = w;
    __syncthreads();
}

#define XB_TMO      128
#define XB_XCNT(j)  (256  + 64 * (j))
#define XB_XSUB(j)  (1280 + 64 * (j))
#define XB_XGEN(j)  (2304 + 64 * (j))
#define XB_TOP      3328
#define XB_TOPGEN   3392
#define XCD_BAR_WORDS 3456
#define XB_SPIN_CAP (1u << 18)
__device__ __forceinline__ unsigned xb_ld(unsigned* p)              { return __hip_atomic_load(p, __ATOMIC_RELAXED, __HIP_MEMORY_SCOPE_AGENT); }
__device__ __forceinline__ unsigned xb_add(unsigned* p, unsigned v) { return __hip_atomic_fetch_add(p, v, __ATOMIC_RELAXED, __HIP_MEMORY_SCOPE_AGENT); }
__device__ __forceinline__ unsigned xb_xcc_id() { return (unsigned)__builtin_amdgcn_s_getreg((3 << 11) | 20) & 0xFu; }
#define XB_SPIN(cond, bar) do { unsigned _sp = 0; while (cond) { __builtin_amdgcn_s_sleep(1); \
    if ((++_sp & 255u) == 0u) { if (xb_ld(&(bar)[XB_TMO])) break; if (_sp > XB_SPIN_CAP) { atomicAdd(&(bar)[XB_TMO], 1u); break; } } } } while (0)
struct XcdBarrier { unsigned* bar; unsigned x; volatile LAS unsigned* st; };
__device__ __forceinline__ XcdBarrier xcd_barrier_post(unsigned* bar, volatile LAS unsigned* st) {
    XcdBarrier b; b.bar = bar; b.x = xb_xcc_id(); b.st = st;
    if (threadIdx.x == 0) (void)xb_add(&bar[XB_XCNT(b.x)], 1u);
    return b;
}
__device__ __forceinline__ void xcd_barrier_complete(unsigned* bar, unsigned x, unsigned& nloc, unsigned& nx) {
    const unsigned G = gridDim.x * gridDim.y * gridDim.z;
    unsigned sum, cnt, mine, sp = 0u;
    for (;;) {
        sum = 0u; cnt = 0u; mine = 0u;
#pragma unroll
        for (unsigned j = 0; j < 16; ++j) { const unsigned c = xb_ld(&bar[XB_XCNT(j)]); sum += c; cnt += (c > 0u) ? 1u : 0u; mine = (j == x) ? c : mine; }
        if (sum == G) break;
        __builtin_amdgcn_s_sleep(1);
        if ((++sp & 255u) == 0u) { if (xb_ld(&bar[XB_TMO])) break; if (sp > XB_SPIN_CAP) { atomicAdd(&bar[XB_TMO], 1u); break; } }
    }
    nloc = mine > 0u ? mine : 1u; nx = cnt > 0u ? cnt : 1u;
}
__device__ __forceinline__ void xcd_barrier(const XcdBarrier& b) {
    asm volatile("s_waitcnt vmcnt(0)" ::: "memory");
    __syncthreads();
    if (threadIdx.x == 0) {
        unsigned* bar = b.bar;
        __builtin_amdgcn_s_waitcnt(0);
        unsigned nloc = b.st[0], nx = b.st[1];
        if (nloc == 0u) { xcd_barrier_complete(bar, b.x, nloc, nx); b.st[0] = nloc; b.st[1] = nx; }
        const unsigned old = xb_add(&bar[XB_XSUB(b.x)], 1u);
        const unsigned gen = old / nloc;
        if (old + 1u == (gen + 1u) * nloc) {
            __builtin_amdgcn_fence(__ATOMIC_RELEASE, "agent");
            asm volatile("s_waitcnt vmcnt(0)" ::: "memory");
            const unsigned og = xb_add(&bar[XB_TOP], 1u);
            const unsigned tg = og / nx;
            if (og + 1u == (tg + 1u) * nx) xb_add(&bar[XB_TOPGEN], 1u);
            else XB_SPIN(xb_ld(&bar[XB_TOPGEN]) == tg, bar);
            __builtin_amdgcn_fence(__ATOMIC_ACQUIRE, "agent");
            xb_add(&bar[XB_XGEN(b.x)], 1u);
            asm volatile("s_waitcnt vmcnt(0)" ::: "memory");
        } else {
            XB_SPIN(xb_ld(&bar[XB_XGEN(b.x)]) == gen, bar);
            __builtin_amdgcn_fence(__ATOMIC_ACQUIRE, "agent");
            asm volatile("s_waitcnt vmcnt(0)" ::: "memory");
        }
    }
    __syncthreads();
}

__device__ __forceinline__ void gsync(cg::grid_group& grid) {
    asm volatile("s_waitcnt vmcnt(0) lgkmcnt(0)" ::: "memory");
    grid.sync();
    __builtin_amdgcn_fence(__ATOMIC_ACQUIRE, "agent");
    asm volatile("s_waitcnt vmcnt(0)" ::: "memory");
}
struct Params { const float* in[21]; float* out; unsigned char* ws; };

__global__ void __launch_bounds__(512) mega(Params p) {
    extern __shared__ __attribute__((aligned(16))) unsigned char lds[];
    cg::grid_group grid = cg::this_grid();
    LAS unsigned char* ldsl = (LAS unsigned char*)lds;
    unsigned char* ws = p.ws; float* out = p.out; unsigned char* outb = (unsigned char*)p.out;
    const int G = gridDim.x, bx = blockIdx.x, tid = threadIdx.x;
    float* MOD = (float*)(ws + WS_MOD); const float* bada = p.in[8];
    const f32x2* ROPE = (const f32x2*)(ws + WS_ROPE);
    bf16_t* H = (bf16_t*)(ws + WS_H);
    float* Gb = (float*)(outb + OB_G); bf16_t* QH = (bf16_t*)(outb + OB_QH); bf16_t* VH = (bf16_t*)(outb + OB_VH);
    bf16_t* GATE = (bf16_t*)(ws + WS_GATE); bf16_t* KPE = (bf16_t*)(ws + WS_KPE); float* CQKV = (float*)(ws + WS_CQKV);
    bf16_t* Qb = (bf16_t*)(ws + WS_Q); bf16_t* CQN = (bf16_t*)(ws + WS_CQN); bf16_t* QLAT = (bf16_t*)(ws + WS_QLAT); bf16_t* CKV = (bf16_t*)(ws + WS_CKV);
    bf16_t* U = (bf16_t*)(ws + WS_U); bf16_t* MIX = (bf16_t*)(ws + WS_MIX); float* DD = (float*)(ws + WS_DD); bf16_t* Sn = (bf16_t*)(ws + WS_S);
    bf16_t* KN = (bf16_t*)(ws + WS_KN); bf16_t* VT = (bf16_t*)(ws + WS_VT); bf16_t* FFH = (bf16_t*)(ws + WS_FFH);
    float* X = out + O_Y;
    pg8::StaticOrder S;
    volatile LAS unsigned* xst = (volatile LAS unsigned*)(ldsl + LDS_Q + 16);
    if (tid == 0) { xst[0] = 0u; xst[1] = 0u; }
    __syncthreads();
    const XcdBarrier xbar = xcd_barrier_post((unsigned*)(ws + WS_BAR), xst);

#ifdef FILLTEST
    for (size_t i = (size_t)bx * 512 + tid; i < 48791552; i += (size_t)G * 512) out[i] = 0.5f;
#endif
    if (PHMASK & 1) phase0(p.in, ws, lds);
#ifdef PROBE_P0
    gsync(grid);
    phase0(p.in, ws, lds);
#endif
    xcd_barrier(xbar);
#ifdef PROBE_SYNC
    for (int z = 0; z < 10; ++z) xcd_barrier(xbar);
#endif
    if (PHMASK & 2) adaln_rows<0>((float*)lds, p.in[0], p.in[1], MOD, bada, 0, 2048, H);
    xcd_barrier(xbar);
    if (PHMASK & 4) { EpiIn E{CQKV, QH, Gb, VH, GATE, KPE, ROPE, out + O_KPE_P, out + O_KPE_S, p.in[15]};
      S.init(MT, NINP, 2048, G, bx); pg8::gemm_phase(ldsl, pg8::Gemm{H, (const bf16_t*)(ws + WS_WIN), MT, NINP, 2048}, S, E); }
    if (G == 256 && bx >= (MT / 256) * (NINP / 256) - 5 * 256) {
        __syncthreads();
        transposes_range(p.in, ws, lds, TR_NIT - 128 * 64, TR_NIT, (bx - 106) * 8 + (tid >> 6), 150 * 8);
    }
    xcd_barrier(xbar);
    if (PHMASK & 8) latent_rows(CQKV, p.in[11], p.in[12], CQN, CKV, out + O_CKV_P, out + O_CKV_S);
    if (PHMASK & 16) for (int it = bx; it < NCHUNK; it += G) {
        if (it < NCHUNK_P) hgrn_a<64>(it, it >> 7, (it >> 10) * 8192 + (it & 127) * 64, 64, Gb, VH, U, DD, lds);
        else hgrn_a<32>(it, it - NCHUNK_P, MP + ((it - NCHUNK_P) >> 3) * 16, 16, Gb, VH, U, DD, lds);
    }
#ifdef PROBE_MISC
    xcd_barrier(xbar);
    latent_rows(CQKV, p.in[11], p.in[12], CQN, CKV, out + O_CKV_P, out + O_CKV_S);
    for (int it = bx; it < NCHUNK; it += G) {
        if (it < NCHUNK_P) hgrn_a<64>(it, it >> 7, (it >> 10) * 8192 + (it & 127) * 64, 64, Gb, VH, U, DD, lds);
        else hgrn_a<32>(it, it - NCHUNK_P, MP + ((it - NCHUNK_P) >> 3) * 16, 16, Gb, VH, U, DD, lds);
    }
#endif
    xcd_barrier(xbar);
    if (PHMASK & 32) { EpiQ E{Qb, ROPE}; S.init(MT, 1536, 512, G, bx); pg8::gemm_phase(ldsl, pg8::Gemm{CQN, (const bf16_t*)(ws + WS_WUQ), MT, 1536, 512}, S, E); }
    if (PHMASK & 32) { EpiPlain E{KN, 1024}; S.init(MP, 1024, 512, G, bx); pg8::gemm_phase(ldsl, pg8::Gemm{CKV, (const bf16_t*)(ws + WS_WUK), MP, 1024, 512}, S, E); }
    if (PHMASK & 32) { EpiPlain E{VT, 16384}; S.init(1024, MP, 512, G, bx); pg8::gemm_phase(ldsl, pg8::Gemm{(const bf16_t*)(ws + WS_WUV), CKV, 1024, MP, 512}, S, E); }
    if (PHMASK & 64) hgrn_b(U, DD, Sn, p.in[6], out + O_ST_P, out + O_ST_S);
#ifdef PROBE_MISC
    xcd_barrier(xbar);
    hgrn_b(U, DD, Sn, p.in[6], out + O_ST_P, out + O_ST_S);
#endif
    xcd_barrier(xbar);
    for (int p5rep = 0; p5rep < P5REPS; ++p5rep) {
    if (p5rep) xcd_barrier(xbar);
    if (PHMASK & 0x380) {
        unsigned* ctr = (unsigned*)(ws + WS_CTL) + p5rep * 64;
        volatile int* qslot = (volatile int*)(lds + LDS_Q);
        for (;;) {
            __syncthreads();
            if (tid == 0) *qslot = (int)__hip_atomic_fetch_add(ctr, 1u, __ATOMIC_RELAXED, __HIP_MEMORY_SCOPE_AGENT);
            __syncthreads();
            const int it = *qslot;
            if (it >= 256 + 512 + NCHUNK) break;
            const int pm_ = p5rep ? (P5MASK2) : 0x380;
            if (it < 256) { if (pm_ & 128) attn_sample_item(it >> 3, it & 7, Qb, (const bf16_t*)(ws + WS_WUKO), p.in[4], p.in[5], CKV, KPE, QLAT, (bf16_t*)(ws + WS_PO), (float*)(ws + WS_PML), ldsl); }
            else if (it < 256 + 512) { if (pm_ & 256) { const int j = it - 256, qb = 31 - (j >> 4), bh = j & 15; attn_prompt_item(bh >> 3, bh & 7, qb, Qb, KN, KPE, VT, MIX, ldsl); } }
            else if (pm_ & 512) { const int c = it - 768;
                if (c < NCHUNK_P) hgrn_c<64>(c, c >> 7, (c >> 10) * 8192 + (c & 127) * 64, 64, Gb, QH, VH, GATE, Sn, p.in[16], MIX, lds);
                else hgrn_c<32>(c, c - NCHUNK_P, MP + ((c - NCHUNK_P) >> 3) * 16, 16, Gb, QH, VH, GATE, Sn, p.in[16], MIX, lds); }
        }
    }
    }
    xcd_barrier(xbar);
    for (int ci = bx; ci < 256; ci += G) attn_sample_combine(ci >> 3, ci & 7, (const bf16_t*)(ws + WS_PO), (const float*)(ws + WS_PML), (const bf16_t*)(ws + WS_WUV), MIX, ldsl);
    xcd_barrier(xbar);
    if (PHMASK & 1024) { EpiRes E{p.in[0], p.in[1], X, MOD, bada, 4096, (float*)(ws + WS_CQKV)}; if (G == 256) S.init(MP, 2048, 2048, G, bx, 8, 64, 16); else S.init(MT, 2048, 2048, G, bx); pg8::gemm_phase(ldsl, pg8::Gemm{MIX, (const bf16_t*)(ws + WS_WOUT), MT, 2048, 2048}, S, E); }
    xcd_barrier(xbar);
    if (G == 256) {
        adaln_rows<8, 2>((float*)lds, X, p.in[1], MOD, bada, 6144, 8192, H, (const float*)(ws + WS_CQKV), 4096, X);
        xcd_barrier(xbar);
        if (bx < 64) { EpiRelu2 E{FFH + (size_t)MP * DFF}; S.init(MS, DFF, 2048, 64, bx); pg8::gemm_phase(ldsl, pg8::Gemm{H + (size_t)MP * DM, (const bf16_t*)(ws + WS_WFF1), MS, DFF, 2048}, S, E); }
        else adaln_rows<0, 1>((float*)lds, X, p.in[1], MOD, bada, 6144, 8192, H, nullptr, 0, nullptr, 64, 192);
        xcd_barrier(xbar);
        { EpiRelu2 E{FFH}; S.init(MP, DFF, 2048, G, bx); pg8::gemm_phase(ldsl, pg8::Gemm{H, (const bf16_t*)(ws + WS_WFF1), MP, DFF, 2048}, S, E); }
    } else {
        adaln_rows<0>((float*)lds, X, X + (size_t)MP * DM, MOD, bada, 6144, 8192, H);
        xcd_barrier(xbar);
        { EpiRelu2 E{FFH}; S.init(MT, DFF, 2048, G, bx); pg8::gemm_phase(ldsl, pg8::Gemm{H, (const bf16_t*)(ws + WS_WFF1), MT, DFF, 2048}, S, E); }
    }
    xcd_barrier(xbar);
    if (PHMASK & 8192) { EpiRes E{X, X + (size_t)MP * DM, X, MOD, bada, 10240, (float*)(ws + WS_H)}; if (G == 256) S.init(MP, 2048, DFF, G, bx, 16, 64, 16); else S.init(MT, 2048, DFF, G, bx); pg8::gemm_phase(ldsl, pg8::Gemm{FFH, (const bf16_t*)(ws + WS_WFF2), MT, 2048, DFF}, S, E); }
    xcd_barrier(xbar);
    if (PHMASK & 16384) { if (G == 256) final_rows<16>((float*)lds, X, p.in[20], (const float*)(ws + WS_H), MOD, bada); else final_rows<0>((float*)lds, X, p.in[20], nullptr, MOD, bada); }
}

extern "C" void kernel_launch(void* const* d_in, const int* in_sizes, int n_in, void* d_out, int out_size, void* d_ws, size_t ws_size, hipStream_t stream) {
    static int grid_blocks = 0;
    if (grid_blocks == 0) {
        if (n_in != 21 || ws_size < WS_TOTAL) { fprintf(stderr, "kernel_launch: unexpected n_in %d or workspace %zu < %zu\n", n_in, ws_size, (size_t)WS_END); grid_blocks = -1; return; }
        int dev = 0, cus = 0, per_cu = 0;
        hipGetDevice(&dev);
        hipDeviceGetAttribute(&cus, hipDeviceAttributeMultiprocessorCount, dev);
        if (hipFuncSetAttribute((const void*)mega, hipFuncAttributeMaxDynamicSharedMemorySize, LDS_BYTES) != hipSuccess) { fprintf(stderr, "kernel_launch: hipFuncSetAttribute failed\n"); }
        if (hipOccupancyMaxActiveBlocksPerMultiprocessor(&per_cu, (const void*)mega, 512, LDS_BYTES) != hipSuccess || per_cu < 1) { fprintf(stderr, "kernel_launch: occupancy query gave %d\n", per_cu); per_cu = 1; }
        (void)hipGetLastError();
        grid_blocks = cus * 1;
    }
    if (grid_blocks < 0) return;
    (void)hipMemsetAsync((char*)d_ws + WS_BAR, 0, XCD_BAR_WORDS * 4, stream);
    Params p{};
    for (int i = 0; i < 21; ++i) p.in[i] = (const float*)d_in[i];
    p.out = (float*)d_out; p.ws = (unsigned char*)d_ws;
    void* args[] = {&p};
    hipError_t e = hipLaunchCooperativeKernel((const void*)mega, dim3(grid_blocks), dim3(512), args, LDS_BYTES, stream);
    if (e != hipSuccess) fprintf(stderr, "cooperative launch failed: %s (grid %d)\n", hipGetErrorString(e), grid_blocks);
}
```
